# Optimizing an MI355X kernel written in HIP

```python
import math
import jax, jax.numpy as jnp
from jax import lax
import numpy as np

D_MODEL = 1024
BATCH = 16
SEQ = 256
DEPTH = 2
DEC_BATCH = 8
DEC_SEQ = 1024
PAST_LEN = 256

GRID_W = 64
LRU_W = 1024
LRU_BLOCKS = 16
LRU_BW = LRU_W // LRU_BLOCKS
CONV_W = 4
LRU_C = 8.0
N_HEADS = 16
N_KV = 4
HEAD_DIM = 64
Q_W = N_HEADS * HEAD_DIM
KV_W = N_KV * HEAD_DIM
ROPE_BASE = 10000.0
Q_BLOCK = 128
POOL_WINDOWS = (2, 4, 8, 16)
POOL_W = 1024
POOL_G = POOL_W // 4
D_FF = 3 * D_MODEL
FFN_CONV_W = 3
N_BRANCH = 3
IN_SIZES = (LRU_W, LRU_W, Q_W, KV_W, KV_W, POOL_W, N_BRANCH * D_MODEL)
IN_COLS = 2 * LRU_W + Q_W + 2 * KV_W + POOL_W + N_BRANCH * D_MODEL
EPS = 1e-6

kernel_name = 'hybrid_lru_gqa_pool_prefix_dit_step'

F32 = jnp.float32


def rmsnorm(x, g):
    xf = x.astype(F32)
    y = xf * lax.rsqrt(jnp.mean(xf * xf, axis=-1, keepdims=True) + EPS)
    return (y * g.astype(F32)).astype(x.dtype)


def modulation(cond, w, b):
    return jax.nn.silu(cond) @ w + b


def dwconv(x, w, b):
    width = w.shape[0]
    left = (width - 1) // 2
    S = x.shape[1]
    xp = jnp.pad(x, ((0, 0), (left, width - 1 - left), (0, 0)))
    out = b
    for k in range(width):
        out = out + xp[:, k:k + S] * w[k]
    return out


def _lin_combine(left, right):
    a_l, b_l = left
    a_r, b_r = right
    return a_l * a_r, a_r * b_l + b_r


def rglru(x, w_r, b_r, w_i, b_i, lam, h0, reverse):
    B, S, W = x.shape
    xb = x.reshape(B, S, LRU_BLOCKS, LRU_BW)
    r = jax.nn.sigmoid(jnp.einsum('bsnk,nkj->bsnj', xb, w_r).reshape(B, S, W) + b_r)
    i = jax.nn.sigmoid(jnp.einsum('bsnk,nkj->bsnj', xb, w_i).reshape(B, S, W) + b_i)
    log_a = (LRU_C * r.astype(F32)) * jax.nn.log_sigmoid(lam.astype(F32))
    a = jnp.exp(log_a)
    u = jnp.sqrt(-jnp.expm1(2.0 * log_a)) * (i * x).astype(F32)
    if h0 is not None:
        edge = S - 1 if reverse else 0
        u = u.at[:, edge].add(a[:, edge] * h0.astype(F32))
    _, h = lax.associative_scan(_lin_combine, (a, u), axis=1, reverse=reverse)
    final = h[:, 0] if reverse else h[:, -1]
    return h.astype(x.dtype), final.astype(x.dtype)


def rope2d(x):
    S = x.shape[1]
    rows = S // GRID_W
    row = np.repeat(np.arange(rows), GRID_W).astype(np.float32)
    col = np.tile(np.arange(GRID_W), rows).astype(np.float32)
    half = HEAD_DIM // 2
    quarter = half // 2
    inv = (ROPE_BASE ** (-np.arange(quarter, dtype=np.float32) / quarter)).astype(np.float32)

    def rot(xh, pos):
        ang = jnp.asarray(pos[:, None] * inv[None, :])
        cos = jnp.cos(ang)[None, :, None, :].astype(x.dtype)
        sin = jnp.sin(ang)[None, :, None, :].astype(x.dtype)
        x1, x2 = xh[..., :quarter], xh[..., quarter:]
        return jnp.concatenate([x1 * cos - x2 * sin, x1 * sin + x2 * cos], axis=-1)

    return jnp.concatenate([rot(x[..., :half], row), rot(x[..., half:], col)], axis=-1)


def attend(q, k, v):
    B, Sq = q.shape[0], q.shape[1]
    G = N_HEADS // N_KV
    nb = Sq // Q_BLOCK
    scale = HEAD_DIM ** -0.5
    qb = q.reshape(B, nb, Q_BLOCK, N_KV, G, HEAD_DIM).transpose(1, 0, 2, 3, 4, 5)
    kf = k.astype(F32)

    def block(qi):
        s = jnp.einsum('bqkgd,bskd->bkgqs', qi.astype(F32), kf) * scale
        p = jax.nn.softmax(s, axis=-1)
        return jnp.einsum('bkgqs,bskd->bqkgd', p.astype(v.dtype), v)

    o = lax.map(block, qb)
    return o.transpose(1, 0, 2, 3, 4, 5).reshape(B, Sq, Q_W)


def pool_mixer(u, w_pool, scale):
    B, S, C = u.shape
    uf = u.astype(F32)
    cs = jnp.pad(jnp.cumsum(uf, axis=1), ((0, 0), (1, 0), (0, 0)))
    t = np.arange(S)
    outs = []
    for g, w in enumerate(POOL_WINDOWS):
        lo = np.clip(t - w // 2, 0, S)
        hi = np.clip(t - w // 2 + w, 0, S)
        sl = slice(g * POOL_G, (g + 1) * POOL_G)
        csg = cs[..., sl]
        cnt = jnp.asarray((hi - lo).astype(np.float32))[None, :, None]
        mean = (csg[:, hi] - csg[:, lo]) / cnt
        d = (mean - uf[..., sl]).astype(u.dtype)
        outs.append(d @ w_pool[g])
    return jnp.concatenate(outs, axis=-1) * scale


def mixers(h, p, ctx):
    B, S, _ = h.shape
    splits = [int(s) for s in np.cumsum(IN_SIZES)[:-1]]
    xr, yr, q, k, v, up, gl = jnp.split(h @ p['w_in'], splits, axis=-1)
    xr = dwconv(xr, p['conv_w'], p['conv_b'])
    h0f = None if ctx is None else ctx[2][:, 0]
    h0b = None if ctx is None else ctx[2][:, 1]
    hf, sf = rglru(xr, p['w_rg'][0], p['b_rg'][0], p['w_ig'][0], p['b_ig'][0], p['lru_lambda'][0], h0f, False)
    hb, sb = rglru(xr, p['w_rg'][1], p['b_rg'][1], p['w_ig'][1], p['b_ig'][1], p['lru_lambda'][1], h0b, True)
    branch_a = ((hf + hb) * jax.nn.gelu(yr)) @ p['w_br_a']
    q = rmsnorm(q.reshape(B, S, N_HEADS, HEAD_DIM), p['q_norm_g'])
    k = rmsnorm(k.reshape(B, S, N_KV, HEAD_DIM), p['k_norm_g'])
    v = v.reshape(B, S, N_KV, HEAD_DIM)
    if ctx is None:
        o = attend(q, k, v)
    else:
        o = attend(rope2d(q), jnp.concatenate([ctx[0], rope2d(k)], axis=1), jnp.concatenate([ctx[1], v], axis=1))
    branch_b = o @ p['w_br_b']
    branch_c = pool_mixer(up, p['w_pool'], p['pool_scale']) @ p['w_br_c']
    ga, gb, gc = jnp.split(jax.nn.sigmoid(gl + p['b_gate']), N_BRANCH, axis=-1)
    out = (ga * branch_a + gb * branch_b + gc * branch_c) @ p['w_o']
    new_ctx = (k, v, jnp.stack([sf, sb], axis=1)) if ctx is None else None
    return out, new_ctx


def conv_ffn(h, p):
    z = dwconv(h @ p['w_up'], p['ffn_conv_w'], p['ffn_conv_b'])
    g, val = jnp.split(z, 2, axis=-1)
    return (jax.nn.silu(g) * val) @ p['w_down']


def trunk_block(x, mod, p, ctx):
    sh1, sc1, g1, sh2, sc2, g2 = jnp.split(mod, 6, axis=-1)
    h = rmsnorm(x, p['norm1_g']) * (1.0 + sc1) + sh1
    mix, new_ctx = mixers(h, p, ctx)
    x = x + g1 * mix
    h = rmsnorm(x, p['norm2_g']) * (1.0 + sc2) + sh2
    x = x + g2 * conv_ffn(h, p)
    return x, new_ctx


def setup_inputs(seed: int = 0) -> dict:
    key = jax.random.key(seed)
    ks = jax.random.split(key, 40)
    D = D_MODEL

    def nrm(k, shape, s):
        return jax.random.normal(k, shape, F32) * s

    lam_p = jax.random.uniform(ks[14], (DEPTH, 2, LRU_W), F32, minval=0.9, maxval=0.999)
    return {
        'x_prompt': nrm(ks[0], (BATCH, SEQ, D), 1.0),
        'x_sample': nrm(ks[1], (DEC_BATCH, DEC_SEQ, D), 1.0),
        'cache_k': nrm(ks[2], (DEC_BATCH, DEPTH, PAST_LEN, N_KV, HEAD_DIM), 1.0),
        'cache_v': nrm(ks[3], (DEC_BATCH, DEPTH, PAST_LEN, N_KV, HEAD_DIM), 1.0),
        'state_lru': nrm(ks[4], (DEC_BATCH, DEPTH, 2, LRU_W), 0.5),
        'c': nrm(ks[5], (DEC_BATCH, D), 1.0),
        'c_ctx': nrm(ks[6], (D,), 1.0),
        'norm1_g': 1.0 + nrm(ks[7], (DEPTH, D), 0.02),
        'norm2_g': 1.0 + nrm(ks[8], (DEPTH, D), 0.02),
        'w_mod': nrm(ks[9], (DEPTH, D, 6 * D), 0.5 * D ** -0.5),
        'b_mod': nrm(ks[10], (DEPTH, 6 * D), 0.01),
        'w_in': nrm(ks[11], (DEPTH, D, IN_COLS), D ** -0.5),
        'b_gate': nrm(ks[12], (DEPTH, N_BRANCH * D), 0.01),
        'conv_w': nrm(ks[13], (DEPTH, CONV_W, LRU_W), CONV_W ** -0.5),
        'conv_b': nrm(ks[15], (DEPTH, LRU_W), 0.01),
        'w_rg': nrm(ks[16], (DEPTH, 2, LRU_BLOCKS, LRU_BW, LRU_BW), LRU_BW ** -0.5),
        'b_rg': nrm(ks[17], (DEPTH, 2, LRU_W), 0.01),
        'w_ig': nrm(ks[18], (DEPTH, 2, LRU_BLOCKS, LRU_BW, LRU_BW), LRU_BW ** -0.5),
        'b_ig': nrm(ks[19], (DEPTH, 2, LRU_W), 0.01),
        'lru_lambda': jnp.log(lam_p) - jnp.log1p(-lam_p),
        'q_norm_g': 1.0 + nrm(ks[20], (DEPTH, HEAD_DIM), 0.02),
        'k_norm_g': 1.0 + nrm(ks[21], (DEPTH, HEAD_DIM), 0.02),
        'w_pool': nrm(ks[22], (DEPTH, 4, POOL_G, POOL_G), POOL_G ** -0.5),
        'pool_scale': 1.0 + nrm(ks[23], (DEPTH, POOL_W), 0.02),
        'w_br_a': nrm(ks[24], (DEPTH, LRU_W, D), LRU_W ** -0.5),
        'w_br_b': nrm(ks[25], (DEPTH, Q_W, D), Q_W ** -0.5),
        'w_br_c': nrm(ks[26], (DEPTH, POOL_W, D), POOL_W ** -0.5),
        'w_o': nrm(ks[27], (DEPTH, D, D), D ** -0.5),
        'w_up': nrm(ks[28], (DEPTH, D, 2 * D_FF), D ** -0.5),
        'ffn_conv_w': nrm(ks[29], (DEPTH, FFN_CONV_W, 2 * D_FF), FFN_CONV_W ** -0.5),
        'ffn_conv_b': nrm(ks[30], (DEPTH, 2 * D_FF), 0.01),
        'w_down': nrm(ks[31], (DEPTH, D_FF, D), D_FF ** -0.5),
        'final_norm_g': 1.0 + nrm(ks[32], (D,), 0.02),
    }


def reference(x_prompt, x_sample, cache_k, cache_v, state_lru, c, c_ctx,
              norm1_g, norm2_g, w_mod, b_mod, w_in, b_gate, conv_w, conv_b,
              w_rg, b_rg, w_ig, b_ig, lru_lambda, q_norm_g, k_norm_g,
              w_pool, pool_scale, w_br_a, w_br_b, w_br_c, w_o,
              w_up, ffn_conv_w, ffn_conv_b, w_down, final_norm_g):
    xp = x_prompt
    xs = x_sample
    new_k, new_v, new_s = [], [], []
    for l in range(DEPTH):
        p = dict(norm1_g=norm1_g[l], norm2_g=norm2_g[l], w_in=w_in[l], b_gate=b_gate[l],
                 conv_w=conv_w[l], conv_b=conv_b[l], w_rg=w_rg[l], b_rg=b_rg[l],
                 w_ig=w_ig[l], b_ig=b_ig[l], lru_lambda=lru_lambda[l],
                 q_norm_g=q_norm_g[l], k_norm_g=k_norm_g[l], w_pool=w_pool[l],
                 pool_scale=pool_scale[l], w_br_a=w_br_a[l], w_br_b=w_br_b[l],
                 w_br_c=w_br_c[l], w_o=w_o[l], w_up=w_up[l], ffn_conv_w=ffn_conv_w[l],
                 ffn_conv_b=ffn_conv_b[l], w_down=w_down[l])
        mod_ctx = modulation(c_ctx, w_mod[l], b_mod[l])[None, None, :]
        mod_lat = modulation(c, w_mod[l], b_mod[l])[:, None, :]
        xp, (kc, vc, sc) = trunk_block(xp, mod_ctx, p, None)
        new_k.append(kc)
        new_v.append(vc)
        new_s.append(sc)
        xs, _ = trunk_block(xs, mod_lat, p, (cache_k[:, l], cache_v[:, l], state_lru[:, l]))
    y_prompt = rmsnorm(xp, final_norm_g)
    y_sample = rmsnorm(xs, final_norm_g)
    new_cache_k = jnp.stack(new_k, axis=1)
    new_cache_v = jnp.stack(new_v, axis=1)
    new_state_lru = jnp.stack(new_s, axis=1)
    return (y_prompt, y_sample, new_cache_k, new_cache_v, new_state_lru)
```

```cpp
#include <hip/hip_runtime.h>
#include <hip/hip_cooperative_groups.h>
#include <cstdio>
namespace cg = cooperative_groups;

#define LAS __attribute__((address_space(3)))
#define DI __device__ __forceinline__
typedef unsigned short bf16_t;
typedef short bf16x8 __attribute__((ext_vector_type(8)));
typedef float f32x4 __attribute__((ext_vector_type(4)));
typedef float f32x16 __attribute__((ext_vector_type(16)));
typedef unsigned u32x4 __attribute__((ext_vector_type(4)));
typedef unsigned u32x2 __attribute__((ext_vector_type(2)));
typedef float f32x2_t __attribute__((ext_vector_type(2)));
typedef __bf16 bfx2 __attribute__((ext_vector_type(2)));

constexpr int MT = 12288, MCTX = 4096, DM = 1024;
constexpr size_t SLOT_E = (size_t)MT * 1024;
constexpr size_t SLOT_B = SLOT_E * 2;
constexpr size_t OFF_SLOTS = 0;
constexpr size_t OFF_KRAW = 8 * SLOT_B;
constexpr size_t OFF_VRAW = OFF_KRAW + (size_t)MT * 256 * 2;
constexpr size_t OFF_CK = OFF_VRAW + (size_t)MT * 256 * 2;
constexpr size_t OFF_VT = OFF_CK + (size_t)8 * 256 * 256 * 2;
constexpr size_t VT_LAT_E = (size_t)16 * 4 * 64 * 256;
constexpr size_t OFF_W = OFF_VT + ((size_t)16 * 4 * 64 * 256 + (size_t)8 * 4 * 64 * 1280) * 2;
constexpr size_t W_IN = 0, W_BR = W_IN + (size_t)7680 * 1024 * 2, W_O = W_BR + (size_t)3 * 1024 * 1024 * 2, W_UP = W_O + (size_t)1024 * 1024 * 2,
                 W_DOWN = W_UP + (size_t)6144 * 1024 * 2, W_POOL = W_DOWN + (size_t)1024 * 3072 * 2, W_GATE = W_POOL + (size_t)1024 * 256 * 2, W_END = W_GATE + (size_t)16 * 2 * 128 * 64 * 2;
constexpr size_t OFF_MOD = OFF_W + W_END;
constexpr size_t OFF_BAR = OFF_MOD + (size_t)2 * 9 * 6144 * 4;
constexpr int XCD_BAR_WORDS = 3456;
constexpr size_t OFF_KMAX = OFF_BAR + (size_t)XCD_BAR_WORDS * 4;
constexpr size_t WS_NEED = OFF_KMAX + 256 * 4;
#ifndef EXP
#define EXP 0
#endif
constexpr int LDS_BYTES = 131072 + 16;
constexpr size_t OUT_CK = (size_t)MT * 1024, OUT_CV = OUT_CK + (size_t)16 * 2 * 256 * 256, OUT_ST = OUT_CV + (size_t)16 * 2 * 256 * 256;

struct Params { const float* in[33]; float* out; unsigned char* ws; };
typedef const __attribute__((address_space(4))) unsigned char* kptr_t;
struct KP { kptr_t k;
    DI const float* in(int i) const { return *(const float* const __attribute__((address_space(4)))*)(k + 8 * i); }
    DI float* out() const { return *(float* const __attribute__((address_space(4)))*)(k + 8 * 33); }
    DI unsigned char* ws() const { return *(unsigned char* const __attribute__((address_space(4)))*)(k + 8 * 34); } };
DI KP fresh_kp() { kptr_t k = (kptr_t)__builtin_amdgcn_kernarg_segment_ptr(); asm volatile("" : "+s"(k)); KP p; p.k = k; return p; }
DI int ltid() { int t = threadIdx.x; asm volatile("" : "+v"(t)); return t; }
DI int lbid() { int t = blockIdx.x; asm volatile("" : "+s"(t)); return t; }
DI int lgdim() { int t = gridDim.x; asm volatile("" : "+s"(t)); return t; }

DI unsigned pk2(float a, float b) { bfx2 v; v[0] = (__bf16)a; v[1] = (__bf16)b; return __builtin_bit_cast(unsigned, v); }
DI float bflo(unsigned u) { return __uint_as_float(u << 16); }
DI float bfhi(unsigned u) { return __uint_as_float(u & 0xffff0000u); }
DI void unpack8(u32x4 v, float* f) { f[0] = bflo(v[0]); f[1] = bfhi(v[0]); f[2] = bflo(v[1]); f[3] = bfhi(v[1]); f[4] = bflo(v[2]); f[5] = bfhi(v[2]); f[6] = bflo(v[3]); f[7] = bfhi(v[3]); }
DI u32x4 pack8(const float* f) { u32x4 r; r[0] = pk2(f[0], f[1]); r[1] = pk2(f[2], f[3]); r[2] = pk2(f[4], f[5]); r[3] = pk2(f[6], f[7]); return r; }
DI float sigmoidf_(float x) { return __builtin_amdgcn_rcpf(1.0f + __builtin_amdgcn_exp2f(-1.4426950408889634f * x)); }
DI float gelu_tanh(float x) { const float z = 0.7978845608028654f * (x + 0.044715f * x * x * x); return x * sigmoidf_(2.0f * z); }
DI int seq_start(int m) { return m < MCTX ? (m & ~255) : (MCTX + ((m - MCTX) & ~1023)); }
DI int seq_len(int m) { return m < MCTX ? 256 : 1024; }
DI int mod_row(int m) { return m < MCTX ? 0 : 1 + ((m - MCTX) >> 10); }

namespace pg8 {
constexpr int BM = 256, BK = 64, HALF = 128, HTB = HALF * BK * 2, STAGE_BYTES = 8 * HTB, NXCD = 8, WGM = 8;
DI int lds_byte(int r, int c) { const int st = (r >> 4) * 2 + (c >> 5), rr = r & 15, cc = c & 31, ob = rr * 64 + cc * 2; return st * 1024 + (ob ^ (((ob >> 9) & 1) << 5)); }
DI void stage_rc(int b, int& R, int& C) { const int st = b / 1024, sb = b % 1024, swz = sb ^ (((sb >> 9) & 1) << 5); R = (st >> 1) * 16 + swz / 64; C = (st & 1) * 32 + (swz % 64) / 2; }
DI int perm32(int rho) { const int n = rho >> 4, i = rho & 15; return 8 * (i >> 2) + 4 * n + (i & 3); }
struct Unit { int pm, pn, seg; };
struct Gemm { const bf16_t* A; const bf16_t* Bt; int lda, ldb, K; int nM, nN, nSeg, pn0; long a_pn_stride, a_seg1, a_seg2, b_seg_stride; };
DI bool next_unit(const Gemm& g, int i, int G, int c, Unit& u) {
    const int nwg = g.nM * g.nN; const int it = i / g.nSeg; u.seg = i - it * g.nSeg;
    const long L = (long)it * G + c; if (L >= nwg) return false;
    int wgid = (int)L; { const int q = nwg / NXCD, r = nwg % NXCD, xcd = wgid % NXCD, off = wgid / NXCD; wgid = (xcd < r ? xcd * (q + 1) : r * (q + 1) + (xcd - r) * q) + off; }
    const int nig = WGM * g.nN, gid = wgid / nig, fm = gid * WGM, gsz = (g.nM - fm) < WGM ? (g.nM - fm) : WGM;
    u.pm = fm + ((wgid % nig) % gsz); u.pn = (wgid % nig) / gsz; return true;
}
DI const char* a_ptr(const Gemm& g, const Unit& u) { return (const char*)(g.A + (size_t)u.pm * 256 * g.lda + (size_t)u.pn * g.a_pn_stride + (u.seg == 0 ? 0 : (u.seg == 1 ? g.a_seg1 : g.a_seg2))); }
DI const char* b_ptr(const Gemm& g, const Unit& u) { return (const char*)(g.Bt + (size_t)(g.pn0 + u.pn) * 256 * g.ldb + (size_t)u.seg * g.b_seg_stride); }

template <class Epi>
DI void gemm_phase(LAS unsigned char* lds, const Gemm g, const Epi& E, int Gv = 0, int cv = 0) {
    const int tid = ltid(), wid = __builtin_amdgcn_readfirstlane(tid >> 6), lane = tid & 63, wr = wid >> 2, wc = wid & 3, fr = lane & 15, fq = lane >> 4;
    constexpr bool MERGE = Epi::MERGE;
    const int K = g.K, nt = MERGE ? 3 * (K / BK) : K / BK; const int G = Gv > 0 ? Gv : lgdim(), c = Gv > 0 ? cv : lbid();
    unsigned voffA[2], voffB[2];
#pragma unroll
    for (int i = 0; i < 2; ++i) { int R, C; stage_rc(tid * 16 + i * 8192, R, C); const int Rb = Epi::PERM ? ((R & ~31) + perm32(R & 31)) : R;
        voffA[i] = (unsigned)(R * g.lda + C) * 2u; voffB[i] = (unsigned)(Rb * g.ldb + C) * 2u; }
    const size_t kstep = (size_t)(BK * 2);
    const size_t hstepA = (size_t)HALF * g.lda * 2, hstepB = (size_t)HALF * g.ldb * 2;
    const unsigned ldsw = (unsigned)wid * 1024u;
    const int aoff = lds_byte(wr * 64 + fr, fq * 8), boff = lds_byte(wc * 32 + fr, fq * 8);
#define PG8_SA(b, h) (((b) * 2 + (h)) * HTB)
#define PG8_SB(b, h) ((4 + (b) * 2 + (h)) * HTB)
#define PG8_STAGE(bufoff, gbase, voff) do { _Pragma("unroll") for (int _i = 0; _i < 2; ++_i) \
        __builtin_amdgcn_global_load_lds((const unsigned*)((const char*)(gbase) + (voff)[_i]), (LAS unsigned*)(lds + (bufoff) + ldsw + _i * 8192), 16, 0, 0); } while (0)
#define PG8_LDA(dst, b, h) do { _Pragma("unroll") for (int m = 0; m < 4; ++m) _Pragma("unroll") for (int k = 0; k < 2; ++k) dst[m][k] = *(const LAS bf16x8*)(lds + PG8_SA(b, h) + aoff + m * 2048 + k * 1024); } while (0)
#define PG8_LDB(dst, b, h) do { _Pragma("unroll") for (int n = 0; n < 2; ++n) _Pragma("unroll") for (int k = 0; k < 2; ++k) dst[n][k] = *(const LAS bf16x8*)(lds + PG8_SB(b, h) + boff + n * 2048 + k * 1024); } while (0)
#define PG8_MMA(ai, bj, At, Bt) do { __builtin_amdgcn_s_setprio(1); _Pragma("unroll") for (int m = 0; m < 4; ++m) _Pragma("unroll") for (int n = 0; n < 2; ++n) _Pragma("unroll") for (int k = 0; k < 2; ++k) \
        acc[ai][bj][m][n] = __builtin_amdgcn_mfma_f32_16x16x32_bf16(Bt[n][k], At[m][k], acc[ai][bj][m][n], 0, 0, 0); __builtin_amdgcn_s_setprio(0); } while (0)
#define PG8_WAIT_V(n) asm volatile("s_waitcnt vmcnt(" #n ")" ::: "memory")
#define PG8_WAIT_L(n) asm volatile("s_waitcnt lgkmcnt(" #n ")" ::: "memory")
#define PG8_BAR __builtin_amdgcn_s_barrier()
#define PG8_SCHED __builtin_amdgcn_sched_barrier(0)
    Unit cur, nxt; int ui = 0;
    if (!next_unit(g, 0, G, c, cur)) return;
    f32x4 acc[2][2][4][2];
#pragma unroll
    for (int a = 0; a < 2; ++a)
#pragma unroll
        for (int b = 0; b < 2; ++b)
#pragma unroll
            for (int m = 0; m < 4; ++m)
#pragma unroll
                for (int n = 0; n < 2; ++n) acc[a][b][m][n] = (f32x4){0.f, 0.f, 0.f, 0.f};
    bf16x8 At[4][2], B0[2][2], B1[2][2];
    const char* cA = a_ptr(g, cur); const char* cB = b_ptr(g, cur);
    PG8_STAGE(PG8_SB(0, 0), cB, voffB); PG8_STAGE(PG8_SA(0, 0), cA, voffA); PG8_STAGE(PG8_SB(0, 1), cB + hstepB, voffB); PG8_STAGE(PG8_SA(0, 1), cA + hstepA, voffA);
    if (wr == 1) PG8_BAR;
    PG8_WAIT_V(4); PG8_BAR;
    PG8_STAGE(PG8_SB(1, 0), cB + kstep, voffB); PG8_STAGE(PG8_SA(1, 0), cA + kstep, voffA); PG8_STAGE(PG8_SB(1, 1), cB + hstepB + kstep, voffB);
    PG8_WAIT_V(6); PG8_BAR;
    for (;;) {
        const bool has_next = next_unit(g, ui + 1, G, c, nxt);
        const char* nA = has_next ? a_ptr(g, nxt) : cA; const char* nB = has_next ? b_ptr(g, nxt) : cB;
        for (int t = 0; t < nt; t += 2) {
            const bool last = (t == nt - 2);
            const char* a1; const char* a2; const char* b2; const char* a3; const char* b3;
            if constexpr (!MERGE) { a1 = cA + (size_t)(t + 1) * kstep; a2 = last ? nA : cA + (size_t)(t + 2) * kstep; b2 = last ? nB : cB + (size_t)(t + 2) * kstep; }
            else { const int ntk = K / BK; const int sg1 = (t + 1) / ntk, sg2 = (t + 2) / ntk;
                a1 = cA + (sg1 == 0 ? 0 : (sg1 == 1 ? g.a_seg1 : g.a_seg2)) * 2 + (size_t)(t + 1 - sg1 * ntk) * kstep;
                a2 = last ? nA : cA + (sg2 == 0 ? 0 : (sg2 == 1 ? g.a_seg1 : g.a_seg2)) * 2 + (size_t)(t + 2 - sg2 * ntk) * kstep;
                b2 = last ? nB : cB + (size_t)sg2 * g.b_seg_stride * 2 + (size_t)(t + 2 - sg2 * ntk) * kstep;
                if (t > 0 && t % ntk == 0) E.rescale(acc, cur, t / ntk, wr, wc, fr, fq); }
            a3 = a2 + kstep; b3 = b2 + kstep;
            PG8_LDB(B0, 0, 0); PG8_SCHED; PG8_LDA(At, 0, 0); PG8_STAGE(PG8_SA(1, 1), a1 + hstepA, voffA);
            PG8_WAIT_L(8); PG8_BAR; PG8_WAIT_L(0); PG8_MMA(0, 0, At, B0); PG8_BAR; PG8_SCHED;
            PG8_LDB(B1, 0, 1); PG8_STAGE(PG8_SB(0, 0), b2, voffB);
            PG8_BAR; PG8_WAIT_L(0); PG8_MMA(0, 1, At, B1); PG8_BAR;
            PG8_LDA(At, 0, 1); PG8_STAGE(PG8_SA(0, 0), a2, voffA);
            PG8_BAR; PG8_WAIT_L(0); PG8_MMA(1, 0, At, B0); PG8_BAR; PG8_SCHED;
            PG8_STAGE(PG8_SB(0, 1), b2 + hstepB, voffB);
            PG8_WAIT_V(6); PG8_BAR; PG8_MMA(1, 1, At, B1); PG8_BAR;
            PG8_LDB(B0, 1, 0); PG8_SCHED; PG8_LDA(At, 1, 0); PG8_STAGE(PG8_SA(0, 1), a2 + hstepA, voffA);
            PG8_WAIT_L(8); PG8_BAR; PG8_WAIT_L(0); PG8_MMA(0, 0, At, B0); PG8_BAR; PG8_SCHED;
            PG8_LDB(B1, 1, 1); PG8_STAGE(PG8_SB(1, 0), b3, voffB);
            PG8_BAR; PG8_WAIT_L(0); PG8_MMA(0, 1, At, B1); PG8_BAR;
            PG8_LDA(At, 1, 1); PG8_STAGE(PG8_SA(1, 0), a3, voffA);
            PG8_BAR; PG8_WAIT_L(0); PG8_MMA(1, 0, At, B0); PG8_BAR; PG8_SCHED;
            PG8_STAGE(PG8_SB(1, 1), b3 + hstepB, voffB);
            PG8_WAIT_V(6); PG8_BAR; PG8_MMA(1, 1, At, B1); PG8_BAR;
        }
        E(acc, cur, wr, wc, fr, fq);
        if (!has_next) break;
#pragma unroll
        for (int a = 0; a < 2; ++a)
#pragma unroll
            for (int b = 0; b < 2; ++b)
#pragma unroll
                for (int m = 0; m < 4; ++m)
#pragma unroll
                    for (int n = 0; n < 2; ++n) acc[a][b][m][n] = (f32x4){0.f, 0.f, 0.f, 0.f};
        cur = nxt; cA = nA; cB = nB; ++ui;
    }
    PG8_WAIT_V(0);
    if (wr == 0) PG8_BAR;
    PG8_BAR;
#undef PG8_SA
#undef PG8_SB
#undef PG8_STAGE
#undef PG8_LDA
#undef PG8_LDB
#undef PG8_MMA
#undef PG8_WAIT_V
#undef PG8_WAIT_L
#undef PG8_BAR
#undef PG8_SCHED
}
}
using pg8::Unit;
typedef f32x4 AccT[2][2][4][2];

struct EpiInProj {
    static constexpr bool PERM = true, MERGE = false;
    bf16_t* slots; bf16_t* kraw; bf16_t* vraw; const float* b_gate;
    DI void operator()(const AccT& acc, const Unit& u, int wr, int wc, int fr, int fq) const {
        const int pn = u.pn; bf16_t* base; int ld = 1024, ccol, mode = 0; const float* bias = b_gate;
        if (pn < 4) { base = slots + 1 * SLOT_E; ccol = pn * 256; }
        else if (pn < 8) { base = slots + 2 * SLOT_E; ccol = (pn - 4) * 256; mode = 1; }
        else if (pn < 12) { base = slots + 3 * SLOT_E; ccol = (pn - 8) * 256; }
        else if (pn == 12) { base = kraw; ld = 256; ccol = 0; }
        else if (pn == 13) { base = vraw; ld = 256; ccol = 0; }
        else if (pn < 18) { base = slots + 4 * SLOT_E; ccol = (pn - 14) * 256; }
        else { const int sec = (pn - 18) >> 2; base = slots + (size_t)(5 + sec) * SLOT_E; ccol = ((pn - 18) & 3) * 256; mode = 2; bias = b_gate + (pn - 18) * 256; }
        const int row0 = u.pm * 256 + wr * 64 + fr, cl = wc * 32 + 8 * fq;
#pragma unroll
        for (int bj = 0; bj < 2; ++bj) {
            float bv[8];
#pragma unroll
            for (int e = 0; e < 8; ++e) bv[e] = (mode == 2) ? bias[cl + bj * 128 + e] : 0.f;
#pragma unroll
            for (int ai = 0; ai < 2; ++ai)
#pragma unroll
                for (int m = 0; m < 4; ++m) {
                    float v[8];
#pragma unroll
                    for (int e = 0; e < 4; ++e) { v[e] = acc[ai][bj][m][0][e]; v[4 + e] = acc[ai][bj][m][1][e]; }
                    if (mode == 1) {
#pragma unroll
                        for (int e = 0; e < 8; ++e) v[e] = gelu_tanh(v[e]);
                    } else if (mode == 2) {
#pragma unroll
                        for (int e = 0; e < 8; ++e) v[e] = sigmoidf_(v[e] + bv[e]);
                    }
                    *(u32x4*)(base + (size_t)(row0 + ai * 128 + m * 16) * ld + ccol + bj * 128 + cl) = pack8(v);
                }
        }
    }
};
struct EpiScaleBf16 {
    static constexpr bool PERM = true, MERGE = false;
    bf16_t* O; int ldc; int pn_base; const float* scale;
    DI void operator()(const AccT& acc, const Unit& u, int wr, int wc, int fr, int fq) const {
        const int row0 = u.pm * 256 + wr * 64 + fr, cl = (u.pn + pn_base) * 256 + wc * 32 + 8 * fq;
#pragma unroll
        for (int bj = 0; bj < 2; ++bj) {
            float sv[8];
#pragma unroll
            for (int e = 0; e < 8; ++e) sv[e] = scale ? scale[cl + bj * 128 + e] : 1.0f;
#pragma unroll
            for (int ai = 0; ai < 2; ++ai)
#pragma unroll
                for (int m = 0; m < 4; ++m) {
                    float v[8];
#pragma unroll
                    for (int e = 0; e < 4; ++e) { v[e] = acc[ai][bj][m][0][e] * sv[e]; v[4 + e] = acc[ai][bj][m][1][e] * sv[4 + e]; }
                    *(u32x4*)(O + (size_t)(row0 + ai * 128 + m * 16) * ldc + cl + bj * 128) = pack8(v);
                }
        }
    }
};
struct EpiMerge {
    static constexpr bool PERM = true, MERGE = true;
    bf16_t* gates; bool dry;
    DI void rescale(AccT& acc, const Unit& u, int sb, int wr, int wc, int fr, int fq) const {
        const int row0 = u.pm * 256 + wr * 64 + fr, cl = u.pn * 256 + wc * 32 + 8 * fq;
        const bf16_t* gp = gates + (size_t)(sb - 1) * SLOT_E + (size_t)row0 * 1024 + cl;
#pragma unroll
        for (int ai = 0; ai < 2; ++ai)
#pragma unroll
            for (int m = 0; m < 4; ++m) {
                asm volatile("" : "+v"(gp));
#pragma unroll
                for (int bj = 0; bj < 2; ++bj) {
                    float a[8], b[8]; unpack8(*(const u32x4*)(gp + bj * 128), a); unpack8(*(const u32x4*)(gp + SLOT_E + bj * 128), b);
#pragma unroll
                    for (int e = 0; e < 4; ++e) { acc[ai][bj][m][0][e] *= a[e] * __builtin_amdgcn_rcpf(b[e]); acc[ai][bj][m][1][e] *= a[4 + e] * __builtin_amdgcn_rcpf(b[4 + e]); }
                }
                gp += (m == 3 ? (128 - 48) : 16) * 1024;
            }
    }
    DI void operator()(const AccT& acc, const Unit& u, int wr, int wc, int fr, int fq) const {
        const int row0 = u.pm * 256 + wr * 64 + fr, cl = u.pn * 256 + wc * 32 + 8 * fq;
        bf16_t* gs = gates + 2 * SLOT_E;
#pragma unroll
        for (int ai = 0; ai < 2; ++ai)
#pragma unroll
            for (int m = 0; m < 4; ++m)
#pragma unroll
                for (int bj = 0; bj < 2; ++bj) {
                    const size_t idx = (size_t)(row0 + ai * 128 + m * 16) * 1024 + cl + bj * 128;
                    float gv[8]; unpack8(*(const u32x4*)(gs + idx), gv);
                    float v[8];
#pragma unroll
                    for (int e = 0; e < 4; ++e) { v[e] = acc[ai][bj][m][0][e] * gv[e]; v[4 + e] = acc[ai][bj][m][1][e] * gv[4 + e]; }
                    if (!dry) *(u32x4*)(gs + idx) = pack8(v);
                }
    }
};
DI float dpp_ror1(float v) { return __builtin_bit_cast(float, __builtin_amdgcn_update_dpp(0, __builtin_bit_cast(int, v), 0x121, 0xf, 0xf, false)); }
DI float dpp_ror15(float v) { return __builtin_bit_cast(float, __builtin_amdgcn_update_dpp(0, __builtin_bit_cast(int, v), 0x12f, 0xf, 0xf, false)); }
struct EpiUpFused {
    static constexpr bool PERM = true, MERGE = false;
    bf16_t* act; float* zedge; float* zpart; const float* cw; const float* cb;
    DI void operator()(const AccT& acc, const Unit& u, int wr, int wc, int fr, int fq) const {
        const int j = u.pn, cl = wc * 32 + 8 * fq;
#pragma unroll
        for (int n = 0; n < 2; ++n) {
            const int ch0 = 128 * j + cl + 4 * n;
            const f32x4 bg = *(const f32x4*)(cb + ch0), w0g = *(const f32x4*)(cw + ch0), w1g = *(const f32x4*)(cw + 6144 + ch0), w2g = *(const f32x4*)(cw + 2 * 6144 + ch0);
            const f32x4 bv = *(const f32x4*)(cb + 3072 + ch0), w0v = *(const f32x4*)(cw + 3072 + ch0), w1v = *(const f32x4*)(cw + 6144 + 3072 + ch0), w2v = *(const f32x4*)(cw + 2 * 6144 + 3072 + ch0);
#pragma unroll
            for (int ai = 0; ai < 2; ++ai) {
                const int rowblk = u.pm * 256 + ai * 128 + wr * 64;
#pragma unroll
                for (int m = 0; m < 4; ++m) {
                    const f32x4 zg = acc[ai][0][m][n], zv = acc[ai][1][m][n];
                    f32x4 pg, pv, ng, nv;
#pragma unroll
                    for (int e = 0; e < 4; ++e) {
                        const float pgs = dpp_ror1(zg[e]), pvs = dpp_ror1(zv[e]), ngs = dpp_ror15(zg[e]), nvs = dpp_ror15(zv[e]);
                        const float pgw = m > 0 ? dpp_ror1(acc[ai][0][m > 0 ? m - 1 : 0][n][e]) : 0.f, pvw = m > 0 ? dpp_ror1(acc[ai][1][m > 0 ? m - 1 : 0][n][e]) : 0.f;
                        const float ngw = m < 3 ? dpp_ror15(acc[ai][0][m < 3 ? m + 1 : 3][n][e]) : 0.f, nvw = m < 3 ? dpp_ror15(acc[ai][1][m < 3 ? m + 1 : 3][n][e]) : 0.f;
                        pg[e] = fr == 0 ? pgw : pgs; pv[e] = fr == 0 ? pvw : pvs; ng[e] = fr == 15 ? ngw : ngs; nv[e] = fr == 15 ? nvw : nvs; }
                    const f32x4 preg = bg + w0g * pg + w1g * zg + w2g * ng, prev = bv + w0v * pv + w1v * zv + w2v * nv;
                    const bool e0 = (m == 0 && fr == 0), e1 = (m == 3 && fr == 15);
                    if (e0 || e1) { const size_t o = ((size_t)((rowblk >> 6) * 2 + (e1 ? 1 : 0))) * 6144 + j * 256 + cl + 4 * n;
                        *(f32x4*)(zpart + o) = preg; *(f32x4*)(zpart + o + 128) = prev; *(f32x4*)(zedge + o) = zg; *(f32x4*)(zedge + o + 128) = zv; }
                    else { u32x2 ov; ov[0] = pk2(preg[0] * sigmoidf_(preg[0]) * prev[0], preg[1] * sigmoidf_(preg[1]) * prev[1]); ov[1] = pk2(preg[2] * sigmoidf_(preg[2]) * prev[2], preg[3] * sigmoidf_(preg[3]) * prev[3]);
                        *(u32x2*)(act + (size_t)(rowblk + 16 * m + fr) * 3072 + ch0) = ov; }
                }
            }
        }
    }
};
DI void ffn_fixup(int pm, bf16_t* act, const float* zedge, const float* zpart, const float* cw, const float* cb) {
    const int tid = ltid();
    for (int pc = tid; pc < 8 * 768; pc += 512) {
        const int er = pc / 768, ch0 = (pc - er * 768) * 4; const int B = 4 * pm + (er >> 1), edge = er & 1;
        const int zc = (ch0 >> 7) * 256 + (ch0 & 127);
        const size_t o = ((size_t)(B * 2 + edge)) * 6144 + zc;
        f32x4 pg = *(const f32x4*)(zpart + o), pv = *(const f32x4*)(zpart + o + 128);
        const int row = B * 64 + (edge ? 63 : 0); const int s0 = seq_start(row), S = seq_len(row), t = row - s0;
        if (edge == 0 && t > 0) { const size_t q = ((size_t)((B - 1) * 2 + 1)) * 6144 + zc; pg += *(const f32x4*)(cw + ch0) * *(const f32x4*)(zedge + q); pv += *(const f32x4*)(cw + 3072 + ch0) * *(const f32x4*)(zedge + q + 128); }
        if (edge == 1 && t < S - 1) { const size_t q = ((size_t)((B + 1) * 2 + 0)) * 6144 + zc; pg += *(const f32x4*)(cw + 2 * 6144 + ch0) * *(const f32x4*)(zedge + q); pv += *(const f32x4*)(cw + 2 * 6144 + 3072 + ch0) * *(const f32x4*)(zedge + q + 128); }
        u32x2 ov; ov[0] = pk2(pg[0] * sigmoidf_(pg[0]) * pv[0], pg[1] * sigmoidf_(pg[1]) * pv[1]); ov[1] = pk2(pg[2] * sigmoidf_(pg[2]) * pv[2], pg[3] * sigmoidf_(pg[3]) * pv[3]);
        *(u32x2*)(act + (size_t)row * 3072 + ch0) = ov;
    }
    asm volatile("s_waitcnt vmcnt(0)" ::: "memory");
    __syncthreads();
}
struct EpiResid {
    static constexpr bool PERM = false, MERGE = false;
    float* x; const float* modl; int gate_off; bool dry;
    DI void operator()(const AccT& acc, const Unit& u, int wr, int wc, int fr, int fq) const {
        const int row0 = u.pm * 256 + wr * 64 + fr, col0 = u.pn * 256 + wc * 32 + 4 * fq;
        const float* gp = modl + (size_t)mod_row(u.pm * 256) * 6144 + gate_off;
#pragma unroll
        for (int bj = 0; bj < 2; ++bj)
#pragma unroll
            for (int n = 0; n < 2; ++n) {
                const int col = col0 + bj * 128 + n * 16; const f32x4 gv = *(const f32x4*)(gp + col);
#pragma unroll
                for (int ai = 0; ai < 2; ++ai)
#pragma unroll
                    for (int m = 0; m < 4; ++m) { float* xp = x + (size_t)(row0 + ai * 128 + m * 16) * 1024 + col; f32x4 xv = *(const f32x4*)xp; xv += gv * acc[ai][bj][m][n]; if (!dry) *(f32x4*)xp = xv; }
            }
    }
};


#define XB_TMO      128
#define XB_XCNT(j)  (256  + 64 * (j))
#define XB_XSUB(j)  (1280 + 64 * (j))
#define XB_XGEN(j)  (2304 + 64 * (j))
#define XB_TOP      3328
#define XB_TOPGEN   3392
#define XB_SPIN_CAP (1u << 18)
DI unsigned xb_ld(unsigned* p) { return __hip_atomic_load(p, __ATOMIC_RELAXED, __HIP_MEMORY_SCOPE_AGENT); }
DI unsigned xb_add(unsigned* p, unsigned v) { return __hip_atomic_fetch_add(p, v, __ATOMIC_RELAXED, __HIP_MEMORY_SCOPE_AGENT); }
DI unsigned xb_xcc_id() { return (unsigned)__builtin_amdgcn_s_getreg((3 << 11) | 20) & 0xFu; }
#define XB_SPIN(cond, bar) do { unsigned _sp = 0; while (cond) { __builtin_amdgcn_s_sleep(1); \
    if ((++_sp & 255u) == 0u) { if (xb_ld(&(bar)[XB_TMO])) break; if (_sp > XB_SPIN_CAP) { atomicAdd(&(bar)[XB_TMO], 1u); break; } } } } while (0)
DI void xcd_barrier_complete(unsigned* bar, unsigned x, unsigned& nloc, unsigned& nx) {
    const unsigned G = gridDim.x;
    unsigned sum, cnt, mine, sp = 0u;
    for (;;) {
        sum = 0u; cnt = 0u; mine = 0u;
#pragma unroll
        for (unsigned j = 0; j < 16; ++j) { const unsigned c = xb_ld(&bar[XB_XCNT(j)]); sum += c; cnt += (c > 0u) ? 1u : 0u; mine = (j == x) ? c : mine; }
        if (sum == G) break;
        __builtin_amdgcn_s_sleep(1);
        if ((++sp & 255u) == 0u) { if (xb_ld(&bar[XB_TMO])) break; if (sp > XB_SPIN_CAP) { atomicAdd(&bar[XB_TMO], 1u); break; } }
    }
    nloc = mine > 0u ? mine : 1u; nx = cnt > 0u ? cnt : 1u;
}
DI void gbar_post(const KP p, unsigned char* shm) {
    volatile LAS unsigned* st = (volatile LAS unsigned*)(LAS unsigned char*)(shm + 131072);
    if (threadIdx.x == 0) { st[0] = 0u; st[1] = 0u; (void)xb_add(&((unsigned*)(p.ws() + OFF_BAR))[XB_XCNT(xb_xcc_id())], 1u); }
    __syncthreads();
}
DI void gbar(const KP p, unsigned char* shm) {
    asm volatile("s_waitcnt vmcnt(0)" ::: "memory");
    __syncthreads();
    if (threadIdx.x == 0) {
        unsigned* bar = (unsigned*)(p.ws() + OFF_BAR); const unsigned x = xb_xcc_id();
        volatile LAS unsigned* st = (volatile LAS unsigned*)(LAS unsigned char*)(shm + 131072);
        __builtin_amdgcn_s_waitcnt(0);
        unsigned nloc = st[0], nx = st[1];
        if (nloc == 0u) { xcd_barrier_complete(bar, x, nloc, nx); st[0] = nloc; st[1] = nx; }
        const unsigned old = xb_add(&bar[XB_XSUB(x)], 1u);
        const unsigned gen = old / nloc;
        if (old + 1u == (gen + 1u) * nloc) {
            __builtin_amdgcn_fence(__ATOMIC_RELEASE, "agent");
            asm volatile("s_waitcnt vmcnt(0)" ::: "memory");
            const unsigned og = xb_add(&bar[XB_TOP], 1u);
            const unsigned tg = og / nx;
            if (og + 1u == (tg + 1u) * nx) xb_add(&bar[XB_TOPGEN], 1u);
            else XB_SPIN(xb_ld(&bar[XB_TOPGEN]) == tg, bar);
            __builtin_amdgcn_fence(__ATOMIC_ACQUIRE, "agent");
            xb_add(&bar[XB_XGEN(x)], 1u);
            asm volatile("s_waitcnt vmcnt(0)" ::: "memory");
        } else {
            XB_SPIN(xb_ld(&bar[XB_XGEN(x)]) == gen, bar);
            __builtin_amdgcn_fence(__ATOMIC_ACQUIRE, "agent");
            asm volatile("s_waitcnt vmcnt(0)" ::: "memory");
        }
    }
    __syncthreads();
}

DI float wave_sum(float v) {
#pragma unroll
    for (int o = 32; o > 0; o >>= 1) v += __shfl_xor(v, o);
    return v;
}

DI void phase_mod(const KP p, unsigned char* shm) {
    float* sc = (float*)shm; float* red = sc + 9 * 1024;
    const int tid = ltid(); bool inited = false;
    const float* cond = p.in(5); const float* cctx = p.in(6);
    for (int it = lbid(); it < 192; it += lgdim()) {
        if (!inited) { for (int e = tid; e < 9 * 1024; e += 512) { const int r = e >> 10, k = e & 1023; const float v = r == 0 ? cctx[k] : cond[(r - 1) * 1024 + k]; sc[e] = v / (1.0f + expf(-v)); } __syncthreads(); inited = true; }
        const int l = it / 96, j0 = (it % 96) * 64, j = tid & 63, kq = tid >> 6;
        const float* w = p.in(9) + (size_t)l * 1024 * 6144 + j0 + j;
        float a0 = 0, a1 = 0, a2 = 0, a3 = 0, a4 = 0, a5 = 0, a6 = 0, a7 = 0, a8 = 0;
        for (int k = kq * 128; k < kq * 128 + 128; ++k) { const float wv = w[(size_t)k * 6144];
            a0 += sc[k] * wv; a1 += sc[1024 + k] * wv; a2 += sc[2048 + k] * wv; a3 += sc[3072 + k] * wv; a4 += sc[4096 + k] * wv; a5 += sc[5120 + k] * wv; a6 += sc[6144 + k] * wv; a7 += sc[7168 + k] * wv; a8 += sc[8192 + k] * wv; }
        float* rp = red + (kq * 9) * 64 + j;
        rp[0] = a0; rp[64] = a1; rp[128] = a2; rp[192] = a3; rp[256] = a4; rp[320] = a5; rp[384] = a6; rp[448] = a7; rp[512] = a8;
        __syncthreads();
        for (int e = tid; e < 576; e += 512) { const int r = e >> 6, jj = e & 63; float s = p.in(10)[(size_t)l * 6144 + j0 + jj];
            for (int q = 0; q < 8; ++q) s += red[(q * 9 + r) * 64 + jj];
            ((float*)(p.ws() + OFF_MOD))[((size_t)l * 9 + r) * 6144 + j0 + jj] = s; }
        __syncthreads();
    }
    __syncthreads();
}

DI void phase_kbound(const KP p, unsigned char* shm) {
    const int tid = ltid(), lane = tid & 63, wid = tid >> 6; float* red = (float*)shm; float* out = (float*)(p.ws() + OFF_KMAX);
    for (int it = lbid(); it < 64; it += lgdim()) {
        const int l = it >> 5, b = (it >> 2) & 7, hk = it & 3; const int key = tid >> 1, half = tid & 1;
        const float* src = p.in(2) + ((((size_t)b * 2 + l) * 256 + key) * 256) + hk * 64 + half * 32;
        float ss = 0.f;
#pragma unroll
        for (int i = 0; i < 8; ++i) { const f32x4 v = *(const f32x4*)(src + i * 4); ss += v[0] * v[0] + v[1] * v[1] + v[2] * v[2] + v[3] * v[3]; }
        ss += __shfl_xor(ss, 1);
#pragma unroll
        for (int o = 2; o < 64; o <<= 1) ss = fmaxf(ss, __shfl_xor(ss, o));
        if (lane == 0) red[wid] = ss;
        __syncthreads();
        if (tid == 0) { float m = red[0]; for (int w = 1; w < 8; ++w) m = fmaxf(m, red[w]); out[it] = m; }
        __syncthreads();
    }
    if (lbid() == lgdim() - 1 && tid < 2) { float g2 = 0.f; for (int d = 0; d < 64; ++d) { const float g = p.in(21)[tid * 64 + d]; g2 = fmaxf(g2, g * g); } out[64 + tid] = 64.0f * g2; }
}

DI void transpose_tile(const float* src, int N, int k0, int scol0, bf16_t* dst, int ldd, int drow0, float* tile) {
    const int tid = ltid();
#pragma unroll
    for (int i = 0; i < 2; ++i) { const int idx = tid + i * 512, k = idx >> 4, n4 = idx & 15; const f32x4 v = *(const f32x4*)(src + (size_t)(k0 + k) * N + scol0 + n4 * 4);
        float* t = tile + k * 65 + n4 * 4; t[0] = v[0]; t[1] = v[1]; t[2] = v[2]; t[3] = v[3]; }
    __syncthreads();
    { const int n = tid >> 3, kg = tid & 7; float f[8];
#pragma unroll
      for (int j = 0; j < 8; ++j) f[j] = tile[(kg * 8 + j) * 65 + n];
      *(u32x4*)(dst + (size_t)(drow0 + n) * ldd + k0 + kg * 8) = pack8(f); }
    __syncthreads();
}
DI void phase_weights(const KP p, int l, unsigned char* shm) {
    float* tile = (float*)shm; unsigned char* W = p.ws() + OFF_W;
    const int G = lgdim(), c = lbid(); int base = 0;
    auto run = [&](const float* src, int K, int N, bf16_t* dst, int ldd, int mode) {
        const int ntn = N / 64, ntk = K / 64, nt = ntn * ntk;
        int first = (c - base) % G; if (first < 0) first += G;
        for (int ti = first; ti < nt; ti += G) { const int kt = ti / ntn, nn = ti - kt * ntn; const int drow0 = nn * 64; int scol0 = drow0;
            if (mode == 1) { const int j = drow0 >> 8, w = drow0 & 255; scol0 = w < 128 ? 128 * j + w : 3072 + 128 * j + (w - 128); }
            transpose_tile(src, N, kt * 64, scol0, dst, ldd, drow0, tile); }
        base += nt;
    };
    run(p.in(11) + (size_t)l * 1024 * 7680, 1024, 7680, (bf16_t*)(W + W_IN), 1024, 0);
    run(p.in(28) + (size_t)l * 1024 * 6144, 1024, 6144, (bf16_t*)(W + W_UP), 1024, 1);
    run(p.in(31) + (size_t)l * 3072 * 1024, 3072, 1024, (bf16_t*)(W + W_DOWN), 3072, 0);
    run(p.in(24) + (size_t)l * 1024 * 1024, 1024, 1024, (bf16_t*)(W + W_BR), 1024, 0);
    run(p.in(25) + (size_t)l * 1024 * 1024, 1024, 1024, (bf16_t*)(W + W_BR) + (size_t)1024 * 1024, 1024, 0);
    run(p.in(26) + (size_t)l * 1024 * 1024, 1024, 1024, (bf16_t*)(W + W_BR) + (size_t)2 * 1024 * 1024, 1024, 0);
    run(p.in(27) + (size_t)l * 1024 * 1024, 1024, 1024, (bf16_t*)(W + W_O), 1024, 0);
    for (int g = 0; g < 4; ++g) run(p.in(22) + ((size_t)l * 4 + g) * 256 * 256, 256, 256, (bf16_t*)(W + W_POOL) + (size_t)g * 256 * 256, 256, 0);
    bf16_t* wg = (bf16_t*)(W + W_GATE);
    for (int e = lbid() * 512 + ltid(); e < 16 * 2 * 128 * 64; e += lgdim() * 512) {
        const int k = e & 63, col = (e >> 6) & 127, dir = (e >> 13) & 1, n = e >> 14;
        const float* src = (col < 64 ? p.in(15) : p.in(17)) + ((((size_t)l * 2 + dir) * 16 + n) * 64 + k) * 64 + (col & 63);
        wg[e] = (bf16_t)(pk2(*src, 0.f) & 0xffffu);
    }
}

DI void phase_norm(const KP p, int l, bool from_input, const float* gam, int sh_off, int sc_off, bf16_t* dst, bool final_) {
    const int tid_ = ltid(); const int lane = tid_ & 63, wid = tid_ >> 6;
    const float* modl = (const float*)(p.ws() + OFF_MOD) + (size_t)l * 9 * 6144;
    const int stride = lgdim() * 8;
    f32x4 gv[4];
#pragma unroll
    for (int i = 0; i < 4; ++i) gv[i] = *(const f32x4*)(gam + i * 256 + lane * 4);
    for (int mb = lbid() * 8 + wid; mb < MT; mb += 3 * stride) {
        f32x4 xv[3][4]; float ss[3];
#pragma unroll
        for (int r = 0; r < 3; ++r) { const int m = mb + r * stride; ss[r] = 0.f;
            if (m < MT) { const float* xr = from_input ? (m < MCTX ? p.in(0) + (size_t)m * 1024 : p.in(1) + (size_t)(m - MCTX) * 1024) : p.out() + (size_t)m * 1024;
#pragma unroll
                for (int i = 0; i < 4; ++i) xv[r][i] = *(const f32x4*)(xr + i * 256 + lane * 4); }
            else {
#pragma unroll
                for (int i = 0; i < 4; ++i) xv[r][i] = (f32x4){0.f, 0.f, 0.f, 0.f}; } }
#pragma unroll
        for (int r = 0; r < 3; ++r) {
#pragma unroll
            for (int i = 0; i < 4; ++i) ss[r] += xv[r][i][0] * xv[r][i][0] + xv[r][i][1] * xv[r][i][1] + xv[r][i][2] * xv[r][i][2] + xv[r][i][3] * xv[r][i][3];
            ss[r] = wave_sum(ss[r]); }
#pragma unroll
        for (int r = 0; r < 3; ++r) { const int m = mb + r * stride; if (m >= MT) continue;
            const float rs = rsqrtf(ss[r] * (1.0f / 1024.0f) + 1e-6f);
            const float* mr = modl + (size_t)mod_row(m) * 6144;
#pragma unroll
            for (int i = 0; i < 4; ++i) { const int cc = i * 256 + lane * 4;
                if (final_) { f32x4 y = xv[r][i] * rs * gv[i]; *(f32x4*)(p.out() + (size_t)m * 1024 + cc) = y; }
                else { const f32x4 scv = *(const f32x4*)(mr + sc_off + cc), shv = *(const f32x4*)(mr + sh_off + cc);
                    f32x4 y = xv[r][i] * rs * gv[i] * (scv + 1.0f) + shv; u32x2 o; o[0] = pk2(y[0], y[1]); o[1] = pk2(y[2], y[3]);
                    *(u32x2*)(dst + (size_t)m * 1024 + cc) = o;
                    if (from_input) *(f32x4*)(p.out() + (size_t)m * 1024 + cc) = xv[r][i]; }
            }
        }
    }
}

DI void phase_e1_elem(const KP p, int l, unsigned char* shm, int parts = 15) {
    float* tab = (float*)shm;
    const int tid = ltid();
    for (int e = tid; e < 1024; e += 512) { const int pos = e >> 4, j = e & 15; const float inv = exp2f(-(float)j * (13.287712379549449f / 16.0f)); const float ang = (float)pos * inv; tab[2 * e] = __cosf(ang); tab[2 * e + 1] = __sinf(ang); }
    __syncthreads();
    bf16_t* slots = (bf16_t*)(p.ws() + OFF_SLOTS);
    bf16_t* qb = slots + 3 * SLOT_E; bf16_t* kraw = (bf16_t*)(p.ws() + OFF_KRAW); bf16_t* vraw = (bf16_t*)(p.ws() + OFF_VRAW);
    const size_t gtid = (size_t)lbid() * 512 + tid, gsz = (size_t)lgdim() * 512;
    if (parts & 1) {
        auto qk_ptr = [&](size_t e) -> bf16_t* { const int i = (int)(e & 7); const int hh = 16 + (int)((e >> 3) & 3); const int m = (int)(e >> 5);
            return kraw + (size_t)m * 256 + (hh - 16) * 64 + i * 8; };
        auto qk_proc = [&](size_t e, u32x4 rawv, bf16_t* ptr) {
            const int i = (int)(e & 7); const int hh = 16 + (int)((e >> 3) & 3); const int m = (int)(e >> 5); const bool isq = false;
            float x[8]; unpack8(rawv, x);
            float ss = 0.f;
#pragma unroll
            for (int j = 0; j < 8; ++j) ss += x[j] * x[j];
            ss += __shfl_xor(ss, 1); ss += __shfl_xor(ss, 2); ss += __shfl_xor(ss, 4);
            const float rs = rsqrtf(ss * (1.0f / 64.0f) + 1e-6f);
            const float* g = (isq ? p.in(20) : p.in(21)) + l * 64 + i * 8; const f32x4 g0 = *(const f32x4*)g, g1 = *(const f32x4*)(g + 4);
#pragma unroll
            for (int j = 0; j < 4; ++j) { x[j] = x[j] * rs * g0[j]; x[4 + j] = x[4 + j] * rs * g1[j]; }
            const bool lat = m >= MCTX;
            float part[8];
#pragma unroll
            for (int j = 0; j < 8; ++j) part[j] = __shfl_xor(x[j], 2);
            if (lat) { const int t = (m - MCTX) & 1023; const int pos = (i < 4) ? (t >> 6) : (t & 63);
#pragma unroll
                for (int j = 0; j < 8; ++j) { const int jj = (i & 1) * 8 + j; const float cs = tab[2 * (pos * 16 + jj)], sn = tab[2 * (pos * 16 + jj) + 1];
                    x[j] = (i & 2) ? (part[j] * sn + x[j] * cs) : (x[j] * cs - part[j] * sn); }
            } else if (!isq) { float* o = p.out() + OUT_CK + ((((size_t)(m >> 8) * 2 + l) * 256 + (m & 255)) * 256) + (hh - 16) * 64 + i * 8;
                *(f32x4*)o = (f32x4){x[0], x[1], x[2], x[3]}; *(f32x4*)(o + 4) = (f32x4){x[4], x[5], x[6], x[7]}; }
            *(u32x4*)ptr = pack8(x); };
        const size_t N = (size_t)MT * 4 * 8;
        for (size_t e = gtid; e < N; e += 2 * gsz) { const size_t e1 = e + gsz; const bool has1 = e1 < N;
            bf16_t* p0 = qk_ptr(e); bf16_t* p1 = qk_ptr(has1 ? e1 : e);
            const u32x4 r0 = *(const u32x4*)p0, r1 = *(const u32x4*)p1;
            qk_proc(e, r0, p0); if (has1) qk_proc(e1, r1, p1); }
    }
    bf16_t* vT = (bf16_t*)(p.ws() + OFF_VT);
    if (parts & 2)
    for (size_t e = gtid; e < (size_t)MT * 32; e += gsz) {
        int seq, t, grp;
        if (e < (size_t)MCTX * 32) { t = (int)(e & 255); grp = (int)((e >> 8) & 31); seq = (int)(e >> 13); }
        else { const size_t e2 = e - (size_t)MCTX * 32; t = (int)(e2 & 1023); grp = (int)((e2 >> 10) & 31); seq = 16 + (int)(e2 >> 15); }
        const int hk = grp >> 3, dg = grp & 7; const int m = seq < 16 ? seq * 256 + t : MCTX + (seq - 16) * 1024 + t;
        const u32x4 raw = *(const u32x4*)(vraw + (size_t)m * 256 + hk * 64 + dg * 8);
        bf16_t* dstp; int Sk;
        if (seq < 16) { Sk = 256; dstp = vT + ((size_t)(seq * 4 + hk) * 64 + dg * 8) * 256 + t; }
        else { Sk = 1280; dstp = vT + VT_LAT_E + ((size_t)((seq - 16) * 4 + hk) * 64 + dg * 8) * 1280 + 256 + t; }
#pragma unroll
        for (int j = 0; j < 8; ++j) dstp[(size_t)j * Sk] = (bf16_t)((j & 1) ? (raw[j >> 1] >> 16) : (raw[j >> 1] & 0xffffu));
        if (seq < 16) { float f[8]; unpack8(raw, f); float* o = p.out() + OUT_CV + ((((size_t)seq * 2 + l) * 256 + t) * 256) + hk * 64 + dg * 8;
            *(f32x4*)o = (f32x4){f[0], f[1], f[2], f[3]}; *(f32x4*)(o + 4) = (f32x4){f[4], f[5], f[6], f[7]}; }
    }
    bf16_t* ck = (bf16_t*)(p.ws() + OFF_CK);
    if (parts & 4)
    for (size_t e = gtid; e < (size_t)8 * 256 * 32; e += gsz) {
        const int c8 = (int)(e & 31), t = (int)((e >> 5) & 255), b = (int)(e >> 13);
        const float* src = p.in(2) + ((((size_t)b * 2 + l) * 256 + t) * 256) + c8 * 8;
        float f[8]; const f32x4 a = *(const f32x4*)src, bb = *(const f32x4*)(src + 4); f[0] = a[0]; f[1] = a[1]; f[2] = a[2]; f[3] = a[3]; f[4] = bb[0]; f[5] = bb[1]; f[6] = bb[2]; f[7] = bb[3];
        *(u32x4*)(ck + ((size_t)b * 256 + t) * 256 + c8 * 8) = pack8(f);
    }
    if (parts & 4)
    for (size_t e = gtid; e < (size_t)8 * 32 * 256; e += gsz) {
        const int t = (int)(e & 255), grp = (int)((e >> 8) & 31), b = (int)(e >> 13); const int hk = grp >> 3, dg = grp & 7;
        const float* src = p.in(3) + ((((size_t)b * 2 + l) * 256 + t) * 256) + hk * 64 + dg * 8;
        bf16_t* dstp = vT + VT_LAT_E + ((size_t)(b * 4 + hk) * 64 + dg * 8) * 1280 + t;
#pragma unroll
        for (int j = 0; j < 8; ++j) dstp[(size_t)j * 1280] = (bf16_t)(pk2(src[j], 0.f) & 0xffffu);
    }
    const bf16_t* up = slots + 4 * SLOT_E; bf16_t* dd = slots;
    if (parts & 8) {
#define POOL_GROUP(GI, WW) \
        for (size_t e = gtid; e < (size_t)MT * 32; e += gsz) { \
            const int c8 = (GI) * 32 + (int)(e & 31), m = (int)(e >> 5); const int s0 = seq_start(m), S = seq_len(m), t = m - s0; \
            u32x4 rv[WW]; \
            _Pragma("unroll") for (int k = 0; k < (WW); ++k) { int tt = t - (WW) / 2 + k; tt = tt < 0 ? 0 : (tt >= S ? S - 1 : tt); rv[k] = *(const u32x4*)(up + (size_t)(s0 + tt) * 1024 + c8 * 8); } \
            float sum[8] = {0, 0, 0, 0, 0, 0, 0, 0}, self[8]; int cnt = 0; \
            _Pragma("unroll") for (int k = 0; k < (WW); ++k) { const int tt = t - (WW) / 2 + k; const bool ok = tt >= 0 && tt < S; cnt += ok ? 1 : 0; float f[8]; unpack8(rv[k], f); \
                _Pragma("unroll") for (int j = 0; j < 8; ++j) sum[j] += ok ? f[j] : 0.f; } \
            unpack8(rv[(WW) / 2], self); \
            const float inv = 1.0f / (float)cnt; \
            _Pragma("unroll") for (int j = 0; j < 8; ++j) sum[j] = sum[j] * inv - self[j]; \
            *(u32x4*)(dd + (size_t)m * 1024 + c8 * 8) = pack8(sum); }
        POOL_GROUP(0, 2) POOL_GROUP(1, 4) POOL_GROUP(2, 8) POOL_GROUP(3, 16)
#undef POOL_GROUP
    }
}

DI void phase_e2(const KP p, int l, const bf16_t* z, int ntl, int j0, bf16_t* act) {
    const float* cw = p.in(29) + (size_t)l * 3 * 6144; const float* cb = p.in(30) + (size_t)l * 6144;
    const int ldz = ntl * 256;
    const int gtid = lbid() * 512 + ltid(), gsz = lgdim() * 512;
    const int per_m = ntl * 16, rpt = gsz / per_m;
    const int r = gtid % per_m, mrow0 = gtid / per_m; const int jl = r >> 4, cg8 = r & 15;
    if (mrow0 >= rpt) return;
    f32x4 wv[2][4][2];
#pragma unroll
    for (int h = 0; h < 2; ++h) { const int wcol = h * 3072 + (j0 + jl) * 128 + cg8 * 8;
#pragma unroll
        for (int q = 0; q < 2; ++q) { wv[h][0][q] = *(const f32x4*)(cb + wcol + q * 4); wv[h][1][q] = *(const f32x4*)(cw + wcol + q * 4); wv[h][2][q] = *(const f32x4*)(cw + 6144 + wcol + q * 4); wv[h][3][q] = *(const f32x4*)(cw + 2 * 6144 + wcol + q * 4); } }
    const u32x4 zero = (u32x4){0, 0, 0, 0};
    for (int mb = mrow0; mb < MT; mb += 2 * rpt) {
        u32x4 zr[2][2][3];
#pragma unroll
        for (int u = 0; u < 2; ++u) { const int m = mb + u * rpt; const bool ok = m < MT; const int mm = ok ? m : mb;
            const int s0 = seq_start(mm), S = seq_len(mm), t = mm - s0; const bool hp = t > 0, hn = t < S - 1;
#pragma unroll
            for (int h = 0; h < 2; ++h) { const bf16_t* zp = z + (size_t)mm * ldz + jl * 256 + h * 128 + cg8 * 8;
                zr[u][h][0] = hp ? *(const u32x4*)(zp - ldz) : zero; zr[u][h][1] = *(const u32x4*)zp; zr[u][h][2] = hn ? *(const u32x4*)(zp + ldz) : zero; } }
#pragma unroll
        for (int u = 0; u < 2; ++u) { const int m = mb + u * rpt; if (m >= MT) continue;
            float res[2][8];
#pragma unroll
            for (int h = 0; h < 2; ++h) { float z0[8], z1[8], z2[8]; unpack8(zr[u][h][0], z0); unpack8(zr[u][h][1], z1); unpack8(zr[u][h][2], z2);
#pragma unroll
                for (int j = 0; j < 8; ++j) res[h][j] = wv[h][0][j >> 2][j & 3] + wv[h][1][j >> 2][j & 3] * z0[j] + wv[h][2][j >> 2][j & 3] * z1[j] + wv[h][3][j >> 2][j & 3] * z2[j]; }
            float o[8];
#pragma unroll
            for (int j = 0; j < 8; ++j) o[j] = res[0][j] * sigmoidf_(res[0][j]) * res[1][j];
            *(u32x4*)(act + (size_t)m * 3072 + (j0 + jl) * 128 + cg8 * 8) = pack8(o); }
    }
}

DI int crow(int reg, int h) { return (reg & 3) + 8 * (reg >> 2) + 4 * h; }
DI float fsig(float x) { return __builtin_amdgcn_rcpf(1.0f + __builtin_amdgcn_exp2f(-1.4426950408889634f * x)); }
constexpr int L2_XW = 0, L2_SEG = 8 * 16 * 68 * 4, L2_CST = L2_SEG + 8192, L2_CW = L2_CST + 512, L2_WG = L2_CW + 1280, L2_RAW = L2_WG + 128 * 144, L2_END = L2_RAW + 8 * 19 * 64 * 2;
static_assert(L2_END <= 131072, "lds");
template <int DIR>
DI void lru_sweep(const KP p, int l, int seq, int n, unsigned char* shm, bool wet) {
    const int tid = ltid(), lane = tid & 63, wid = tid >> 6, l16 = lane & 15, kg = lane >> 4;
    const int S = seq < 16 ? 256 : 1024, m0 = seq < 16 ? seq * 256 : MCTX + (seq - 16) * 1024, nst = S >> 7;
    bf16_t* slots = (bf16_t*)(p.ws() + OFF_SLOTS);
    const bf16_t* xr = slots + 1 * SLOT_E + n * 64; const bf16_t* yv = slots + 2 * SLOT_E + n * 64; bf16_t* yo = slots + 4 * SLOT_E + n * 64;
    float* xw = (float*)(shm + L2_XW) + wid * 16 * 68; float* segs = (float*)(shm + L2_SEG); float* cst = (float*)(shm + L2_CST);
    bf16_t* wgl = (bf16_t*)(shm + L2_WG);
    { const bf16_t* wg = (const bf16_t*)(p.ws() + OFF_W + W_GATE) + ((size_t)n * 2 + DIR) * 128 * 64;
#pragma unroll
      for (int i = 0; i < 2; ++i) { const int pc = tid + i * 512, col = pc >> 3, part = pc & 7; *(u32x4*)(wgl + col * 72 + part * 8) = *(const u32x4*)(wg + col * 64 + part * 8); } }
    float br[4], bi[4], ls8[4];
#pragma unroll
    for (int cq = 0; cq < 4; ++cq) { const size_t o = ((size_t)l * 2 + DIR) * 1024 + n * 64 + cq * 16 + l16; br[cq] = p.in(16)[o]; bi[cq] = p.in(18)[o];
        ls8[cq] = -8.0f * 1.4426950408889634f * log1pf(expf(-p.in(19)[o])); }
    const float w0 = p.in(13)[((size_t)l * 4 + 0) * 1024 + n * 64 + lane], w1 = p.in(13)[((size_t)l * 4 + 1) * 1024 + n * 64 + lane], w2 = p.in(13)[((size_t)l * 4 + 2) * 1024 + n * 64 + lane],
                w3 = p.in(13)[((size_t)l * 4 + 3) * 1024 + n * 64 + lane], wb = p.in(14)[(size_t)l * 1024 + n * 64 + lane];
    if (tid < 64) cst[tid] = seq < 16 ? 0.f : p.in(4)[(((size_t)(seq - 16) * 2 + l) * 2 + DIR) * 1024 + n * 64 + tid];
    __syncthreads();
    bf16_t* rawt = (bf16_t*)(shm + L2_RAW) + wid * 19 * 64;
    u32x4 rr[3];
    auto load_raw = [&](int base) {
#pragma unroll
        for (int i = 0; i < 3; ++i) { const int pc = lane + i * 64, r = pc >> 3, part = pc & 7; const int tt = base + wid * 16 - 1 + r; rr[i] = (u32x4){0, 0, 0, 0};
            if (pc < 152 && tt >= 0 && tt < S) rr[i] = *(const u32x4*)(xr + (size_t)(m0 + tt) * 1024 + part * 8); } };
    load_raw(DIR == 0 ? 0 : (nst - 1) * 128);
#pragma unroll 1
    for (int s = 0; s < nst; ++s) {
        const int base = (DIR == 0 ? s : nst - 1 - s) * 128; const int par = s & 1;
        u32x4 yv4[2], tv4[2];
#pragma unroll
        for (int i = 0; i < 2; ++i) { const int pc = lane + i * 64; const size_t o = (size_t)(m0 + base + wid * 16 + (pc >> 3)) * 1024 + (pc & 7) * 8;
            yv4[i] = *(const u32x4*)(yv + o); tv4[i] = DIR == 1 ? *(const u32x4*)(yo + o) : (u32x4){0, 0, 0, 0}; }
#pragma unroll
        for (int i = 0; i < 3; ++i) { const int pc = lane + i * 64; if (pc < 152) *(u32x4*)(rawt + pc * 8) = rr[i]; }
        { float xf[19];
#pragma unroll
          for (int r = 0; r < 19; ++r) xf[r] = bflo((unsigned)rawt[r * 64 + lane]);
#pragma unroll
          for (int tk = 0; tk < 16; ++tk) xw[tk * 68 + lane] = wb + w0 * xf[tk] + w1 * xf[tk + 1] + w2 * xf[tk + 2] + w3 * xf[tk + 3]; }
        if (s + 1 < nst) load_raw((DIR == 0 ? s + 1 : nst - 2 - s) * 128);
        bf16x8 Af[2];
#pragma unroll
        for (int ks = 0; ks < 2; ++ks) { const f32x4 a0 = *(const f32x4*)(xw + l16 * 68 + ks * 32 + kg * 8), a1 = *(const f32x4*)(xw + l16 * 68 + ks * 32 + kg * 8 + 4);
            u32x4 pk; pk[0] = pk2(a0[0], a0[1]); pk[1] = pk2(a0[2], a0[3]); pk[2] = pk2(a1[0], a1[1]); pk[3] = pk2(a1[2], a1[3]); Af[ks] = __builtin_bit_cast(bf16x8, pk); }
        float hh[4][4], pp[4][4], Pl[4], Hl[4];
#pragma unroll
        for (int cq = 0; cq < 4; ++cq) { f32x4 ar = (f32x4){0.f, 0.f, 0.f, 0.f}, ai = (f32x4){0.f, 0.f, 0.f, 0.f};
#pragma unroll
            for (int ks = 0; ks < 2; ++ks) { const bf16x8 Br = *(const bf16x8*)(wgl + (cq * 16 + l16) * 72 + ks * 32 + kg * 8), Bi = *(const bf16x8*)(wgl + ((4 + cq) * 16 + l16) * 72 + ks * 32 + kg * 8);
                ar = __builtin_amdgcn_mfma_f32_16x16x32_bf16(Af[ks], Br, ar, 0, 0, 0); ai = __builtin_amdgcn_mfma_f32_16x16x32_bf16(Af[ks], Bi, ai, 0, 0, 0); }
            float H = 0.f, P = 1.f;
#pragma unroll
            for (int jj = 0; jj < 4; ++jj) { const int i = DIR == 0 ? jj : 3 - jj;
                const float r = fsig(ar[i] + br[cq]), ig = fsig(ai[i] + bi[cq]), x = xw[(kg * 4 + i) * 68 + cq * 16 + l16];
                const float a = __builtin_amdgcn_exp2f(r * ls8[cq]); const float u = __builtin_amdgcn_sqrtf(fmaf(-a, a, 1.0f)) * ig * x; H = fmaf(a, H, u); P *= a; hh[cq][i] = H; pp[cq][i] = P; }
            Pl[cq] = P; Hl[cq] = H; }
        float Pe[4], He[4];
#pragma unroll
        for (int cq = 0; cq < 4; ++cq) {
#pragma unroll
            for (int d = 1; d <= 2; d <<= 1) { const int src = (DIR == 0 ? lane - 16 * d : lane + 16 * d) & 63; const bool ok = DIR == 0 ? kg >= d : kg <= 3 - d;
                const float Pp = __shfl(Pl[cq], src), Hp = __shfl(Hl[cq], src);
                if (ok) { Hl[cq] = fmaf(Pl[cq], Hp, Hl[cq]); Pl[cq] *= Pp; } }
            const int src = (DIR == 0 ? lane - 16 : lane + 16) & 63; const bool ok = DIR == 0 ? kg >= 1 : kg <= 2;
            const float Pp = __shfl(Pl[cq], src), Hp = __shfl(Hl[cq], src); Pe[cq] = ok ? Pp : 1.0f; He[cq] = ok ? Hp : 0.0f; }
        if (kg == (DIR == 0 ? 3 : 0)) {
#pragma unroll
            for (int cq = 0; cq < 4; ++cq) { float* sp = segs + ((par * 8 + wid) * 64 + cq * 16 + l16) * 2; sp[0] = Pl[cq]; sp[1] = Hl[cq]; } }
        __syncthreads();
        float cwl = cst[par * 64 + lane];
        { float sP[8], sH[8];
#pragma unroll
          for (int w2 = 0; w2 < 8; ++w2) { const f32x2_t v = *(const f32x2_t*)(segs + ((par * 8 + w2) * 64 + lane) * 2); sP[w2] = v[0]; sH[w2] = v[1]; }
#pragma unroll
          for (int jj = 0; jj < 8; ++jj) { const int w2 = DIR == 0 ? jj : 7 - jj; const bool before = DIR == 0 ? w2 < wid : w2 > wid; if (before) cwl = fmaf(sP[w2], cwl, sH[w2]); } }
#pragma unroll
        for (int cq = 0; cq < 4; ++cq) { const int c = cq * 16 + l16; const float cwv = __shfl(cwl, c);
            const float cl = fmaf(Pe[cq], cwv, He[cq]);
#pragma unroll
            for (int i = 0; i < 4; ++i) hh[cq][i] = fmaf(pp[cq][i], cl, hh[cq][i]);
            if (wid == (DIR == 0 ? 7 : 0) && kg == (DIR == 0 ? 3 : 0)) cst[(par ^ 1) * 64 + c] = hh[cq][DIR == 0 ? 3 : 0];
#pragma unroll
            for (int i = 0; i < 4; ++i) xw[(kg * 4 + i) * 68 + c] = hh[cq][i];
        }
#pragma unroll
        for (int i = 0; i < 2; ++i) { const int pc = lane + i * 64, tk = pc >> 3, part = pc & 7; const f32x4 h0 = *(const f32x4*)(xw + tk * 68 + part * 8), h1 = *(const f32x4*)(xw + tk * 68 + part * 8 + 4);
            float y[8], t[8], o[8]; unpack8(yv4[i], y); unpack8(tv4[i], t);
#pragma unroll
            for (int e = 0; e < 4; ++e) { o[e] = fmaf(h0[e], y[e], t[e]); o[4 + e] = fmaf(h1[e], y[4 + e], t[4 + e]); }
            if (wet) *(u32x4*)(yo + (size_t)(m0 + base + wid * 16 + tk) * 1024 + part * 8) = pack8(o); }
    }
    __syncthreads();
    if (wet && seq < 16 && tid < 64) p.out()[OUT_ST + (((size_t)seq * 2 + l) * 2 + DIR) * 1024 + n * 64 + tid] = cst[(nst & 1) * 64 + tid];
    __syncthreads();
}
DI void lru_item(const KP p, int l, int seq, int n, unsigned char* shm, bool wet = true) {
    __syncthreads();
    lru_sweep<0>(p, l, seq, n, shm, wet);
    lru_sweep<1>(p, l, seq, n, shm, wet);
}

DI void attn_item(const KP p, int l, int seq, int hk, int qb, unsigned char* shm, bool wet = true) {
    const int tid = ltid(), lane = tid & 63, wid = tid >> 6, h = lane >> 5, l32 = lane & 31;
    const bool lat = seq >= 16; const int m0 = lat ? MCTX + (seq - 16) * 1024 : seq * 256; const int Sk = lat ? 1280 : 256, nt = Sk >> 6;
    bf16_t* slots = (bf16_t*)(p.ws() + OFF_SLOTS); bf16_t* qbuf = slots + 3 * SLOT_E;
    const bf16_t* kraw = (const bf16_t*)(p.ws() + OFF_KRAW); const bf16_t* ck = (const bf16_t*)(p.ws() + OFF_CK);
    const bf16_t* vT = (const bf16_t*)(p.ws() + OFF_VT) + (lat ? VT_LAT_E + (size_t)((seq - 16) * 4 + hk) * 64 * 1280 : (size_t)(seq * 4 + hk) * 64 * 256);
    bf16_t* Kt = (bf16_t*)shm; bf16_t* Vt = (bf16_t*)(shm + 4 * 9216);
    const int head = hk * 4 + (wid >> 1); const int mq = m0 + qb * 64 + (wid & 1) * 32 + l32;
    bf16x8 Qf[4];
    { float qv[4][8]; float ss = 0.f;
#pragma unroll
      for (int ks = 0; ks < 4; ++ks) { unpack8(*(const u32x4*)(qbuf + (size_t)mq * 1024 + head * 64 + ks * 16 + h * 8), qv[ks]);
#pragma unroll
          for (int j = 0; j < 8; ++j) ss += qv[ks][j] * qv[ks][j]; }
      ss += __shfl_xor(ss, 32);
      const float rs = rsqrtf(ss * (1.0f / 64.0f) + 1e-6f);
      const float* gq = p.in(20) + l * 64 + h * 8;
#pragma unroll
      for (int ks = 0; ks < 4; ++ks) { const f32x4 g0 = *(const f32x4*)(gq + ks * 16), g1 = *(const f32x4*)(gq + ks * 16 + 4);
#pragma unroll
          for (int j = 0; j < 4; ++j) { qv[ks][j] *= rs * g0[j]; qv[ks][4 + j] *= rs * g1[j]; } }
      if (lat) { const int t = mq - m0;
#pragma unroll
          for (int j = 0; j < 8; ++j) { const float inv = exp2f(-(float)(h * 8 + j) * (13.287712379549449f / 16.0f));
              const float ar = (float)(t >> 6) * inv, ac = (float)(t & 63) * inv; const float cr = __cosf(ar), sr = __sinf(ar), cc = __cosf(ac), sc = __sinf(ac);
              const float a1 = qv[0][j], a2 = qv[1][j], b1 = qv[2][j], b2 = qv[3][j];
              qv[0][j] = a1 * cr - a2 * sr; qv[1][j] = a1 * sr + a2 * cr; qv[2][j] = b1 * cc - b2 * sc; qv[3][j] = b1 * sc + b2 * cc; } }
#pragma unroll
      for (int ks = 0; ks < 4; ++ks) Qf[ks] = __builtin_bit_cast(bf16x8, pack8(qv[ks])); }
    float offs;
    { float qq = 0.f;
#pragma unroll
      for (int ks = 0; ks < 4; ++ks)
#pragma unroll
          for (int j = 0; j < 8; ++j) { const float v = __uint_as_float(((unsigned)(unsigned short)Qf[ks][j]) << 16); qq += v * v; }
      qq += __shfl_xor(qq, 32);
      const float* kb = (const float*)(p.ws() + OFF_KMAX); float kmx = kb[64 + l]; if (lat) kmx = fmaxf(kmx, kb[(l * 8 + (seq - 16)) * 4 + hk]);
      offs = 1.01f * 0.125f * 1.4426950408889634f * sqrtf(qq * kmx); }
    const int lr = tid >> 3, lp = tid & 7;
    auto kaddr = [&](int kt) -> const bf16_t* { if (lat) { return kt < 4 ? ck + ((size_t)(seq - 16) * 256 + kt * 64 + lr) * 256 + hk * 64 + lp * 8 : kraw + (size_t)(m0 + (kt - 4) * 64 + lr) * 256 + hk * 64 + lp * 8; }
                                                  return kraw + (size_t)(m0 + kt * 64 + lr) * 256 + hk * 64 + lp * 8; };
    u32x4 kA = *(const u32x4*)kaddr(0), vA = *(const u32x4*)(vT + (size_t)lr * Sk + lp * 8);
    u32x4 kB = *(const u32x4*)kaddr(1), vB = *(const u32x4*)(vT + (size_t)lr * Sk + 64 + lp * 8);
    f32x16 O0, O1;
#pragma unroll
    for (int r = 0; r < 16; ++r) { O0[r] = 0.f; O1[r] = 0.f; }
    float lrun = 0.f; const float cs = 0.125f * 1.4426950408889634f;
    auto compute = [&](const bf16_t* Kb, const bf16_t* Vb) {
        f32x16 st0, st1;
#pragma unroll
        for (int r = 0; r < 16; ++r) { st0[r] = 0.f; st1[r] = 0.f; }
        bf16x8 ka[4][2];
#pragma unroll
        for (int ks = 0; ks < 4; ++ks) { ka[ks][0] = *(const bf16x8*)(Kb + (l32) * 72 + ks * 16 + h * 8); ka[ks][1] = *(const bf16x8*)(Kb + (32 + l32) * 72 + ks * 16 + h * 8); }
        __builtin_amdgcn_s_setprio(1);
#pragma unroll
        for (int ks = 0; ks < 4; ++ks) { st0 = __builtin_amdgcn_mfma_f32_32x32x16_bf16(ka[ks][0], Qf[ks], st0, 0, 0, 0); st1 = __builtin_amdgcn_mfma_f32_32x32x16_bf16(ka[ks][1], Qf[ks], st1, 0, 0, 0); }
        __builtin_amdgcn_s_setprio(0);
        float psum = 0.f;
#pragma unroll
        for (int r = 0; r < 16; ++r) { const float p0 = __builtin_amdgcn_exp2f(fmaf(st0[r], cs, -offs)), p1 = __builtin_amdgcn_exp2f(fmaf(st1[r], cs, -offs)); st0[r] = p0; st1[r] = p1; psum += p0 + p1; }
        lrun += psum;
#pragma unroll
        for (int kb = 0; kb < 2; ++kb)
#pragma unroll
            for (int s = 0; s < 2; ++s) {
                u32x4 pb;
                if (kb == 0) { pb[0] = pk2(st0[8 * s + 0], st0[8 * s + 1]); pb[1] = pk2(st0[8 * s + 2], st0[8 * s + 3]); pb[2] = pk2(st0[8 * s + 4], st0[8 * s + 5]); pb[3] = pk2(st0[8 * s + 6], st0[8 * s + 7]); }
                else { pb[0] = pk2(st1[8 * s + 0], st1[8 * s + 1]); pb[1] = pk2(st1[8 * s + 2], st1[8 * s + 3]); pb[2] = pk2(st1[8 * s + 4], st1[8 * s + 5]); pb[3] = pk2(st1[8 * s + 6], st1[8 * s + 7]); }
                const bf16x8 Pb = __builtin_bit_cast(bf16x8, pb);
                { const bf16_t* vp = Vb + (l32) * 68 + kb * 32 + 16 * s + 4 * h; const u32x2 v0 = *(const u32x2*)vp, v1 = *(const u32x2*)(vp + 8); u32x4 va; va[0] = v0[0]; va[1] = v0[1]; va[2] = v1[0]; va[3] = v1[1];
                  O0 = __builtin_amdgcn_mfma_f32_32x32x16_bf16(__builtin_bit_cast(bf16x8, va), Pb, O0, 0, 0, 0); }
                { const bf16_t* vp = Vb + (32 + l32) * 68 + kb * 32 + 16 * s + 4 * h; const u32x2 v0 = *(const u32x2*)vp, v1 = *(const u32x2*)(vp + 8); u32x4 va; va[0] = v0[0]; va[1] = v0[1]; va[2] = v1[0]; va[3] = v1[1];
                  O1 = __builtin_amdgcn_mfma_f32_32x32x16_bf16(__builtin_bit_cast(bf16x8, va), Pb, O1, 0, 0, 0); }
            }
    };
#pragma unroll 1
    for (int it = 0; it < (nt >> 1); ++it) {
        const int sb = (it & 1) * 2; bf16_t* K0 = Kt + sb * 4608; bf16_t* K1 = K0 + 4608; bf16_t* V0 = Vt + sb * 4352; bf16_t* V1 = V0 + 4352;
        *(u32x4*)(K0 + lr * 72 + lp * 8) = kA; *(u32x4*)(K1 + lr * 72 + lp * 8) = kB;
        { u32x2 w0, w1; w0[0] = vA[0]; w0[1] = vA[1]; w1[0] = vA[2]; w1[1] = vA[3]; *(u32x2*)(V0 + lr * 68 + lp * 8) = w0; *(u32x2*)(V0 + lr * 68 + lp * 8 + 4) = w1; }
        { u32x2 w0, w1; w0[0] = vB[0]; w0[1] = vB[1]; w1[0] = vB[2]; w1[1] = vB[3]; *(u32x2*)(V1 + lr * 68 + lp * 8) = w0; *(u32x2*)(V1 + lr * 68 + lp * 8 + 4) = w1; }
        __syncthreads();
        const int kt = it * 2;
        if (kt + 2 < nt) { kA = *(const u32x4*)kaddr(kt + 2); vA = *(const u32x4*)(vT + (size_t)lr * Sk + (kt + 2) * 64 + lp * 8);
                           kB = *(const u32x4*)kaddr(kt + 3); vB = *(const u32x4*)(vT + (size_t)lr * Sk + (kt + 3) * 64 + lp * 8); }
        compute(K0, V0);
        compute(K1, V1);
    }
    const float ltot = lrun + __shfl_xor(lrun, 32); const float inv = 1.0f / ltot;
    if (wet)
#pragma unroll
    for (int rg = 0; rg < 4; ++rg) { const int d = 8 * rg + 4 * h; u32x2 o;
        o[0] = pk2(O0[4 * rg] * inv, O0[4 * rg + 1] * inv); o[1] = pk2(O0[4 * rg + 2] * inv, O0[4 * rg + 3] * inv); *(u32x2*)(qbuf + (size_t)mq * 1024 + head * 64 + d) = o;
        o[0] = pk2(O1[4 * rg] * inv, O1[4 * rg + 1] * inv); o[1] = pk2(O1[4 * rg + 2] * inv, O1[4 * rg + 3] * inv); *(u32x2*)(qbuf + (size_t)mq * 1024 + head * 64 + 32 + d) = o; }
    __syncthreads();
}

__global__ void __launch_bounds__(512) mega(Params p_unused) {
    KP p = fresh_kp();
    extern __shared__ __attribute__((aligned(16))) unsigned char shm[];
    cg::grid_group grid = cg::this_grid();
    LAS unsigned char* lds = (LAS unsigned char*)shm;
    bf16_t* slots = (bf16_t*)(p.ws() + OFF_SLOTS); unsigned char* W = p.ws() + OFF_W;
    const int G = lgdim(), c = lbid();
    if (lbid() < 0) grid.sync();
    gbar_post(p, shm);
    phase_mod(p, shm);
    phase_kbound(p, shm);
    phase_weights(p, 0, shm);
#if EXP == 5
    phase_mod(p, shm); phase_weights(p, 0, shm);
#endif
    gbar(p, shm); p = fresh_kp();
#pragma unroll 1
    for (int l = 0; l < 2; ++l) {
        const float* modl = (const float*)(p.ws() + OFF_MOD) + (size_t)l * 9 * 6144;
        phase_norm(p, l, l == 0, p.in(7) + l * 1024, 0, 1024, slots, false);
        if (l == 1) phase_weights(p, 1, shm);
#if EXP == 5
        if (l == 1) phase_weights(p, 1, shm);
#endif
#if EXP == 7
        phase_norm(p, l, l == 0, p.in(7) + l * 1024, 0, 1024, slots, false);
#endif
#if EXP == 1
        for (int r = 0; r < 12; ++r) gbar(p, shm);
#endif
        gbar(p, shm); p = fresh_kp();
        { pg8::Gemm g{slots, (const bf16_t*)(W + W_IN), 1024, 1024, 1024, 48, 30, 1, 0, 0, 0, 0, 0};
          EpiInProj E{slots, (bf16_t*)(p.ws() + OFF_KRAW), (bf16_t*)(p.ws() + OFF_VRAW), p.in(12) + (size_t)l * 3072};
          pg8::gemm_phase(lds, g, E);
#if EXP == 4
          __syncthreads(); pg8::gemm_phase(lds, g, E);
#endif
        }
        gbar(p, shm); p = fresh_kp();
        phase_e1_elem(p, l, shm);
#if EXP == 8
        __syncthreads(); phase_e1_elem(p, l, shm, 14);
#endif
        gbar(p, shm); p = fresh_kp();
        { pg8::Gemm g{slots, (const bf16_t*)(W + W_POOL), 1024, 256, 256, 48, 4, 1, 0, 256, 0, 0, 0};
          EpiScaleBf16 E{slots, 1024, 0, p.in(23) + (size_t)l * 1024};
          if (G != 256) pg8::gemm_phase(lds, g, E); else if (c >= 128) pg8::gemm_phase(lds, g, E, 128, c - 128); }
        __syncthreads();
#if EXP == 3
        { const bool dry = lbid() < 0;
          if (c < 128) lru_item(p, l, 16 + (c >> 4), c & 15, shm, dry); else { for (int k = 0; k < 2; ++k) { const int it = (c - 128) * 2 + k; lru_item(p, l, it >> 4, it & 15, shm, dry); } } }
#endif
        if (G == 256) { if (c < 128) lru_item(p, l, 16 + (c >> 4), c & 15, shm); else { for (int k = 0; k < 2; ++k) { const int it = (c - 128) * 2 + k; lru_item(p, l, it >> 4, it & 15, shm); } } }
        else for (int it = c; it < 384; it += G) { if (it < 128) lru_item(p, l, 16 + (it >> 4), it & 15, shm); else lru_item(p, l, (it - 128) >> 4, (it - 128) & 15, shm); }
        if (G == 256) {
            for (int it = c; it < 512; it += 256) attn_item(p, l, 16 + (it >> 6), (it >> 4) & 3, it & 15, shm);
            if (c >= 128) for (int k = 0; k < 2; ++k) { const int j = (c - 128) * 2 + k; attn_item(p, l, j >> 4, (j >> 2) & 3, j & 3, shm); }
        } else
        for (int it = c; it < 768; it += G) { if (it < 512) attn_item(p, l, 16 + (it >> 6), (it >> 4) & 3, it & 15, shm); else { const int j = it - 512; attn_item(p, l, j >> 4, (j >> 2) & 3, j & 3, shm); } }
        gbar(p, shm); p = fresh_kp();
        { pg8::Gemm g{slots + 4 * SLOT_E, (const bf16_t*)(W + W_BR), 1024, 1024, 1024, 48, 4, 1, 0, 0, -(long)SLOT_E, -4 * (long)SLOT_E, (long)1024 * 1024};
          EpiMerge E{slots + 5 * SLOT_E, false};
#if EXP == 9
          { EpiMerge E2{slots + 5 * SLOT_E, lbid() >= 0}; pg8::gemm_phase(lds, g, E2); __syncthreads(); }
#endif
          pg8::gemm_phase(lds, g, E); }
        gbar(p, shm); p = fresh_kp();
        { pg8::Gemm g{slots + 7 * SLOT_E, (const bf16_t*)(W + W_O), 1024, 1024, 1024, 48, 4, 1, 0, 0, 0, 0, 0};
          EpiResid E{p.out(), modl, 2048, false};
#if EXP == 10
          { EpiResid E2{p.out(), modl, 2048, lbid() >= 0}; pg8::gemm_phase(lds, g, E2); __syncthreads(); }
#endif
          pg8::gemm_phase(lds, g, E); }
        gbar(p, shm); p = fresh_kp();
        phase_norm(p, l, false, p.in(8) + l * 1024, 3072, 4096, slots, false);
        gbar(p, shm); p = fresh_kp();
        { pg8::Gemm g{slots, (const bf16_t*)(W + W_UP), 1024, 1024, 1024, 48, 24, 1, 0, 0, 0, 0, 0};
          float* zedge = (float*)(slots + 1 * SLOT_E); float* zpart = zedge + (size_t)192 * 2 * 6144;
          EpiUpFused E{slots + 5 * SLOT_E, zedge, zpart, p.in(29) + (size_t)l * 3 * 6144, p.in(30) + (size_t)l * 6144};
          pg8::gemm_phase(lds, g, E); }
        gbar(p, shm); p = fresh_kp();
        { pg8::Gemm g{slots + 5 * SLOT_E, (const bf16_t*)(W + W_DOWN), 3072, 3072, 3072, 48, 4, 1, 0, 0, 0, 0, 0};
          { Unit u0; if (pg8::next_unit(g, 0, G, c, u0)) { const float* zedge = (const float*)(slots + 1 * SLOT_E);
              ffn_fixup(u0.pm, slots + 5 * SLOT_E, zedge, zedge + (size_t)192 * 2 * 6144, p.in(29) + (size_t)l * 3 * 6144, p.in(30) + (size_t)l * 6144); } }
          EpiResid E{p.out(), modl, 5120, false};
#if EXP == 10
          { EpiResid E2{p.out(), modl, 5120, lbid() >= 0}; pg8::gemm_phase(lds, g, E2); __syncthreads(); }
#endif
          pg8::gemm_phase(lds, g, E); }
        gbar(p, shm); p = fresh_kp();
    }
    phase_norm(p, 0, false, p.in(32), 0, 0, nullptr, true);
}

extern "C" void kernel_launch(void* const* d_in, const int* in_sizes, int n_in, void* d_out, int out_size, void* d_ws, size_t ws_size, hipStream_t stream) {
    static int grid_blocks = 0;
    if (!grid_blocks) {
        int dev = 0, cus = 0, per_cu = 0;
        (void)hipGetDevice(&dev);
        (void)hipDeviceGetAttribute(&cus, hipDeviceAttributeMultiprocessorCount, dev);
        if (hipFuncSetAttribute((const void*)mega, hipFuncAttributeMaxDynamicSharedMemorySize, LDS_BYTES) != hipSuccess) { fprintf(stderr, "setattr failed\n"); return; }
        if (hipOccupancyMaxActiveBlocksPerMultiprocessor(&per_cu, (const void*)mega, 512, LDS_BYTES) != hipSuccess || per_cu < 1) { fprintf(stderr, "occupancy query failed\n"); return; }
        grid_blocks = cus;
    }
    if (ws_size < WS_NEED || n_in < 33) { fprintf(stderr, "workspace too small: %zu < %zu\n", ws_size, (size_t)WS_NEED); return; }
    Params p{};
    for (int i = 0; i < 33; ++i) p.in[i] = (const float*)d_in[i];
    p.out = (float*)d_out; p.ws = (unsigned char*)d_ws;
    (void)hipMemsetAsync((unsigned char*)d_ws + OFF_BAR, 0, (size_t)XCD_BAR_WORDS * 4 + 256 * 4, stream);
    void* args[] = {&p};
    hipError_t e = hipLaunchCooperativeKernel((void*)mega, dim3(grid_blocks), dim3(512), args, LDS_BYTES, stream);
    if (e != hipSuccess) fprintf(stderr, "cooperative launch failed: %s (grid %d)\n", hipGetErrorString(e), grid_blocks);
}
```

```cpp
#include <hip/hip_runtime.h>
#include <hip/hip_cooperative_groups.h>
#include <cstdio>
namespace cg = cooperative_groups;

#define LAS __attribute__((address_space(3)))
#define DI __device__ __forceinline__
typedef unsigned short bf16_t;
typedef short bf16x8 __attribute__((ext_vector_type(8)));
typedef float f32x4 __attribute__((ext_vector_type(4)));
typedef float f32x16 __attribute__((ext_vector_type(16)));
typedef unsigned u32x4 __attribute__((ext_vector_type(4)));
typedef unsigned u32x2 __attribute__((ext_vector_type(2)));
typedef float f32x2_t __attribute__((ext_vector_type(2)));
typedef __bf16 bfx2 __attribute__((ext_vector_type(2)));

constexpr int MT = 12288, MCTX = 4096, DM = 1024;
constexpr size_t SLOT_E = (size_t)MT * 1024;
constexpr size_t SLOT_B = SLOT_E * 2;
constexpr size_t OFF_SLOTS = 0;
constexpr size_t OFF_KRAW = 8 * SLOT_B;
constexpr size_t OFF_VRAW = OFF_KRAW + (size_t)MT * 256 * 2;
constexpr size_t OFF_CK = OFF_VRAW + (size_t)MT * 256 * 2;
constexpr size_t OFF_VT = OFF_CK + (size_t)8 * 256 * 256 * 2;
constexpr size_t VT_LAT_E = (size_t)16 * 4 * 64 * 256;
constexpr size_t OFF_W = OFF_VT + ((size_t)16 * 4 * 64 * 256 + (size_t)8 * 4 * 64 * 1280) * 2;
constexpr size_t W_IN = 0, W_BR = W_IN + (size_t)7680 * 1024 * 2, W_O = W_BR + (size_t)3 * 1024 * 1024 * 2, W_UP = W_O + (size_t)1024 * 1024 * 2,
                 W_DOWN = W_UP + (size_t)6144 * 1024 * 2, W_POOL = W_DOWN + (size_t)1024 * 3072 * 2, W_GATE = W_POOL + (size_t)1024 * 256 * 2, W_END = W_GATE + (size_t)16 * 2 * 128 * 64 * 2;
constexpr size_t OFF_MOD = OFF_W + W_END;
constexpr size_t OFF_BAR = OFF_MOD + (size_t)2 * 9 * 6144 * 4;
constexpr int XCD_BAR_WORDS = 3456;
constexpr size_t OFF_KMAX = OFF_BAR + (size_t)XCD_BAR_WORDS * 4;
constexpr size_t OFF_CNT = OFF_KMAX + 256 * 4;
constexpr size_t OFF_RSS = OFF_CNT + 256 * 4;
constexpr size_t WS_NEED = OFF_RSS + (size_t)MT * 16 * 4;
#ifndef EXP
#define EXP 0
#endif
constexpr int LDS_BYTES = 131072 + 16 + 4096;
constexpr size_t OUT_CK = (size_t)MT * 1024, OUT_CV = OUT_CK + (size_t)16 * 2 * 256 * 256, OUT_ST = OUT_CV + (size_t)16 * 2 * 256 * 256;

struct Params { const float* in[33]; float* out; unsigned char* ws; };
typedef const __attribute__((address_space(4))) unsigned char* kptr_t;
struct KP { kptr_t k;
    DI const float* in(int i) const { return *(const float* const __attribute__((address_space(4)))*)(k + 8 * i); }
    DI float* out() const { return *(float* const __attribute__((address_space(4)))*)(k + 8 * 33); }
    DI unsigned char* ws() const { return *(unsigned char* const __attribute__((address_space(4)))*)(k + 8 * 34); } };
DI KP fresh_kp() { kptr_t k = (kptr_t)__builtin_amdgcn_kernarg_segment_ptr(); asm volatile("" : "+s"(k)); KP p; p.k = k; return p; }
DI int ltid() { int t = threadIdx.x; asm volatile("" : "+v"(t)); return t; }
DI int lbid() { int t = blockIdx.x; asm volatile("" : "+s"(t)); return t; }
DI int lgdim() { int t = gridDim.x; asm volatile("" : "+s"(t)); return t; }

DI unsigned pk2(float a, float b) { bfx2 v; v[0] = (__bf16)a; v[1] = (__bf16)b; return __builtin_bit_cast(unsigned, v); }
DI float bflo(unsigned u) { return __uint_as_float(u << 16); }
DI float bfhi(unsigned u) { return __uint_as_float(u & 0xffff0000u); }
DI void unpack8(u32x4 v, float* f) { f[0] = bflo(v[0]); f[1] = bfhi(v[0]); f[2] = bflo(v[1]); f[3] = bfhi(v[1]); f[4] = bflo(v[2]); f[5] = bfhi(v[2]); f[6] = bflo(v[3]); f[7] = bfhi(v[3]); }
DI u32x4 pack8(const float* f) { u32x4 r; r[0] = pk2(f[0], f[1]); r[1] = pk2(f[2], f[3]); r[2] = pk2(f[4], f[5]); r[3] = pk2(f[6], f[7]); return r; }
DI float sigmoidf_(float x) { return __builtin_amdgcn_rcpf(1.0f + __builtin_amdgcn_exp2f(-1.4426950408889634f * x)); }
DI float gelu_tanh(float x) { const float z = 0.7978845608028654f * (x + 0.044715f * x * x * x); return x * sigmoidf_(2.0f * z); }
DI int seq_start(int m) { return m < MCTX ? (m & ~255) : (MCTX + ((m - MCTX) & ~1023)); }
DI int seq_len(int m) { return m < MCTX ? 256 : 1024; }
DI int mod_row(int m) { return m < MCTX ? 0 : 1 + ((m - MCTX) >> 10); }

namespace pg8 {
constexpr int BM = 256, BK = 64, HALF = 128, HTB = HALF * BK * 2, STAGE_BYTES = 8 * HTB, NXCD = 8, WGM = 8;
DI int lds_byte(int r, int c) { const int st = (r >> 4) * 2 + (c >> 5), rr = r & 15, cc = c & 31, ob = rr * 64 + cc * 2; return st * 1024 + (ob ^ (((ob >> 9) & 1) << 5)); }
DI void stage_rc(int b, int& R, int& C) { const int st = b / 1024, sb = b % 1024, swz = sb ^ (((sb >> 9) & 1) << 5); R = (st >> 1) * 16 + swz / 64; C = (st & 1) * 32 + (swz % 64) / 2; }
DI int perm32(int rho) { const int n = rho >> 4, i = rho & 15; return 8 * (i >> 2) + 4 * n + (i & 3); }
struct Unit { int pm, pn, seg; };
struct Gemm { const bf16_t* A; const bf16_t* Bt; int lda, ldb, K; int nM, nN, nSeg, pn0; long a_pn_stride, a_seg1, a_seg2, b_seg_stride; };
DI bool next_unit(const Gemm& g, int i, int G, int c, Unit& u) {
    const int nwg = g.nM * g.nN; const int it = i / g.nSeg; u.seg = i - it * g.nSeg;
    const long L = (long)it * G + c; if (L >= nwg) return false;
    int wgid = (int)L; { const int q = nwg / NXCD, r = nwg % NXCD, xcd = wgid % NXCD, off = wgid / NXCD; wgid = (xcd < r ? xcd * (q + 1) : r * (q + 1) + (xcd - r) * q) + off; }
    const int nig = WGM * g.nN, gid = wgid / nig, fm = gid * WGM, gsz = (g.nM - fm) < WGM ? (g.nM - fm) : WGM;
    u.pm = fm + ((wgid % nig) % gsz); u.pn = (wgid % nig) / gsz; return true;
}
DI const char* a_ptr(const Gemm& g, const Unit& u) { return (const char*)(g.A + (size_t)u.pm * 256 * g.lda + (size_t)u.pn * g.a_pn_stride + (u.seg == 0 ? 0 : (u.seg == 1 ? g.a_seg1 : g.a_seg2))); }
DI const char* b_ptr(const Gemm& g, const Unit& u) { return (const char*)(g.Bt + (size_t)(g.pn0 + u.pn) * 256 * g.ldb + (size_t)u.seg * g.b_seg_stride); }

template <class Epi>
DI void gemm_phase(LAS unsigned char* lds, const Gemm g, const Epi& E, int Gv = 0, int cv = 0) {
    const int tid = ltid(), wid = __builtin_amdgcn_readfirstlane(tid >> 6), lane = tid & 63, wr = wid >> 2, wc = wid & 3, fr = lane & 15, fq = lane >> 4;
    constexpr bool MERGE = Epi::MERGE;
    const int K = g.K, nt = MERGE ? 3 * (K / BK) : K / BK; const int G = Gv > 0 ? Gv : lgdim(), c = Gv > 0 ? cv : lbid();
    unsigned voffA[2], voffB[2];
#pragma unroll
    for (int i = 0; i < 2; ++i) { int R, C; stage_rc(tid * 16 + i * 8192, R, C); const int Rb = Epi::PERM ? ((R & ~31) + perm32(R & 31)) : R;
        voffA[i] = (unsigned)(R * g.lda + C) * 2u; voffB[i] = (unsigned)(Rb * g.ldb + C) * 2u; }
    const size_t kstep = (size_t)(BK * 2);
    const size_t hstepA = (size_t)HALF * g.lda * 2, hstepB = (size_t)HALF * g.ldb * 2;
    const unsigned ldsw = (unsigned)wid * 1024u;
    const int aoff = lds_byte(wr * 64 + fr, fq * 8), boff = lds_byte(wc * 32 + fr, fq * 8);
#define PG8_SA(b, h) (((b) * 2 + (h)) * HTB)
#define PG8_SB(b, h) ((4 + (b) * 2 + (h)) * HTB)
#define PG8_STAGE(bufoff, gbase, voff) do { _Pragma("unroll") for (int _i = 0; _i < 2; ++_i) \
        __builtin_amdgcn_global_load_lds((const unsigned*)((const char*)(gbase) + (voff)[_i]), (LAS unsigned*)(lds + (bufoff) + ldsw + _i * 8192), 16, 0, 0); } while (0)
#define PG8_LDA(dst, b, h) do { _Pragma("unroll") for (int m = 0; m < 4; ++m) _Pragma("unroll") for (int k = 0; k < 2; ++k) dst[m][k] = *(const LAS bf16x8*)(lds + PG8_SA(b, h) + aoff + m * 2048 + k * 1024); } while (0)
#define PG8_LDB(dst, b, h) do { _Pragma("unroll") for (int n = 0; n < 2; ++n) _Pragma("unroll") for (int k = 0; k < 2; ++k) dst[n][k] = *(const LAS bf16x8*)(lds + PG8_SB(b, h) + boff + n * 2048 + k * 1024); } while (0)
#define PG8_MMA(ai, bj, At, Bt) do { __builtin_amdgcn_s_setprio(1); _Pragma("unroll") for (int m = 0; m < 4; ++m) _Pragma("unroll") for (int n = 0; n < 2; ++n) _Pragma("unroll") for (int k = 0; k < 2; ++k) \
        acc[ai][bj][m][n] = __builtin_amdgcn_mfma_f32_16x16x32_bf16(Bt[n][k], At[m][k], acc[ai][bj][m][n], 0, 0, 0); __builtin_amdgcn_s_setprio(0); } while (0)
#define PG8_WAIT_V(n) asm volatile("s_waitcnt vmcnt(" #n ")" ::: "memory")
#define PG8_WAIT_L(n) asm volatile("s_waitcnt lgkmcnt(" #n ")" ::: "memory")
#define PG8_BAR __builtin_amdgcn_s_barrier()
#define PG8_SCHED __builtin_amdgcn_sched_barrier(0)
    Unit cur, nxt; int ui = 0;
    if (!next_unit(g, 0, G, c, cur)) return;
    f32x4 acc[2][2][4][2];
#pragma unroll
    for (int a = 0; a < 2; ++a)
#pragma unroll
        for (int b = 0; b < 2; ++b)
#pragma unroll
            for (int m = 0; m < 4; ++m)
#pragma unroll
                for (int n = 0; n < 2; ++n) acc[a][b][m][n] = (f32x4){0.f, 0.f, 0.f, 0.f};
    bf16x8 At[4][2], B0[2][2], B1[2][2];
    const char* cA = a_ptr(g, cur); const char* cB = b_ptr(g, cur);
    PG8_STAGE(PG8_SB(0, 0), cB, voffB); PG8_STAGE(PG8_SA(0, 0), cA, voffA); PG8_STAGE(PG8_SB(0, 1), cB + hstepB, voffB); PG8_STAGE(PG8_SA(0, 1), cA + hstepA, voffA);
    if (wr == 1) PG8_BAR;
    PG8_WAIT_V(4); PG8_BAR;
    PG8_STAGE(PG8_SB(1, 0), cB + kstep, voffB); PG8_STAGE(PG8_SA(1, 0), cA + kstep, voffA); PG8_STAGE(PG8_SB(1, 1), cB + hstepB + kstep, voffB);
    PG8_WAIT_V(6); PG8_BAR;
    for (;;) {
        const bool has_next = next_unit(g, ui + 1, G, c, nxt);
        const char* nA = has_next ? a_ptr(g, nxt) : cA; const char* nB = has_next ? b_ptr(g, nxt) : cB;
        for (int t = 0; t < nt; t += 2) {
            const bool last = (t == nt - 2);
            const char* a1; const char* a2; const char* b2; const char* a3; const char* b3;
            if constexpr (!MERGE) { a1 = cA + (size_t)(t + 1) * kstep; a2 = last ? nA : cA + (size_t)(t + 2) * kstep; b2 = last ? nB : cB + (size_t)(t + 2) * kstep; }
            else { const int ntk = K / BK; const int sg1 = (t + 1) / ntk, sg2 = (t + 2) / ntk;
                a1 = cA + (sg1 == 0 ? 0 : (sg1 == 1 ? g.a_seg1 : g.a_seg2)) * 2 + (size_t)(t + 1 - sg1 * ntk) * kstep;
                a2 = last ? nA : cA + (sg2 == 0 ? 0 : (sg2 == 1 ? g.a_seg1 : g.a_seg2)) * 2 + (size_t)(t + 2 - sg2 * ntk) * kstep;
                b2 = last ? nB : cB + (size_t)sg2 * g.b_seg_stride * 2 + (size_t)(t + 2 - sg2 * ntk) * kstep;
                if (t > 0 && t % ntk == 0) E.rescale(acc, cur, t / ntk, wr, wc, fr, fq); }
            a3 = a2 + kstep; b3 = b2 + kstep;
            PG8_LDB(B0, 0, 0); PG8_SCHED; PG8_LDA(At, 0, 0); PG8_STAGE(PG8_SA(1, 1), a1 + hstepA, voffA);
            PG8_WAIT_L(8); PG8_BAR; PG8_WAIT_L(0); PG8_MMA(0, 0, At, B0); PG8_BAR; PG8_SCHED;
            PG8_LDB(B1, 0, 1); PG8_STAGE(PG8_SB(0, 0), b2, voffB);
            PG8_BAR; PG8_WAIT_L(0); PG8_MMA(0, 1, At, B1); PG8_BAR;
            PG8_LDA(At, 0, 1); PG8_STAGE(PG8_SA(0, 0), a2, voffA);
            PG8_BAR; PG8_WAIT_L(0); PG8_MMA(1, 0, At, B0); PG8_BAR; PG8_SCHED;
            PG8_STAGE(PG8_SB(0, 1), b2 + hstepB, voffB);
            PG8_WAIT_V(6); PG8_BAR; PG8_MMA(1, 1, At, B1); PG8_BAR;
            PG8_LDB(B0, 1, 0); PG8_SCHED; PG8_LDA(At, 1, 0); PG8_STAGE(PG8_SA(0, 1), a2 + hstepA, voffA);
            PG8_WAIT_L(8); PG8_BAR; PG8_WAIT_L(0); PG8_MMA(0, 0, At, B0); PG8_BAR; PG8_SCHED;
            PG8_LDB(B1, 1, 1); PG8_STAGE(PG8_SB(1, 0), b3, voffB);
            PG8_BAR; PG8_WAIT_L(0); PG8_MMA(0, 1, At, B1); PG8_BAR;
            PG8_LDA(At, 1, 1); PG8_STAGE(PG8_SA(1, 0), a3, voffA);
            PG8_BAR; PG8_WAIT_L(0); PG8_MMA(1, 0, At, B0); PG8_BAR; PG8_SCHED;
            PG8_STAGE(PG8_SB(1, 1), b3 + hstepB, voffB);
            PG8_WAIT_V(6); PG8_BAR; PG8_MMA(1, 1, At, B1); PG8_BAR;
        }
        if constexpr (!Epi::AFTER_DRAIN) E(acc, cur, wr, wc, fr, fq);
        if (!has_next) break;
#pragma unroll
        for (int a = 0; a < 2; ++a)
#pragma unroll
            for (int b = 0; b < 2; ++b)
#pragma unroll
                for (int m = 0; m < 4; ++m)
#pragma unroll
                    for (int n = 0; n < 2; ++n) acc[a][b][m][n] = (f32x4){0.f, 0.f, 0.f, 0.f};
        cur = nxt; cA = nA; cB = nB; ++ui;
    }
    PG8_WAIT_V(0);
    if (wr == 0) PG8_BAR;
    PG8_BAR;
    if constexpr (Epi::AFTER_DRAIN) E.fused(acc, cur, wr, wc, fr, fq);
#undef PG8_SA
#undef PG8_SB
#undef PG8_STAGE
#undef PG8_LDA
#undef PG8_LDB
#undef PG8_MMA
#undef PG8_WAIT_V
#undef PG8_WAIT_L
#undef PG8_BAR
#undef PG8_SCHED
}
}
using pg8::Unit;
typedef f32x4 AccT[2][2][4][2];

struct EpiInProj {
    static constexpr bool PERM = true, MERGE = false, AFTER_DRAIN = false;
    bf16_t* slots; bf16_t* kraw; bf16_t* vraw; const float* b_gate;
    DI void operator()(const AccT& acc, const Unit& u, int wr, int wc, int fr, int fq) const {
        const int pn = u.pn; bf16_t* base; int ld = 1024, ccol, mode = 0; const float* bias = b_gate;
        if (pn < 4) { base = slots + 1 * SLOT_E; ccol = pn * 256; }
        else if (pn < 8) { base = slots + 2 * SLOT_E; ccol = (pn - 4) * 256; mode = 1; }
        else if (pn < 12) { base = slots + 3 * SLOT_E; ccol = (pn - 8) * 256; }
        else if (pn == 12) { base = kraw; ld = 256; ccol = 0; }
        else if (pn == 13) { base = vraw; ld = 256; ccol = 0; }
        else if (pn < 18) { base = slots + 4 * SLOT_E; ccol = (pn - 14) * 256; }
        else { const int sec = (pn - 18) >> 2; base = slots + (size_t)(5 + sec) * SLOT_E; ccol = ((pn - 18) & 3) * 256; mode = 2; bias = b_gate + (pn - 18) * 256; }
        const int row0 = u.pm * 256 + wr * 64 + fr, cl = wc * 32 + 8 * fq;
#pragma unroll
        for (int bj = 0; bj < 2; ++bj) {
            float bv[8];
#pragma unroll
            for (int e = 0; e < 8; ++e) bv[e] = (mode == 2) ? bias[cl + bj * 128 + e] : 0.f;
#pragma unroll
            for (int ai = 0; ai < 2; ++ai)
#pragma unroll
                for (int m = 0; m < 4; ++m) {
                    float v[8];
#pragma unroll
                    for (int e = 0; e < 4; ++e) { v[e] = acc[ai][bj][m][0][e]; v[4 + e] = acc[ai][bj][m][1][e]; }
                    if (mode == 1) {
#pragma unroll
                        for (int e = 0; e < 8; ++e) v[e] = gelu_tanh(v[e]);
                    } else if (mode == 2) {
#pragma unroll
                        for (int e = 0; e < 8; ++e) v[e] = sigmoidf_(v[e] + bv[e]);
                    }
                    *(u32x4*)(base + (size_t)(row0 + ai * 128 + m * 16) * ld + ccol + bj * 128 + cl) = pack8(v);
                }
        }
    }
};
struct EpiScaleBf16 {
    static constexpr bool PERM = true, MERGE = false, AFTER_DRAIN = false;
    bf16_t* O; int ldc; int pn_base; const float* scale;
    DI void operator()(const AccT& acc, const Unit& u, int wr, int wc, int fr, int fq) const {
        const int row0 = u.pm * 256 + wr * 64 + fr, cl = (u.pn + pn_base) * 256 + wc * 32 + 8 * fq;
#pragma unroll
        for (int bj = 0; bj < 2; ++bj) {
            float sv[8];
#pragma unroll
            for (int e = 0; e < 8; ++e) sv[e] = scale ? scale[cl + bj * 128 + e] : 1.0f;
#pragma unroll
            for (int ai = 0; ai < 2; ++ai)
#pragma unroll
                for (int m = 0; m < 4; ++m) {
                    float v[8];
#pragma unroll
                    for (int e = 0; e < 4; ++e) { v[e] = acc[ai][bj][m][0][e] * sv[e]; v[4 + e] = acc[ai][bj][m][1][e] * sv[4 + e]; }
                    *(u32x4*)(O + (size_t)(row0 + ai * 128 + m * 16) * ldc + cl + bj * 128) = pack8(v);
                }
        }
    }
};
struct EpiMerge {
    static constexpr bool PERM = true, MERGE = true, AFTER_DRAIN = false;
    bf16_t* gates; bool dry;
    DI void rescale(AccT& acc, const Unit& u, int sb, int wr, int wc, int fr, int fq) const {
        const int row0 = u.pm * 256 + wr * 64 + fr, cl = u.pn * 256 + wc * 32 + 8 * fq;
        const bf16_t* gp = gates + (size_t)(sb - 1) * SLOT_E + (size_t)row0 * 1024 + cl;
#pragma unroll
        for (int ai = 0; ai < 2; ++ai)
#pragma unroll
            for (int m = 0; m < 4; ++m) {
                asm volatile("" : "+v"(gp));
#pragma unroll
                for (int bj = 0; bj < 2; ++bj) {
                    float a[8], b[8]; unpack8(*(const u32x4*)(gp + bj * 128), a); unpack8(*(const u32x4*)(gp + SLOT_E + bj * 128), b);
#pragma unroll
                    for (int e = 0; e < 4; ++e) { acc[ai][bj][m][0][e] *= a[e] * __builtin_amdgcn_rcpf(b[e]); acc[ai][bj][m][1][e] *= a[4 + e] * __builtin_amdgcn_rcpf(b[4 + e]); }
                }
                gp += (m == 3 ? (128 - 48) : 16) * 1024;
            }
    }
    DI void operator()(const AccT& acc, const Unit& u, int wr, int wc, int fr, int fq) const {
        const int row0 = u.pm * 256 + wr * 64 + fr, cl = u.pn * 256 + wc * 32 + 8 * fq;
        bf16_t* gs = gates + 2 * SLOT_E;
#pragma unroll
        for (int ai = 0; ai < 2; ++ai)
#pragma unroll
            for (int m = 0; m < 4; ++m)
#pragma unroll
                for (int bj = 0; bj < 2; ++bj) {
                    const size_t idx = (size_t)(row0 + ai * 128 + m * 16) * 1024 + cl + bj * 128;
                    float gv[8]; unpack8(*(const u32x4*)(gs + idx), gv);
                    float v[8];
#pragma unroll
                    for (int e = 0; e < 4; ++e) { v[e] = acc[ai][bj][m][0][e] * gv[e]; v[4 + e] = acc[ai][bj][m][1][e] * gv[4 + e]; }
                    if (!dry) *(u32x4*)(gs + idx) = pack8(v);
                }
    }
};
DI float dpp_ror1(float v) { return __builtin_bit_cast(float, __builtin_amdgcn_update_dpp(0, __builtin_bit_cast(int, v), 0x121, 0xf, 0xf, false)); }
DI float dpp_ror15(float v) { return __builtin_bit_cast(float, __builtin_amdgcn_update_dpp(0, __builtin_bit_cast(int, v), 0x12f, 0xf, 0xf, false)); }
struct EpiUpFused {
    static constexpr bool PERM = true, MERGE = false, AFTER_DRAIN = false;
    bf16_t* act; float* zedge; float* zpart; const float* cw; const float* cb;
    DI void operator()(const AccT& acc, const Unit& u, int wr, int wc, int fr, int fq) const {
        const int j = u.pn, cl = wc * 32 + 8 * fq;
#pragma unroll
        for (int n = 0; n < 2; ++n) {
            const int ch0 = 128 * j + cl + 4 * n;
            const f32x4 bg = *(const f32x4*)(cb + ch0), w0g = *(const f32x4*)(cw + ch0), w1g = *(const f32x4*)(cw + 6144 + ch0), w2g = *(const f32x4*)(cw + 2 * 6144 + ch0);
            const f32x4 bv = *(const f32x4*)(cb + 3072 + ch0), w0v = *(const f32x4*)(cw + 3072 + ch0), w1v = *(const f32x4*)(cw + 6144 + 3072 + ch0), w2v = *(const f32x4*)(cw + 2 * 6144 + 3072 + ch0);
#pragma unroll
            for (int ai = 0; ai < 2; ++ai) {
                const int rowblk = u.pm * 256 + ai * 128 + wr * 64;
#pragma unroll
                for (int m = 0; m < 4; ++m) {
                    const f32x4 zg = acc[ai][0][m][n], zv = acc[ai][1][m][n];
                    f32x4 pg, pv, ng, nv;
#pragma unroll
                    for (int e = 0; e < 4; ++e) {
                        const float pgs = dpp_ror1(zg[e]), pvs = dpp_ror1(zv[e]), ngs = dpp_ror15(zg[e]), nvs = dpp_ror15(zv[e]);
                        const float pgw = m > 0 ? dpp_ror1(acc[ai][0][m > 0 ? m - 1 : 0][n][e]) : 0.f, pvw = m > 0 ? dpp_ror1(acc[ai][1][m > 0 ? m - 1 : 0][n][e]) : 0.f;
                        const float ngw = m < 3 ? dpp_ror15(acc[ai][0][m < 3 ? m + 1 : 3][n][e]) : 0.f, nvw = m < 3 ? dpp_ror15(acc[ai][1][m < 3 ? m + 1 : 3][n][e]) : 0.f;
                        pg[e] = fr == 0 ? pgw : pgs; pv[e] = fr == 0 ? pvw : pvs; ng[e] = fr == 15 ? ngw : ngs; nv[e] = fr == 15 ? nvw : nvs; }
                    const f32x4 preg = bg + w0g * pg + w1g * zg + w2g * ng, prev = bv + w0v * pv + w1v * zv + w2v * nv;
                    const bool e0 = (m == 0 && fr == 0), e1 = (m == 3 && fr == 15);
                    if (e0 || e1) { const size_t o = ((size_t)((rowblk >> 6) * 2 + (e1 ? 1 : 0))) * 6144 + j * 256 + cl + 4 * n;
                        *(f32x4*)(zpart + o) = preg; *(f32x4*)(zpart + o + 128) = prev; *(f32x4*)(zedge + o) = zg; *(f32x4*)(zedge + o + 128) = zv; }
                    else { u32x2 ov; ov[0] = pk2(preg[0] * sigmoidf_(preg[0]) * prev[0], preg[1] * sigmoidf_(preg[1]) * prev[1]); ov[1] = pk2(preg[2] * sigmoidf_(preg[2]) * prev[2], preg[3] * sigmoidf_(preg[3]) * prev[3]);
                        *(u32x2*)(act + (size_t)(rowblk + 16 * m + fr) * 3072 + ch0) = ov; }
                }
            }
        }
    }
};
DI void ffn_fixup(int pm, bf16_t* act, const float* zedge, const float* zpart, const float* cw, const float* cb) {
    const int tid = ltid();
    for (int pc = tid; pc < 8 * 768; pc += 512) {
        const int er = pc / 768, ch0 = (pc - er * 768) * 4; const int B = 4 * pm + (er >> 1), edge = er & 1;
        const int zc = (ch0 >> 7) * 256 + (ch0 & 127);
        const size_t o = ((size_t)(B * 2 + edge)) * 6144 + zc;
        f32x4 pg = *(const f32x4*)(zpart + o), pv = *(const f32x4*)(zpart + o + 128);
        const int row = B * 64 + (edge ? 63 : 0); const int s0 = seq_start(row), S = seq_len(row), t = row - s0;
        if (edge == 0 && t > 0) { const size_t q = ((size_t)((B - 1) * 2 + 1)) * 6144 + zc; pg += *(const f32x4*)(cw + ch0) * *(const f32x4*)(zedge + q); pv += *(const f32x4*)(cw + 3072 + ch0) * *(const f32x4*)(zedge + q + 128); }
        if (edge == 1 && t < S - 1) { const size_t q = ((size_t)((B + 1) * 2 + 0)) * 6144 + zc; pg += *(const f32x4*)(cw + 2 * 6144 + ch0) * *(const f32x4*)(zedge + q); pv += *(const f32x4*)(cw + 2 * 6144 + 3072 + ch0) * *(const f32x4*)(zedge + q + 128); }
        u32x2 ov; ov[0] = pk2(pg[0] * sigmoidf_(pg[0]) * pv[0], pg[1] * sigmoidf_(pg[1]) * pv[1]); ov[1] = pk2(pg[2] * sigmoidf_(pg[2]) * pv[2], pg[3] * sigmoidf_(pg[3]) * pv[3]);
        *(u32x2*)(act + (size_t)row * 3072 + ch0) = ov;
    }
    asm volatile("s_waitcnt vmcnt(0)" ::: "memory");
    __syncthreads();
}
struct EpiResid {
    static constexpr bool PERM = false, MERGE = false, AFTER_DRAIN = false;
    float* x; const float* modl; int gate_off; bool dry;
    DI void operator()(const AccT& acc, const Unit& u, int wr, int wc, int fr, int fq) const {
        const int row0 = u.pm * 256 + wr * 64 + fr, col0 = u.pn * 256 + wc * 32 + 4 * fq;
        const float* gp = modl + (size_t)mod_row(u.pm * 256) * 6144 + gate_off;
#pragma unroll
        for (int bj = 0; bj < 2; ++bj)
#pragma unroll
            for (int n = 0; n < 2; ++n) {
                const int col = col0 + bj * 128 + n * 16; const f32x4 gv = *(const f32x4*)(gp + col);
#pragma unroll
                for (int ai = 0; ai < 2; ++ai)
#pragma unroll
                    for (int m = 0; m < 4; ++m) { float* xp = x + (size_t)(row0 + ai * 128 + m * 16) * 1024 + col; f32x4 xv = *(const f32x4*)xp; xv += gv * acc[ai][bj][m][n]; if (!dry) *(f32x4*)xp = xv; }
            }
    }
};


#define XB_TMO      128
#define XB_XCNT(j)  (256  + 64 * (j))
#define XB_XSUB(j)  (1280 + 64 * (j))
#define XB_XGEN(j)  (2304 + 64 * (j))
#define XB_TOP      3328
#define XB_TOPGEN   3392
#define XB_SPIN_CAP (1u << 18)
DI unsigned xb_ld(unsigned* p) { return __hip_atomic_load(p, __ATOMIC_RELAXED, __HIP_MEMORY_SCOPE_AGENT); }
DI unsigned xb_add(unsigned* p, unsigned v) { return __hip_atomic_fetch_add(p, v, __ATOMIC_RELAXED, __HIP_MEMORY_SCOPE_AGENT); }
DI unsigned xb_xcc_id() { return (unsigned)__builtin_amdgcn_s_getreg((3 << 11) | 20) & 0xFu; }
#define XB_SPIN(cond, bar) do { unsigned _sp = 0; while (cond) { __builtin_amdgcn_s_sleep(1); \
    if ((++_sp & 255u) == 0u) { if (xb_ld(&(bar)[XB_TMO])) break; if (_sp > XB_SPIN_CAP) { atomicAdd(&(bar)[XB_TMO], 1u); break; } } } } while (0)
DI void xcd_barrier_complete(unsigned* bar, unsigned x, unsigned& nloc, unsigned& nx) {
    const unsigned G = gridDim.x;
    unsigned sum, cnt, mine, sp = 0u;
    for (;;) {
        sum = 0u; cnt = 0u; mine = 0u;
#pragma unroll
        for (unsigned j = 0; j < 16; ++j) { const unsigned c = xb_ld(&bar[XB_XCNT(j)]); sum += c; cnt += (c > 0u) ? 1u : 0u; mine = (j == x) ? c : mine; }
        if (sum == G) break;
        __builtin_amdgcn_s_sleep(1);
        if ((++sp & 255u) == 0u) { if (xb_ld(&bar[XB_TMO])) break; if (sp > XB_SPIN_CAP) { atomicAdd(&bar[XB_TMO], 1u); break; } }
    }
    nloc = mine > 0u ? mine : 1u; nx = cnt > 0u ? cnt : 1u;
}
DI void gbar_post(const KP p, unsigned char* shm) {
    volatile LAS unsigned* st = (volatile LAS unsigned*)(LAS unsigned char*)(shm + 131072);
    if (threadIdx.x == 0) { st[0] = 0u; st[1] = 0u; (void)xb_add(&((unsigned*)(p.ws() + OFF_BAR))[XB_XCNT(xb_xcc_id())], 1u); }
    __syncthreads();
}
DI void gbar(const KP p, unsigned char* shm) {
    asm volatile("s_waitcnt vmcnt(0)" ::: "memory");
    __syncthreads();
    if (threadIdx.x == 0) {
        unsigned* bar = (unsigned*)(p.ws() + OFF_BAR); const unsigned x = xb_xcc_id();
        volatile LAS unsigned* st = (volatile LAS unsigned*)(LAS unsigned char*)(shm + 131072);
        __builtin_amdgcn_s_waitcnt(0);
        unsigned nloc = st[0], nx = st[1];
        if (nloc == 0u) { xcd_barrier_complete(bar, x, nloc, nx); st[0] = nloc; st[1] = nx; }
        const unsigned old = xb_add(&bar[XB_XSUB(x)], 1u);
        const unsigned gen = old / nloc;
        if (old + 1u == (gen + 1u) * nloc) {
            __builtin_amdgcn_fence(__ATOMIC_RELEASE, "agent");
            asm volatile("s_waitcnt vmcnt(0)" ::: "memory");
            const unsigned og = xb_add(&bar[XB_TOP], 1u);
            const unsigned tg = og / nx;
            if (og + 1u == (tg + 1u) * nx) xb_add(&bar[XB_TOPGEN], 1u);
            else XB_SPIN(xb_ld(&bar[XB_TOPGEN]) == tg, bar);
            __builtin_amdgcn_fence(__ATOMIC_ACQUIRE, "agent");
            xb_add(&bar[XB_XGEN(x)], 1u);
            asm volatile("s_waitcnt vmcnt(0)" ::: "memory");
        } else {
            XB_SPIN(xb_ld(&bar[XB_XGEN(x)]) == gen, bar);
            __builtin_amdgcn_fence(__ATOMIC_ACQUIRE, "agent");
            asm volatile("s_waitcnt vmcnt(0)" ::: "memory");
        }
    }
    __syncthreads();
}

struct EpiResidNorm {
    static constexpr bool PERM = false, MERGE = false, AFTER_DRAIN = true;
    float* x; const float* modl; int gate_off; int mode; const float* gam; const float* modn; int sh_off, sc_off; bf16_t* dst; float* rss; unsigned* cnt; unsigned* bar; float* rsl;
    DI void fused(AccT& acc, const Unit& u, int wr, int wc, int fr, int fq) const {
        const int row0 = u.pm * 256 + wr * 64 + fr, col0 = u.pn * 256 + wc * 32 + 4 * fq;
        const int mrow = mod_row(u.pm * 256);
        const float* gp = modl + (size_t)mrow * 6144 + gate_off + col0;
        { f32x4 gv[2][2];
#pragma unroll
          for (int bj = 0; bj < 2; ++bj)
#pragma unroll
              for (int n = 0; n < 2; ++n) gv[bj][n] = *(const f32x4*)(gp + bj * 128 + n * 16);
          const float* xp = x + (size_t)row0 * 1024 + col0;
#pragma unroll
          for (int ai = 0; ai < 2; ++ai)
#pragma unroll
              for (int m = 0; m < 4; ++m) {
                  asm volatile("" : "+v"(xp));
                  float sq = 0.f;
#pragma unroll
                  for (int bj = 0; bj < 2; ++bj)
#pragma unroll
                      for (int n = 0; n < 2; ++n) { f32x4 xv = *(const f32x4*)(xp + bj * 128 + n * 16); xv += gv[bj][n] * acc[ai][bj][m][n]; acc[ai][bj][m][n] = xv; sq += xv[0] * xv[0] + xv[1] * xv[1] + xv[2] * xv[2] + xv[3] * xv[3]; }
                  sq += __shfl_xor(sq, 16); sq += __shfl_xor(sq, 32);
                  if (fq == 0) __hip_atomic_store(&rss[(size_t)(row0 + ai * 128 + m * 16) * 16 + u.pn * 4 + wc], sq, __ATOMIC_RELAXED, __HIP_MEMORY_SCOPE_AGENT);
                  xp += (m == 3 ? (128 - 48) : 16) * 1024;
              } }
        asm volatile("s_waitcnt vmcnt(0)" ::: "memory");
        __syncthreads();
        if (threadIdx.x == 0) { (void)xb_add(&cnt[u.pm], 1u); XB_SPIN(xb_ld(&cnt[u.pm]) < 4u, bar); }
        __syncthreads();
        float rs[2][4];
        { const int L = fq * 16 + fr; float* rw = rsl + (wr * 4 + wc) * 128;
#pragma unroll
          for (int ai = 0; ai < 2; ++ai) { const float* rp = rss + (size_t)(u.pm * 256 + ai * 128 + wr * 64 + L) * 16;
              float t = 0.f;
#pragma unroll
              for (int q = 0; q < 8; ++q) { const unsigned long long w = __hip_atomic_load((const unsigned long long*)rp + q, __ATOMIC_RELAXED, __HIP_MEMORY_SCOPE_AGENT); t += __uint_as_float((unsigned)w) + __uint_as_float((unsigned)(w >> 32)); }
              rw[ai * 64 + L] = rsqrtf(t * (1.0f / 1024.0f) + 1e-6f); }
#pragma unroll
          for (int ai = 0; ai < 2; ++ai)
#pragma unroll
              for (int m = 0; m < 4; ++m) rs[ai][m] = rw[ai * 64 + 16 * m + fr]; }
        { const float* mn = modn + (size_t)mrow * 6144 + col0;
          f32x4 ms[2][2], sh[2][2];
#pragma unroll
          for (int bj = 0; bj < 2; ++bj)
#pragma unroll
              for (int n = 0; n < 2; ++n) { const int cc = bj * 128 + n * 16; ms[bj][n] = *(const f32x4*)(gam + col0 + cc); sh[bj][n] = (f32x4){0.f, 0.f, 0.f, 0.f};
                  if (mode == 0) { ms[bj][n] = ms[bj][n] * (*(const f32x4*)(mn + sc_off + cc) + 1.0f); sh[bj][n] = *(const f32x4*)(mn + sh_off + cc); } }
          float* xq = x + (size_t)row0 * 1024 + col0; bf16_t* dq = dst + (size_t)row0 * 1024 + col0;
#pragma unroll
          for (int ai = 0; ai < 2; ++ai)
#pragma unroll
              for (int m = 0; m < 4; ++m) {
                  asm volatile("" : "+v"(xq), "+v"(dq));
#pragma unroll
                  for (int bj = 0; bj < 2; ++bj)
#pragma unroll
                      for (int n = 0; n < 2; ++n) { const int cc = bj * 128 + n * 16; const f32x4 y = acc[ai][bj][m][n] * rs[ai][m] * ms[bj][n] + sh[bj][n];
                          if (mode == 0) { *(f32x4*)(xq + cc) = acc[ai][bj][m][n]; u32x2 ob; ob[0] = pk2(y[0], y[1]); ob[1] = pk2(y[2], y[3]); *(u32x2*)(dq + cc) = ob; } else *(f32x4*)(xq + cc) = y; }
                  xq += (m == 3 ? (128 - 48) : 16) * 1024; dq += (m == 3 ? (128 - 48) : 16) * 1024;
              } }
    }
};

DI float wave_sum(float v) {
#pragma unroll
    for (int o = 32; o > 0; o >>= 1) v += __shfl_xor(v, o);
    return v;
}

DI void phase_mod(const KP p, unsigned char* shm) {
    float* sc = (float*)shm; float* red = sc + 9 * 1024;
    const int tid = ltid(); bool inited = false;
    const float* cond = p.in(5); const float* cctx = p.in(6);
    for (int it = lbid(); it < 192; it += lgdim()) {
        if (!inited) { for (int e = tid; e < 9 * 1024; e += 512) { const int r = e >> 10, k = e & 1023; const float v = r == 0 ? cctx[k] : cond[(r - 1) * 1024 + k]; sc[e] = v / (1.0f + expf(-v)); } __syncthreads(); inited = true; }
        const int l = it / 96, j0 = (it % 96) * 64, j = tid & 63, kq = tid >> 6;
        const float* w = p.in(9) + (size_t)l * 1024 * 6144 + j0 + j;
        float a0 = 0, a1 = 0, a2 = 0, a3 = 0, a4 = 0, a5 = 0, a6 = 0, a7 = 0, a8 = 0;
        for (int k = kq * 128; k < kq * 128 + 128; ++k) { const float wv = w[(size_t)k * 6144];
            a0 += sc[k] * wv; a1 += sc[1024 + k] * wv; a2 += sc[2048 + k] * wv; a3 += sc[3072 + k] * wv; a4 += sc[4096 + k] * wv; a5 += sc[5120 + k] * wv; a6 += sc[6144 + k] * wv; a7 += sc[7168 + k] * wv; a8 += sc[8192 + k] * wv; }
        float* rp = red + (kq * 9) * 64 + j;
        rp[0] = a0; rp[64] = a1; rp[128] = a2; rp[192] = a3; rp[256] = a4; rp[320] = a5; rp[384] = a6; rp[448] = a7; rp[512] = a8;
        __syncthreads();
        for (int e = tid; e < 576; e += 512) { const int r = e >> 6, jj = e & 63; float s = p.in(10)[(size_t)l * 6144 + j0 + jj];
            for (int q = 0; q < 8; ++q) s += red[(q * 9 + r) * 64 + jj];
            ((float*)(p.ws() + OFF_MOD))[((size_t)l * 9 + r) * 6144 + j0 + jj] = s; }
        __syncthreads();
    }
    __syncthreads();
}

DI void phase_kbound(const KP p, unsigned char* shm) {
    const int tid = ltid(), lane = tid & 63, wid = tid >> 6; float* red = (float*)shm; float* out = (float*)(p.ws() + OFF_KMAX);
    for (int it = lbid(); it < 64; it += lgdim()) {
        const int l = it >> 5, b = (it >> 2) & 7, hk = it & 3; const int key = tid >> 1, half = tid & 1;
        const float* src = p.in(2) + ((((size_t)b * 2 + l) * 256 + key) * 256) + hk * 64 + half * 32;
        float ss = 0.f;
#pragma unroll
        for (int i = 0; i < 8; ++i) { const f32x4 v = *(const f32x4*)(src + i * 4); ss += v[0] * v[0] + v[1] * v[1] + v[2] * v[2] + v[3] * v[3]; }
        ss += __shfl_xor(ss, 1);
#pragma unroll
        for (int o = 2; o < 64; o <<= 1) ss = fmaxf(ss, __shfl_xor(ss, o));
        if (lane == 0) red[wid] = ss;
        __syncthreads();
        if (tid == 0) { float m = red[0]; for (int w = 1; w < 8; ++w) m = fmaxf(m, red[w]); out[it] = m; }
        __syncthreads();
    }
    if (lbid() == lgdim() - 1 && tid < 2) { float g2 = 0.f; for (int d = 0; d < 64; ++d) { const float g = p.in(21)[tid * 64 + d]; g2 = fmaxf(g2, g * g); } out[64 + tid] = 64.0f * g2; }
}

DI void transpose_tile(const float* src, int N, int k0, int scol0, bf16_t* dst, int ldd, int drow0, float* tile) {
    const int tid = ltid();
#pragma unroll
    for (int i = 0; i < 2; ++i) { const int idx = tid + i * 512, k = idx >> 4, n4 = idx & 15; const f32x4 v = *(const f32x4*)(src + (size_t)(k0 + k) * N + scol0 + n4 * 4);
        float* t = tile + k * 65 + n4 * 4; t[0] = v[0]; t[1] = v[1]; t[2] = v[2]; t[3] = v[3]; }
    __syncthreads();
    { const int n = tid >> 3, kg = tid & 7; float f[8];
#pragma unroll
      for (int j = 0; j < 8; ++j) f[j] = tile[(kg * 8 + j) * 65 + n];
      *(u32x4*)(dst + (size_t)(drow0 + n) * ldd + k0 + kg * 8) = pack8(f); }
    __syncthreads();
}
DI void phase_weights(const KP p, int l, unsigned char* shm) {
    float* tile = (float*)shm; unsigned char* W = p.ws() + OFF_W;
    const int G = lgdim(), c = lbid(); int base = 0;
    auto run = [&](const float* src, int K, int N, bf16_t* dst, int ldd, int mode) {
        const int ntn = N / 64, ntk = K / 64, nt = ntn * ntk;
        int first = (c - base) % G; if (first < 0) first += G;
        for (int ti = first; ti < nt; ti += G) { const int kt = ti / ntn, nn = ti - kt * ntn; const int drow0 = nn * 64; int scol0 = drow0;
            if (mode == 1) { const int j = drow0 >> 8, w = drow0 & 255; scol0 = w < 128 ? 128 * j + w : 3072 + 128 * j + (w - 128); }
            transpose_tile(src, N, kt * 64, scol0, dst, ldd, drow0, tile); }
        base += nt;
    };
    run(p.in(11) + (size_t)l * 1024 * 7680, 1024, 7680, (bf16_t*)(W + W_IN), 1024, 0);
    run(p.in(28) + (size_t)l * 1024 * 6144, 1024, 6144, (bf16_t*)(W + W_UP), 1024, 1);
    run(p.in(31) + (size_t)l * 3072 * 1024, 3072, 1024, (bf16_t*)(W + W_DOWN), 3072, 0);
    run(p.in(24) + (size_t)l * 1024 * 1024, 1024, 1024, (bf16_t*)(W + W_BR), 1024, 0);
    run(p.in(25) + (size_t)l * 1024 * 1024, 1024, 1024, (bf16_t*)(W + W_BR) + (size_t)1024 * 1024, 1024, 0);
    run(p.in(26) + (size_t)l * 1024 * 1024, 1024, 1024, (bf16_t*)(W + W_BR) + (size_t)2 * 1024 * 1024, 1024, 0);
    run(p.in(27) + (size_t)l * 1024 * 1024, 1024, 1024, (bf16_t*)(W + W_O), 1024, 0);
    for (int g = 0; g < 4; ++g) run(p.in(22) + ((size_t)l * 4 + g) * 256 * 256, 256, 256, (bf16_t*)(W + W_POOL) + (size_t)g * 256 * 256, 256, 0);
    bf16_t* wg = (bf16_t*)(W + W_GATE);
    for (int e = lbid() * 512 + ltid(); e < 16 * 2 * 128 * 64; e += lgdim() * 512) {
        const int k = e & 63, col = (e >> 6) & 127, dir = (e >> 13) & 1, n = e >> 14;
        const float* src = (col < 64 ? p.in(15) : p.in(17)) + ((((size_t)l * 2 + dir) * 16 + n) * 64 + k) * 64 + (col & 63);
        wg[e] = (bf16_t)(pk2(*src, 0.f) & 0xffffu);
    }
}

DI void phase_norm(const KP p, int l, bool from_input, const float* gam, int sh_off, int sc_off, bf16_t* dst, bool final_) {
    const int tid_ = ltid(); const int lane = tid_ & 63, wid = tid_ >> 6;
    const float* modl = (const float*)(p.ws() + OFF_MOD) + (size_t)l * 9 * 6144;
    const int stride = lgdim() * 8;
    f32x4 gv[4];
#pragma unroll
    for (int i = 0; i < 4; ++i) gv[i] = *(const f32x4*)(gam + i * 256 + lane * 4);
    for (int mb = lbid() * 8 + wid; mb < MT; mb += 3 * stride) {
        f32x4 xv[3][4]; float ss[3];
#pragma unroll
        for (int r = 0; r < 3; ++r) { const int m = mb + r * stride; ss[r] = 0.f;
            if (m < MT) { const float* xr = from_input ? (m < MCTX ? p.in(0) + (size_t)m * 1024 : p.in(1) + (size_t)(m - MCTX) * 1024) : p.out() + (size_t)m * 1024;
#pragma unroll
                for (int i = 0; i < 4; ++i) xv[r][i] = *(const f32x4*)(xr + i * 256 + lane * 4); }
            else {
#pragma unroll
                for (int i = 0; i < 4; ++i) xv[r][i] = (f32x4){0.f, 0.f, 0.f, 0.f}; } }
#pragma unroll
        for (int r = 0; r < 3; ++r) {
#pragma unroll
            for (int i = 0; i < 4; ++i) ss[r] += xv[r][i][0] * xv[r][i][0] + xv[r][i][1] * xv[r][i][1] + xv[r][i][2] * xv[r][i][2] + xv[r][i][3] * xv[r][i][3];
            ss[r] = wave_sum(ss[r]); }
#pragma unroll
        for (int r = 0; r < 3; ++r) { const int m = mb + r * stride; if (m >= MT) continue;
            const float rs = rsqrtf(ss[r] * (1.0f / 1024.0f) + 1e-6f);
            const float* mr = modl + (size_t)mod_row(m) * 6144;
#pragma unroll
            for (int i = 0; i < 4; ++i) { const int cc = i * 256 + lane * 4;
                if (final_) { f32x4 y = xv[r][i] * rs * gv[i]; *(f32x4*)(p.out() + (size_t)m * 1024 + cc) = y; }
                else { const f32x4 scv = *(const f32x4*)(mr + sc_off + cc), shv = *(const f32x4*)(mr + sh_off + cc);
                    f32x4 y = xv[r][i] * rs * gv[i] * (scv + 1.0f) + shv; u32x2 o; o[0] = pk2(y[0], y[1]); o[1] = pk2(y[2], y[3]);
                    *(u32x2*)(dst + (size_t)m * 1024 + cc) = o;
                    if (from_input) *(f32x4*)(p.out() + (size_t)m * 1024 + cc) = xv[r][i]; }
            }
        }
    }
}

DI void phase_e1_elem(const KP p, int l, unsigned char* shm, int parts = 15) {
    float* tab = (float*)shm;
    const int tid = ltid();
    for (int e = tid; e < 1024; e += 512) { const int pos = e >> 4, j = e & 15; const float inv = exp2f(-(float)j * (13.287712379549449f / 16.0f)); const float ang = (float)pos * inv; tab[2 * e] = __cosf(ang); tab[2 * e + 1] = __sinf(ang); }
    __syncthreads();
    bf16_t* slots = (bf16_t*)(p.ws() + OFF_SLOTS);
    bf16_t* qb = slots + 3 * SLOT_E; bf16_t* kraw = (bf16_t*)(p.ws() + OFF_KRAW); bf16_t* vraw = (bf16_t*)(p.ws() + OFF_VRAW);
    const size_t gtid = (size_t)lbid() * 512 + tid, gsz = (size_t)lgdim() * 512;
    if (parts & 1) {
        auto qk_ptr = [&](size_t e) -> bf16_t* { const int i = (int)(e & 7); const int hh = 16 + (int)((e >> 3) & 3); const int m = (int)(e >> 5);
            return kraw + (size_t)m * 256 + (hh - 16) * 64 + i * 8; };
        auto qk_proc = [&](size_t e, u32x4 rawv, bf16_t* ptr) {
            const int i = (int)(e & 7); const int hh = 16 + (int)((e >> 3) & 3); const int m = (int)(e >> 5); const bool isq = false;
            float x[8]; unpack8(rawv, x);
            float ss = 0.f;
#pragma unroll
            for (int j = 0; j < 8; ++j) ss += x[j] * x[j];
            ss += __shfl_xor(ss, 1); ss += __shfl_xor(ss, 2); ss += __shfl_xor(ss, 4);
            const float rs = rsqrtf(ss * (1.0f / 64.0f) + 1e-6f);
            const float* g = (isq ? p.in(20) : p.in(21)) + l * 64 + i * 8; const f32x4 g0 = *(const f32x4*)g, g1 = *(const f32x4*)(g + 4);
#pragma unroll
            for (int j = 0; j < 4; ++j) { x[j] = x[j] * rs * g0[j]; x[4 + j] = x[4 + j] * rs * g1[j]; }
            const bool lat = m >= MCTX;
            float part[8];
#pragma unroll
            for (int j = 0; j < 8; ++j) part[j] = __shfl_xor(x[j], 2);
            if (lat) { const int t = (m - MCTX) & 1023; const int pos = (i < 4) ? (t >> 6) : (t & 63);
#pragma unroll
                for (int j = 0; j < 8; ++j) { const int jj = (i & 1) * 8 + j; const float cs = tab[2 * (pos * 16 + jj)], sn = tab[2 * (pos * 16 + jj) + 1];
                    x[j] = (i & 2) ? (part[j] * sn + x[j] * cs) : (x[j] * cs - part[j] * sn); }
            } else if (!isq) { float* o = p.out() + OUT_CK + ((((size_t)(m >> 8) * 2 + l) * 256 + (m & 255)) * 256) + (hh - 16) * 64 + i * 8;
                *(f32x4*)o = (f32x4){x[0], x[1], x[2], x[3]}; *(f32x4*)(o + 4) = (f32x4){x[4], x[5], x[6], x[7]}; }
            *(u32x4*)ptr = pack8(x); };
        const size_t N = (size_t)MT * 4 * 8;
        for (size_t e = gtid; e < N; e += 2 * gsz) { const size_t e1 = e + gsz; const bool has1 = e1 < N;
            bf16_t* p0 = qk_ptr(e); bf16_t* p1 = qk_ptr(has1 ? e1 : e);
            const u32x4 r0 = *(const u32x4*)p0, r1 = *(const u32x4*)p1;
            qk_proc(e, r0, p0); if (has1) qk_proc(e1, r1, p1); }
    }
    bf16_t* vT = (bf16_t*)(p.ws() + OFF_VT);
    if (parts & 2)
    for (size_t e = gtid; e < (size_t)MT * 32; e += gsz) {
        int seq, t, grp;
        if (e < (size_t)MCTX * 32) { t = (int)(e & 255); grp = (int)((e >> 8) & 31); seq = (int)(e >> 13); }
        else { const size_t e2 = e - (size_t)MCTX * 32; t = (int)(e2 & 1023); grp = (int)((e2 >> 10) & 31); seq = 16 + (int)(e2 >> 15); }
        const int hk = grp >> 3, dg = grp & 7; const int m = seq < 16 ? seq * 256 + t : MCTX + (seq - 16) * 1024 + t;
        const u32x4 raw = *(const u32x4*)(vraw + (size_t)m * 256 + hk * 64 + dg * 8);
        bf16_t* dstp; int Sk;
        if (seq < 16) { Sk = 256; dstp = vT + ((size_t)(seq * 4 + hk) * 64 + dg * 8) * 256 + t; }
        else { Sk = 1280; dstp = vT + VT_LAT_E + ((size_t)((seq - 16) * 4 + hk) * 64 + dg * 8) * 1280 + 256 + t; }
#pragma unroll
        for (int j = 0; j < 8; ++j) dstp[(size_t)j * Sk] = (bf16_t)((j & 1) ? (raw[j >> 1] >> 16) : (raw[j >> 1] & 0xffffu));
        if (seq < 16) { float f[8]; unpack8(raw, f); float* o = p.out() + OUT_CV + ((((size_t)seq * 2 + l) * 256 + t) * 256) + hk * 64 + dg * 8;
            *(f32x4*)o = (f32x4){f[0], f[1], f[2], f[3]}; *(f32x4*)(o + 4) = (f32x4){f[4], f[5], f[6], f[7]}; }
    }
    bf16_t* ck = (bf16_t*)(p.ws() + OFF_CK);
    if (parts & 4)
    for (size_t e = gtid; e < (size_t)8 * 256 * 32; e += gsz) {
        const int c8 = (int)(e & 31), t = (int)((e >> 5) & 255), b = (int)(e >> 13);
        const float* src = p.in(2) + ((((size_t)b * 2 + l) * 256 + t) * 256) + c8 * 8;
        float f[8]; const f32x4 a = *(const f32x4*)src, bb = *(const f32x4*)(src + 4); f[0] = a[0]; f[1] = a[1]; f[2] = a[2]; f[3] = a[3]; f[4] = bb[0]; f[5] = bb[1]; f[6] = bb[2]; f[7] = bb[3];
        *(u32x4*)(ck + ((size_t)b * 256 + t) * 256 + c8 * 8) = pack8(f);
    }
    if (parts & 4)
    for (size_t e = gtid; e < (size_t)8 * 32 * 256; e += gsz) {
        const int t = (int)(e & 255), grp = (int)((e >> 8) & 31), b = (int)(e >> 13); const int hk = grp >> 3, dg = grp & 7;
        const float* src = p.in(3) + ((((size_t)b * 2 + l) * 256 + t) * 256) + hk * 64 + dg * 8;
        bf16_t* dstp = vT + VT_LAT_E + ((size_t)(b * 4 + hk) * 64 + dg * 8) * 1280 + t;
#pragma unroll
        for (int j = 0; j < 8; ++j) dstp[(size_t)j * 1280] = (bf16_t)(pk2(src[j], 0.f) & 0xffffu);
    }
    const bf16_t* up = slots + 4 * SLOT_E; bf16_t* dd = slots;
    if (parts & 8) {
#define POOL_GROUP(GI, WW) \
        for (size_t e = gtid; e < (size_t)MT * 32; e += gsz) { \
            const int c8 = (GI) * 32 + (int)(e & 31), m = (int)(e >> 5); const int s0 = seq_start(m), S = seq_len(m), t = m - s0; \
            u32x4 rv[WW]; \
            _Pragma("unroll") for (int k = 0; k < (WW); ++k) { int tt = t - (WW) / 2 + k; tt = tt < 0 ? 0 : (tt >= S ? S - 1 : tt); rv[k] = *(const u32x4*)(up + (size_t)(s0 + tt) * 1024 + c8 * 8); } \
            float sum[8] = {0, 0, 0, 0, 0, 0, 0, 0}, self[8]; int cnt = 0; \
            _Pragma("unroll") for (int k = 0; k < (WW); ++k) { const int tt = t - (WW) / 2 + k; const bool ok = tt >= 0 && tt < S; cnt += ok ? 1 : 0; float f[8]; unpack8(rv[k], f); \
                _Pragma("unroll") for (int j = 0; j < 8; ++j) sum[j] += ok ? f[j] : 0.f; } \
            unpack8(rv[(WW) / 2], self); \
            const float inv = 1.0f / (float)cnt; \
            _Pragma("unroll") for (int j = 0; j < 8; ++j) sum[j] = sum[j] * inv - self[j]; \
            *(u32x4*)(dd + (size_t)m * 1024 + c8 * 8) = pack8(sum); }
        POOL_GROUP(0, 2) POOL_GROUP(1, 4) POOL_GROUP(2, 8) POOL_GROUP(3, 16)
#undef POOL_GROUP
    }
}

DI void phase_e2(const KP p, int l, const bf16_t* z, int ntl, int j0, bf16_t* act) {
    const float* cw = p.in(29) + (size_t)l * 3 * 6144; const float* cb = p.in(30) + (size_t)l * 6144;
    const int ldz = ntl * 256;
    const int gtid = lbid() * 512 + ltid(), gsz = lgdim() * 512;
    const int per_m = ntl * 16, rpt = gsz / per_m;
    const int r = gtid % per_m, mrow0 = gtid / per_m; const int jl = r >> 4, cg8 = r & 15;
    if (mrow0 >= rpt) return;
    f32x4 wv[2][4][2];
#pragma unroll
    for (int h = 0; h < 2; ++h) { const int wcol = h * 3072 + (j0 + jl) * 128 + cg8 * 8;
#pragma unroll
        for (int q = 0; q < 2; ++q) { wv[h][0][q] = *(const f32x4*)(cb + wcol + q * 4); wv[h][1][q] = *(const f32x4*)(cw + wcol + q * 4); wv[h][2][q] = *(const f32x4*)(cw + 6144 + wcol + q * 4); wv[h][3][q] = *(const f32x4*)(cw + 2 * 6144 + wcol + q * 4); } }
    const u32x4 zero = (u32x4){0, 0, 0, 0};
    for (int mb = mrow0; mb < MT; mb += 2 * rpt) {
        u32x4 zr[2][2][3];
#pragma unroll
        for (int u = 0; u < 2; ++u) { const int m = mb + u * rpt; const bool ok = m < MT; const int mm = ok ? m : mb;
            const int s0 = seq_start(mm), S = seq_len(mm), t = mm - s0; const bool hp = t > 0, hn = t < S - 1;
#pragma unroll
            for (int h = 0; h < 2; ++h) { const bf16_t* zp = z + (size_t)mm * ldz + jl * 256 + h * 128 + cg8 * 8;
                zr[u][h][0] = hp ? *(const u32x4*)(zp - ldz) : zero; zr[u][h][1] = *(const u32x4*)zp; zr[u][h][2] = hn ? *(const u32x4*)(zp + ldz) : zero; } }
#pragma unroll
        for (int u = 0; u < 2; ++u) { const int m = mb + u * rpt; if (m >= MT) continue;
            float res[2][8];
#pragma unroll
            for (int h = 0; h < 2; ++h) { float z0[8], z1[8], z2[8]; unpack8(zr[u][h][0], z0); unpack8(zr[u][h][1], z1); unpack8(zr[u][h][2], z2);
#pragma unroll
                for (int j = 0; j < 8; ++j) res[h][j] = wv[h][0][j >> 2][j & 3] + wv[h][1][j >> 2][j & 3] * z0[j] + wv[h][2][j >> 2][j & 3] * z1[j] + wv[h][3][j >> 2][j & 3] * z2[j]; }
            float o[8];
#pragma unroll
            for (int j = 0; j < 8; ++j) o[j] = res[0][j] * sigmoidf_(res[0][j]) * res[1][j];
            *(u32x4*)(act + (size_t)m * 3072 + (j0 + jl) * 128 + cg8 * 8) = pack8(o); }
    }
}

DI int crow(int reg, int h) { return (reg & 3) + 8 * (reg >> 2) + 4 * h; }
DI float fsig(float x) { return __builtin_amdgcn_rcpf(1.0f + __builtin_amdgcn_exp2f(-1.4426950408889634f * x)); }
constexpr int L2_XW = 0, L2_SEG = 8 * 16 * 68 * 4, L2_CST = L2_SEG + 8192, L2_CW = L2_CST + 512, L2_WG = L2_CW + 1280, L2_RAW = L2_WG + 128 * 144, L2_END = L2_RAW + 8 * 19 * 64 * 2;
static_assert(L2_END <= 131072, "lds");
template <int DIR>
DI void lru_sweep(const KP p, int l, int seq, int n, unsigned char* shm, bool wet) {
    const int tid = ltid(), lane = tid & 63, wid = tid >> 6, l16 = lane & 15, kg = lane >> 4;
    const int S = seq < 16 ? 256 : 1024, m0 = seq < 16 ? seq * 256 : MCTX + (seq - 16) * 1024, nst = S >> 7;
    bf16_t* slots = (bf16_t*)(p.ws() + OFF_SLOTS);
    const bf16_t* xr = slots + 1 * SLOT_E + n * 64; const bf16_t* yv = slots + 2 * SLOT_E + n * 64; bf16_t* yo = slots + 4 * SLOT_E + n * 64;
    float* xw = (float*)(shm + L2_XW) + wid * 16 * 68; float* segs = (float*)(shm + L2_SEG); float* cst = (float*)(shm + L2_CST);
    bf16_t* wgl = (bf16_t*)(shm + L2_WG);
    { const bf16_t* wg = (const bf16_t*)(p.ws() + OFF_W + W_GATE) + ((size_t)n * 2 + DIR) * 128 * 64;
#pragma unroll
      for (int i = 0; i < 2; ++i) { const int pc = tid + i * 512, col = pc >> 3, part = pc & 7; *(u32x4*)(wgl + col * 72 + part * 8) = *(const u32x4*)(wg + col * 64 + part * 8); } }
    float br[4], bi[4], ls8[4];
#pragma unroll
    for (int cq = 0; cq < 4; ++cq) { const size_t o = ((size_t)l * 2 + DIR) * 1024 + n * 64 + cq * 16 + l16; br[cq] = p.in(16)[o]; bi[cq] = p.in(18)[o];
        ls8[cq] = -8.0f * 1.4426950408889634f * log1pf(expf(-p.in(19)[o])); }
    const float w0 = p.in(13)[((size_t)l * 4 + 0) * 1024 + n * 64 + lane], w1 = p.in(13)[((size_t)l * 4 + 1) * 1024 + n * 64 + lane], w2 = p.in(13)[((size_t)l * 4 + 2) * 1024 + n * 64 + lane],
                w3 = p.in(13)[((size_t)l * 4 + 3) * 1024 + n * 64 + lane], wb = p.in(14)[(size_t)l * 1024 + n * 64 + lane];
    if (tid < 64) cst[tid] = seq < 16 ? 0.f : p.in(4)[(((size_t)(seq - 16) * 2 + l) * 2 + DIR) * 1024 + n * 64 + tid];
    __syncthreads();
    bf16_t* rawt = (bf16_t*)(shm + L2_RAW) + wid * 19 * 64;
    u32x4 rr[3];
    auto load_raw = [&](int base) {
#pragma unroll
        for (int i = 0; i < 3; ++i) { const int pc = lane + i * 64, r = pc >> 3, part = pc & 7; const int tt = base + wid * 16 - 1 + r; rr[i] = (u32x4){0, 0, 0, 0};
            if (pc < 152 && tt >= 0 && tt < S) rr[i] = *(const u32x4*)(xr + (size_t)(m0 + tt) * 1024 + part * 8); } };
    load_raw(DIR == 0 ? 0 : (nst - 1) * 128);
#pragma unroll 1
    for (int s = 0; s < nst; ++s) {
        const int base = (DIR == 0 ? s : nst - 1 - s) * 128; const int par = s & 1;
        u32x4 yv4[2], tv4[2];
#pragma unroll
        for (int i = 0; i < 2; ++i) { const int pc = lane + i * 64; const size_t o = (size_t)(m0 + base + wid * 16 + (pc >> 3)) * 1024 + (pc & 7) * 8;
            yv4[i] = *(const u32x4*)(yv + o); tv4[i] = DIR == 1 ? *(const u32x4*)(yo + o) : (u32x4){0, 0, 0, 0}; }
#pragma unroll
        for (int i = 0; i < 3; ++i) { const int pc = lane + i * 64; if (pc < 152) *(u32x4*)(rawt + pc * 8) = rr[i]; }
        { float xf[19];
#pragma unroll
          for (int r = 0; r < 19; ++r) xf[r] = bflo((unsigned)rawt[r * 64 + lane]);
#pragma unroll
          for (int tk = 0; tk < 16; ++tk) xw[tk * 68 + lane] = wb + w0 * xf[tk] + w1 * xf[tk + 1] + w2 * xf[tk + 2] + w3 * xf[tk + 3]; }
        if (s + 1 < nst) load_raw((DIR == 0 ? s + 1 : nst - 2 - s) * 128);
        bf16x8 Af[2];
#pragma unroll
        for (int ks = 0; ks < 2; ++ks) { const f32x4 a0 = *(const f32x4*)(xw + l16 * 68 + ks * 32 + kg * 8), a1 = *(const f32x4*)(xw + l16 * 68 + ks * 32 + kg * 8 + 4);
            u32x4 pk; pk[0] = pk2(a0[0], a0[1]); pk[1] = pk2(a0[2], a0[3]); pk[2] = pk2(a1[0], a1[1]); pk[3] = pk2(a1[2], a1[3]); Af[ks] = __builtin_bit_cast(bf16x8, pk); }
        float hh[4][4], pp[4][4], Pl[4], Hl[4];
#pragma unroll
        for (int cq = 0; cq < 4; ++cq) { f32x4 ar = (f32x4){0.f, 0.f, 0.f, 0.f}, ai = (f32x4){0.f, 0.f, 0.f, 0.f};
#pragma unroll
            for (int ks = 0; ks < 2; ++ks) { const bf16x8 Br = *(const bf16x8*)(wgl + (cq * 16 + l16) * 72 + ks * 32 + kg * 8), Bi = *(const bf16x8*)(wgl + ((4 + cq) * 16 + l16) * 72 + ks * 32 + kg * 8);
                ar = __builtin_amdgcn_mfma_f32_16x16x32_bf16(Af[ks], Br, ar, 0, 0, 0); ai = __builtin_amdgcn_mfma_f32_16x16x32_bf16(Af[ks], Bi, ai, 0, 0, 0); }
            float H = 0.f, P = 1.f;
#pragma unroll
            for (int jj = 0; jj < 4; ++jj) { const int i = DIR == 0 ? jj : 3 - jj;
                const float r = fsig(ar[i] + br[cq]), ig = fsig(ai[i] + bi[cq]), x = xw[(kg * 4 + i) * 68 + cq * 16 + l16];
                const float a = __builtin_amdgcn_exp2f(r * ls8[cq]); const float u = __builtin_amdgcn_sqrtf(fmaf(-a, a, 1.0f)) * ig * x; H = fmaf(a, H, u); P *= a; hh[cq][i] = H; pp[cq][i] = P; }
            Pl[cq] = P; Hl[cq] = H; }
        float Pe[4], He[4];
#pragma unroll
        for (int cq = 0; cq < 4; ++cq) {
#pragma unroll
            for (int d = 1; d <= 2; d <<= 1) { const int src = (DIR == 0 ? lane - 16 * d : lane + 16 * d) & 63; const bool ok = DIR == 0 ? kg >= d : kg <= 3 - d;
                const float Pp = __shfl(Pl[cq], src), Hp = __shfl(Hl[cq], src);
                if (ok) { Hl[cq] = fmaf(Pl[cq], Hp, Hl[cq]); Pl[cq] *= Pp; } }
            const int src = (DIR == 0 ? lane - 16 : lane + 16) & 63; const bool ok = DIR == 0 ? kg >= 1 : kg <= 2;
            const float Pp = __shfl(Pl[cq], src), Hp = __shfl(Hl[cq], src); Pe[cq] = ok ? Pp : 1.0f; He[cq] = ok ? Hp : 0.0f; }
        if (kg == (DIR == 0 ? 3 : 0)) {
#pragma unroll
            for (int cq = 0; cq < 4; ++cq) { float* sp = segs + ((par * 8 + wid) * 64 + cq * 16 + l16) * 2; sp[0] = Pl[cq]; sp[1] = Hl[cq]; } }
        __syncthreads();
        float cwl = cst[par * 64 + lane];
        { float sP[8], sH[8];
#pragma unroll
          for (int w2 = 0; w2 < 8; ++w2) { const f32x2_t v = *(const f32x2_t*)(segs + ((par * 8 + w2) * 64 + lane) * 2); sP[w2] = v[0]; sH[w2] = v[1]; }
#pragma unroll
          for (int jj = 0; jj < 8; ++jj) { const int w2 = DIR == 0 ? jj : 7 - jj; const bool before = DIR == 0 ? w2 < wid : w2 > wid; if (before) cwl = fmaf(sP[w2], cwl, sH[w2]); } }
#pragma unroll
        for (int cq = 0; cq < 4; ++cq) { const int c = cq * 16 + l16; const float cwv = __shfl(cwl, c);
            const float cl = fmaf(Pe[cq], cwv, He[cq]);
#pragma unroll
            for (int i = 0; i < 4; ++i) hh[cq][i] = fmaf(pp[cq][i], cl, hh[cq][i]);
            if (wid == (DIR == 0 ? 7 : 0) && kg == (DIR == 0 ? 3 : 0)) cst[(par ^ 1) * 64 + c] = hh[cq][DIR == 0 ? 3 : 0];
#pragma unroll
            for (int i = 0; i < 4; ++i) xw[(kg * 4 + i) * 68 + c] = hh[cq][i];
        }
#pragma unroll
        for (int i = 0; i < 2; ++i) { const int pc = lane + i * 64, tk = pc >> 3, part = pc & 7; const f32x4 h0 = *(const f32x4*)(xw + tk * 68 + part * 8), h1 = *(const f32x4*)(xw + tk * 68 + part * 8 + 4);
            float y[8], t[8], o[8]; unpack8(yv4[i], y); unpack8(tv4[i], t);
#pragma unroll
            for (int e = 0; e < 4; ++e) { o[e] = fmaf(h0[e], y[e], t[e]); o[4 + e] = fmaf(h1[e], y[4 + e], t[4 + e]); }
            if (wet) *(u32x4*)(yo + (size_t)(m0 + base + wid * 16 + tk) * 1024 + part * 8) = pack8(o); }
    }
    __syncthreads();
    if (wet && seq < 16 && tid < 64) p.out()[OUT_ST + (((size_t)seq * 2 + l) * 2 + DIR) * 1024 + n * 64 + tid] = cst[(nst & 1) * 64 + tid];
    __syncthreads();
}
DI void lru_item(const KP p, int l, int seq, int n, unsigned char* shm, bool wet = true) {
    __syncthreads();
    lru_sweep<0>(p, l, seq, n, shm, wet);
    lru_sweep<1>(p, l, seq, n, shm, wet);
}

DI void attn_item(const KP p, int l, int seq, int hk, int qb, unsigned char* shm, bool wet = true) {
    const int tid = ltid(), lane = tid & 63, wid = tid >> 6, h = lane >> 5, l32 = lane & 31;
    const bool lat = seq >= 16; const int m0 = lat ? MCTX + (seq - 16) * 1024 : seq * 256; const int Sk = lat ? 1280 : 256, nt = Sk >> 6;
    bf16_t* slots = (bf16_t*)(p.ws() + OFF_SLOTS); bf16_t* qbuf = slots + 3 * SLOT_E;
    const bf16_t* kraw = (const bf16_t*)(p.ws() + OFF_KRAW); const bf16_t* ck = (const bf16_t*)(p.ws() + OFF_CK);
    const bf16_t* vT = (const bf16_t*)(p.ws() + OFF_VT) + (lat ? VT_LAT_E + (size_t)((seq - 16) * 4 + hk) * 64 * 1280 : (size_t)(seq * 4 + hk) * 64 * 256);
    bf16_t* Kt = (bf16_t*)shm; bf16_t* Vt = (bf16_t*)(shm + 4 * 9216);
    const int head = hk * 4 + (wid >> 1); const int mq = m0 + qb * 64 + (wid & 1) * 32 + l32;
    bf16x8 Qf[4];
    { float qv[4][8]; float ss = 0.f;
#pragma unroll
      for (int ks = 0; ks < 4; ++ks) { unpack8(*(const u32x4*)(qbuf + (size_t)mq * 1024 + head * 64 + ks * 16 + h * 8), qv[ks]);
#pragma unroll
          for (int j = 0; j < 8; ++j) ss += qv[ks][j] * qv[ks][j]; }
      ss += __shfl_xor(ss, 32);
      const float rs = rsqrtf(ss * (1.0f / 64.0f) + 1e-6f);
      const float* gq = p.in(20) + l * 64 + h * 8;
#pragma unroll
      for (int ks = 0; ks < 4; ++ks) { const f32x4 g0 = *(const f32x4*)(gq + ks * 16), g1 = *(const f32x4*)(gq + ks * 16 + 4);
#pragma unroll
          for (int j = 0; j < 4; ++j) { qv[ks][j] *= rs * g0[j]; qv[ks][4 + j] *= rs * g1[j]; } }
      if (lat) { const int t = mq - m0;
#pragma unroll
          for (int j = 0; j < 8; ++j) { const float inv = exp2f(-(float)(h * 8 + j) * (13.287712379549449f / 16.0f));
              const float ar = (float)(t >> 6) * inv, ac = (float)(t & 63) * inv; const float cr = __cosf(ar), sr = __sinf(ar), cc = __cosf(ac), sc = __sinf(ac);
              const float a1 = qv[0][j], a2 = qv[1][j], b1 = qv[2][j], b2 = qv[3][j];
              qv[0][j] = a1 * cr - a2 * sr; qv[1][j] = a1 * sr + a2 * cr; qv[2][j] = b1 * cc - b2 * sc; qv[3][j] = b1 * sc + b2 * cc; } }
#pragma unroll
      for (int ks = 0; ks < 4; ++ks) Qf[ks] = __builtin_bit_cast(bf16x8, pack8(qv[ks])); }
    float offs;
    { float qq = 0.f;
#pragma unroll
      for (int ks = 0; ks < 4; ++ks)
#pragma unroll
          for (int j = 0; j < 8; ++j) { const float v = __uint_as_float(((unsigned)(unsigned short)Qf[ks][j]) << 16); qq += v * v; }
      qq += __shfl_xor(qq, 32);
      const float* kb = (const float*)(p.ws() + OFF_KMAX); float kmx = kb[64 + l]; if (lat) kmx = fmaxf(kmx, kb[(l * 8 + (seq - 16)) * 4 + hk]);
      offs = 1.01f * 0.125f * 1.4426950408889634f * sqrtf(qq * kmx); }
    const int lr = tid >> 3, lp = tid & 7;
    auto kaddr = [&](int kt) -> const bf16_t* { if (lat) { return kt < 4 ? ck + ((size_t)(seq - 16) * 256 + kt * 64 + lr) * 256 + hk * 64 + lp * 8 : kraw + (size_t)(m0 + (kt - 4) * 64 + lr) * 256 + hk * 64 + lp * 8; }
                                                  return kraw + (size_t)(m0 + kt * 64 + lr) * 256 + hk * 64 + lp * 8; };
    u32x4 kA = *(const u32x4*)kaddr(0), vA = *(const u32x4*)(vT + (size_t)lr * Sk + lp * 8);
    u32x4 kB = *(const u32x4*)kaddr(1), vB = *(const u32x4*)(vT + (size_t)lr * Sk + 64 + lp * 8);
    f32x16 O0, O1;
#pragma unroll
    for (int r = 0; r < 16; ++r) { O0[r] = 0.f; O1[r] = 0.f; }
    float lrun = 0.f; const float cs = 0.125f * 1.4426950408889634f;
    auto compute = [&](const bf16_t* Kb, const bf16_t* Vb) {
        f32x16 st0, st1;
#pragma unroll
        for (int r = 0; r < 16; ++r) { st0[r] = 0.f; st1[r] = 0.f; }
        bf16x8 ka[4][2];
#pragma unroll
        for (int ks = 0; ks < 4; ++ks) { ka[ks][0] = *(const bf16x8*)(Kb + (l32) * 72 + ks * 16 + h * 8); ka[ks][1] = *(const bf16x8*)(Kb + (32 + l32) * 72 + ks * 16 + h * 8); }
        __builtin_amdgcn_s_setprio(1);
#pragma unroll
        for (int ks = 0; ks < 4; ++ks) { st0 = __builtin_amdgcn_mfma_f32_32x32x16_bf16(ka[ks][0], Qf[ks], st0, 0, 0, 0); st1 = __builtin_amdgcn_mfma_f32_32x32x16_bf16(ka[ks][1], Qf[ks], st1, 0, 0, 0); }
        __builtin_amdgcn_s_setprio(0);
        float psum = 0.f;
#pragma unroll
        for (int r = 0; r < 16; ++r) { const float p0 = __builtin_amdgcn_exp2f(fmaf(st0[r], cs, -offs)), p1 = __builtin_amdgcn_exp2f(fmaf(st1[r], cs, -offs)); st0[r] = p0; st1[r] = p1; psum += p0 + p1; }
        lrun += psum;
#pragma unroll
        for (int kb = 0; kb < 2; ++kb)
#pragma unroll
            for (int s = 0; s < 2; ++s) {
                u32x4 pb;
                if (kb == 0) { pb[0] = pk2(st0[8 * s + 0], st0[8 * s + 1]); pb[1] = pk2(st0[8 * s + 2], st0[8 * s + 3]); pb[2] = pk2(st0[8 * s + 4], st0[8 * s + 5]); pb[3] = pk2(st0[8 * s + 6], st0[8 * s + 7]); }
                else { pb[0] = pk2(st1[8 * s + 0], st1[8 * s + 1]); pb[1] = pk2(st1[8 * s + 2], st1[8 * s + 3]); pb[2] = pk2(st1[8 * s + 4], st1[8 * s + 5]); pb[3] = pk2(st1[8 * s + 6], st1[8 * s + 7]); }
                const bf16x8 Pb = __builtin_bit_cast(bf16x8, pb);
                { const bf16_t* vp = Vb + (l32) * 68 + kb * 32 + 16 * s + 4 * h; const u32x2 v0 = *(const u32x2*)vp, v1 = *(const u32x2*)(vp + 8); u32x4 va; va[0] = v0[0]; va[1] = v0[1]; va[2] = v1[0]; va[3] = v1[1];
                  O0 = __builtin_amdgcn_mfma_f32_32x32x16_bf16(__builtin_bit_cast(bf16x8, va), Pb, O0, 0, 0, 0); }
                { const bf16_t* vp = Vb + (32 + l32) * 68 + kb * 32 + 16 * s + 4 * h; const u32x2 v0 = *(const u32x2*)vp, v1 = *(const u32x2*)(vp + 8); u32x4 va; va[0] = v0[0]; va[1] = v0[1]; va[2] = v1[0]; va[3] = v1[1];
                  O1 = __builtin_amdgcn_mfma_f32_32x32x16_bf16(__builtin_bit_cast(bf16x8, va), Pb, O1, 0, 0, 0); }
            }
    };
#pragma unroll 1
    for (int it = 0; it < (nt >> 1); ++it) {
        const int sb = (it & 1) * 2; bf16_t* K0 = Kt + sb * 4608; bf16_t* K1 = K0 + 4608; bf16_t* V0 = Vt + sb * 4352; bf16_t* V1 = V0 + 4352;
        *(u32x4*)(K0 + lr * 72 + lp * 8) = kA; *(u32x4*)(K1 + lr * 72 + lp * 8) = kB;
        { u32x2 w0, w1; w0[0] = vA[0]; w0[1] = vA[1]; w1[0] = vA[2]; w1[1] = vA[3]; *(u32x2*)(V0 + lr * 68 + lp * 8) = w0; *(u32x2*)(V0 + lr * 68 + lp * 8 + 4) = w1; }
        { u32x2 w0, w1; w0[0] = vB[0]; w0[1] = vB[1]; w1[0] = vB[2]; w1[1] = vB[3]; *(u32x2*)(V1 + lr * 68 + lp * 8) = w0; *(u32x2*)(V1 + lr * 68 + lp * 8 + 4) = w1; }
        __syncthreads();
        const int kt = it * 2;
        if (kt + 2 < nt) { kA = *(const u32x4*)kaddr(kt + 2); vA = *(const u32x4*)(vT + (size_t)lr * Sk + (kt + 2) * 64 + lp * 8);
                           kB = *(const u32x4*)kaddr(kt + 3); vB = *(const u32x4*)(vT + (size_t)lr * Sk + (kt + 3) * 64 + lp * 8); }
        compute(K0, V0);
        compute(K1, V1);
    }
    const float ltot = lrun + __shfl_xor(lrun, 32); const float inv = 1.0f / ltot;
    if (wet)
#pragma unroll
    for (int rg = 0; rg < 4; ++rg) { const int d = 8 * rg + 4 * h; u32x2 o;
        o[0] = pk2(O0[4 * rg] * inv, O0[4 * rg + 1] * inv); o[1] = pk2(O0[4 * rg + 2] * inv, O0[4 * rg + 3] * inv); *(u32x2*)(qbuf + (size_t)mq * 1024 + head * 64 + d) = o;
        o[0] = pk2(O1[4 * rg] * inv, O1[4 * rg + 1] * inv); o[1] = pk2(O1[4 * rg + 2] * inv, O1[4 * rg + 3] * inv); *(u32x2*)(qbuf + (size_t)mq * 1024 + head * 64 + 32 + d) = o; }
    __syncthreads();
}

__global__ void __launch_bounds__(512) mega(Params p_unused) {
    KP p = fresh_kp();
    extern __shared__ __attribute__((aligned(16))) unsigned char shm[];
    cg::grid_group grid = cg::this_grid();
    LAS unsigned char* lds = (LAS unsigned char*)shm;
    bf16_t* slots = (bf16_t*)(p.ws() + OFF_SLOTS); unsigned char* W = p.ws() + OFF_W;
    const int G = lgdim(), c = lbid();
    if (lbid() < 0) grid.sync();
    gbar_post(p, shm);
    phase_mod(p, shm);
    phase_kbound(p, shm);
    phase_weights(p, 0, shm);
#if EXP == 5
    phase_mod(p, shm); phase_weights(p, 0, shm);
#endif
    gbar(p, shm); p = fresh_kp();
#pragma unroll 1
    for (int l = 0; l < 2; ++l) {
        const float* modl = (const float*)(p.ws() + OFF_MOD) + (size_t)l * 9 * 6144;
        if (l == 0) phase_norm(p, 0, true, p.in(7), 0, 1024, slots, false);
        else phase_weights(p, 1, shm);
#if EXP == 1
        for (int r = 0; r < 12; ++r) gbar(p, shm);
#endif
        gbar(p, shm); p = fresh_kp();
        { pg8::Gemm g{slots, (const bf16_t*)(W + W_IN), 1024, 1024, 1024, 48, 30, 1, 0, 0, 0, 0, 0};
          EpiInProj E{slots, (bf16_t*)(p.ws() + OFF_KRAW), (bf16_t*)(p.ws() + OFF_VRAW), p.in(12) + (size_t)l * 3072};
          pg8::gemm_phase(lds, g, E);
#if EXP == 4
          __syncthreads(); pg8::gemm_phase(lds, g, E);
#endif
        }
        gbar(p, shm); p = fresh_kp();
        phase_e1_elem(p, l, shm);
#if EXP == 8
        __syncthreads(); phase_e1_elem(p, l, shm, 14);
#endif
        gbar(p, shm); p = fresh_kp();
        { pg8::Gemm g{slots, (const bf16_t*)(W + W_POOL), 1024, 256, 256, 48, 4, 1, 0, 256, 0, 0, 0};
          EpiScaleBf16 E{slots, 1024, 0, p.in(23) + (size_t)l * 1024};
          if (G != 256) pg8::gemm_phase(lds, g, E); else if (c >= 128) pg8::gemm_phase(lds, g, E, 128, c - 128); }
        __syncthreads();
#if EXP == 3
        { const bool dry = lbid() < 0;
          if (c < 128) lru_item(p, l, 16 + (c >> 4), c & 15, shm, dry); else { for (int k = 0; k < 2; ++k) { const int it = (c - 128) * 2 + k; lru_item(p, l, it >> 4, it & 15, shm, dry); } } }
#endif
        if (G == 256) { if (c < 128) lru_item(p, l, 16 + (c >> 4), c & 15, shm); else { for (int k = 0; k < 2; ++k) { const int it = (c - 128) * 2 + k; lru_item(p, l, it >> 4, it & 15, shm); } } }
        else for (int it = c; it < 384; it += G) { if (it < 128) lru_item(p, l, 16 + (it >> 4), it & 15, shm); else lru_item(p, l, (it - 128) >> 4, (it - 128) & 15, shm); }
        if (G == 256) {
            for (int it = c; it < 512; it += 256) attn_item(p, l, 16 + (it >> 6), (it >> 4) & 3, it & 15, shm);
            if (c >= 128) for (int k = 0; k < 2; ++k) { const int j = (c - 128) * 2 + k; attn_item(p, l, j >> 4, (j >> 2) & 3, j & 3, shm); }
        } else
        for (int it = c; it < 768; it += G) { if (it < 512) attn_item(p, l, 16 + (it >> 6), (it >> 4) & 3, it & 15, shm); else { const int j = it - 512; attn_item(p, l, j >> 4, (j >> 2) & 3, j & 3, shm); } }
        gbar(p, shm); p = fresh_kp();
        { pg8::Gemm g{slots + 4 * SLOT_E, (const bf16_t*)(W + W_BR), 1024, 1024, 1024, 48, 4, 1, 0, 0, -(long)SLOT_E, -4 * (long)SLOT_E, (long)1024 * 1024};
          EpiMerge E{slots + 5 * SLOT_E, false};
#if EXP == 9
          { EpiMerge E2{slots + 5 * SLOT_E, lbid() >= 0}; pg8::gemm_phase(lds, g, E2); __syncthreads(); }
#endif
          pg8::gemm_phase(lds, g, E); }
        gbar(p, shm); p = fresh_kp();
        { pg8::Gemm g{slots + 7 * SLOT_E, (const bf16_t*)(W + W_O), 1024, 1024, 1024, 48, 4, 1, 0, 0, 0, 0, 0};
          EpiResidNorm E{p.out(), modl, 2048, 0, p.in(8) + l * 1024, modl, 3072, 4096, slots, (float*)(p.ws() + OFF_RSS), (unsigned*)(p.ws() + OFF_CNT) + (l * 2 + 0) * 48, (unsigned*)(p.ws() + OFF_BAR), (float*)(shm + 131072 + 16)};
          pg8::gemm_phase(lds, g, E); }
        gbar(p, shm); p = fresh_kp();
        { pg8::Gemm g{slots, (const bf16_t*)(W + W_UP), 1024, 1024, 1024, 48, 24, 1, 0, 0, 0, 0, 0};
          float* zedge = (float*)(slots + 1 * SLOT_E); float* zpart = zedge + (size_t)192 * 2 * 6144;
          EpiUpFused E{slots + 5 * SLOT_E, zedge, zpart, p.in(29) + (size_t)l * 3 * 6144, p.in(30) + (size_t)l * 6144};
          pg8::gemm_phase(lds, g, E); }
        gbar(p, shm); p = fresh_kp();
        { pg8::Gemm g{slots + 5 * SLOT_E, (const bf16_t*)(W + W_DOWN), 3072, 3072, 3072, 48, 4, 1, 0, 0, 0, 0, 0};
          { Unit u0; if (pg8::next_unit(g, 0, G, c, u0)) { const float* zedge = (const float*)(slots + 1 * SLOT_E);
              ffn_fixup(u0.pm, slots + 5 * SLOT_E, zedge, zedge + (size_t)192 * 2 * 6144, p.in(29) + (size_t)l * 3 * 6144, p.in(30) + (size_t)l * 6144); } }
          const float* modn = (const float*)(p.ws() + OFF_MOD) + (size_t)9 * 6144;
          EpiResidNorm E{p.out(), modl, 5120, l == 0 ? 0 : 1, l == 0 ? p.in(7) + 1024 : p.in(32), modn, 0, 1024, slots, (float*)(p.ws() + OFF_RSS), (unsigned*)(p.ws() + OFF_CNT) + (l * 2 + 1) * 48, (unsigned*)(p.ws() + OFF_BAR), (float*)(shm + 131072 + 16)};
          pg8::gemm_phase(lds, g, E); }
        gbar(p, shm); p = fresh_kp();
    }
}

extern "C" void kernel_launch(void* const* d_in, const int* in_sizes, int n_in, void* d_out, int out_size, void* d_ws, size_t ws_size, hipStream_t stream) {
    static int grid_blocks = 0;
    if (!grid_blocks) {
        int dev = 0, cus = 0, per_cu = 0;
        (void)hipGetDevice(&dev);
        (void)hipDeviceGetAttribute(&cus, hipDeviceAttributeMultiprocessorCount, dev);
        if (hipFuncSetAttribute((const void*)mega, hipFuncAttributeMaxDynamicSharedMemorySize, LDS_BYTES) != hipSuccess) { fprintf(stderr, "setattr failed\n"); return; }
        if (hipOccupancyMaxActiveBlocksPerMultiprocessor(&per_cu, (const void*)mega, 512, LDS_BYTES) != hipSuccess || per_cu < 1) { fprintf(stderr, "occupancy query failed\n"); return; }
        grid_blocks = cus;
    }
    if (ws_size < WS_NEED || n_in < 33) { fprintf(stderr, "workspace too small: %zu < %zu\n", ws_size, (size_t)WS_NEED); return; }
    Params p{};
    for (int i = 0; i < 33; ++i) p.in[i] = (const float*)d_in[i];
    p.out = (float*)d_out; p.ws = (unsigned char*)d_ws;
    (void)hipMemsetAsync((unsigned char*)d_ws + OFF_BAR, 0, (size_t)XCD_BAR_WORDS * 4 + 256 * 4 + 256 * 4, stream);
    void* args[] = {&p};
    hipError_t e = hipLaunchCooperativeKernel((void*)mega, dim3(grid_blocks), dim3(512), args, LDS_BYTES, stream);
    if (e != hipSuccess) fprintf(stderr, "cooperative launch failed: %s (grid %d)\n", hipGetErrorString(e), grid_blocks);
}
```

```cpp
#include <hip/hip_runtime.h>
#include <hip/hip_cooperative_groups.h>
#include <cstdio>
namespace cg = cooperative_groups;

#define LAS __attribute__((address_space(3)))
#define DI __device__ __forceinline__
typedef unsigned short bf16_t;
typedef short bf16x8 __attribute__((ext_vector_type(8)));
typedef float f32x4 __attribute__((ext_vector_type(4)));
typedef float f32x16 __attribute__((ext_vector_type(16)));
typedef unsigned u32x4 __attribute__((ext_vector_type(4)));
typedef unsigned u32x2 __attribute__((ext_vector_type(2)));
typedef float f32x2_t __attribute__((ext_vector_type(2)));
typedef __bf16 bfx2 __attribute__((ext_vector_type(2)));

constexpr int MT = 12288, MCTX = 4096, DM = 1024;
constexpr size_t SLOT_E = (size_t)MT * 1024;
constexpr size_t SLOT_B = SLOT_E * 2;
constexpr size_t OFF_SLOTS = 0;
constexpr size_t OFF_KRAW = 8 * SLOT_B;
constexpr size_t OFF_VRAW = OFF_KRAW + (size_t)MT * 256 * 2;
constexpr size_t OFF_CK = OFF_VRAW + (size_t)MT * 256 * 2;
constexpr size_t OFF_VT = OFF_CK + (size_t)8 * 256 * 256 * 2;
constexpr size_t VT_LAT_E = (size_t)16 * 4 * 64 * 256;
constexpr size_t OFF_W = OFF_VT + ((size_t)16 * 4 * 64 * 256 + (size_t)8 * 4 * 64 * 1280) * 2;
constexpr size_t W_IN = 0, W_BR = W_IN + (size_t)7680 * 1024 * 2, W_O = W_BR + (size_t)3 * 1024 * 1024 * 2, W_UP = W_O + (size_t)1024 * 1024 * 2,
                 W_DOWN = W_UP + (size_t)6144 * 1024 * 2, W_POOL = W_DOWN + (size_t)1024 * 3072 * 2, W_GATE = W_POOL + (size_t)1024 * 256 * 2, W_END = W_GATE + (size_t)16 * 2 * 128 * 64 * 2;
constexpr size_t OFF_MOD = OFF_W + W_END;
constexpr size_t OFF_BAR = OFF_MOD + (size_t)2 * 9 * 6144 * 4;
constexpr int XCD_BAR_WORDS = 3456;
constexpr size_t OFF_KMAX = OFF_BAR + (size_t)XCD_BAR_WORDS * 4;
constexpr size_t OFF_CNT = OFF_KMAX + 256 * 4;
constexpr size_t OFF_RSS = OFF_CNT + 256 * 4;
constexpr size_t WS_NEED = OFF_RSS + (size_t)MT * 16 * 4;
#ifndef EXP
#define EXP 0
#endif
constexpr int LDS_BYTES = 131072 + 16 + 4096;
constexpr size_t OUT_CK = (size_t)MT * 1024, OUT_CV = OUT_CK + (size_t)16 * 2 * 256 * 256, OUT_ST = OUT_CV + (size_t)16 * 2 * 256 * 256;

struct Params { const float* in[33]; float* out; unsigned char* ws; };
typedef const __attribute__((address_space(4))) unsigned char* kptr_t;
struct KP { kptr_t k;
    DI const float* in(int i) const { return *(const float* const __attribute__((address_space(4)))*)(k + 8 * i); }
    DI float* out() const { return *(float* const __attribute__((address_space(4)))*)(k + 8 * 33); }
    DI unsigned char* ws() const { return *(unsigned char* const __attribute__((address_space(4)))*)(k + 8 * 34); } };
DI KP fresh_kp() { kptr_t k = (kptr_t)__builtin_amdgcn_kernarg_segment_ptr(); asm volatile("" : "+s"(k)); KP p; p.k = k; return p; }
DI int ltid() { int t = threadIdx.x; asm volatile("" : "+v"(t)); return t; }
DI int lbid() { int t = blockIdx.x; asm volatile("" : "+s"(t)); return t; }
DI int lgdim() { int t = gridDim.x; asm volatile("" : "+s"(t)); return t; }

DI unsigned pk2(float a, float b) { bfx2 v; v[0] = (__bf16)a; v[1] = (__bf16)b; return __builtin_bit_cast(unsigned, v); }
DI float bflo(unsigned u) { return __uint_as_float(u << 16); }
DI float bfhi(unsigned u) { return __uint_as_float(u & 0xffff0000u); }
DI void unpack8(u32x4 v, float* f) { f[0] = bflo(v[0]); f[1] = bfhi(v[0]); f[2] = bflo(v[1]); f[3] = bfhi(v[1]); f[4] = bflo(v[2]); f[5] = bfhi(v[2]); f[6] = bflo(v[3]); f[7] = bfhi(v[3]); }
DI u32x4 pack8(const float* f) { u32x4 r; r[0] = pk2(f[0], f[1]); r[1] = pk2(f[2], f[3]); r[2] = pk2(f[4], f[5]); r[3] = pk2(f[6], f[7]); return r; }
DI float sigmoidf_(float x) { return __builtin_amdgcn_rcpf(1.0f + __builtin_amdgcn_exp2f(-1.4426950408889634f * x)); }
DI float gelu_tanh(float x) { const float z = 0.7978845608028654f * (x + 0.044715f * x * x * x); return x * sigmoidf_(2.0f * z); }
DI int seq_start(int m) { return m < MCTX ? (m & ~255) : (MCTX + ((m - MCTX) & ~1023)); }
DI int seq_len(int m) { return m < MCTX ? 256 : 1024; }
DI int mod_row(int m) { return m < MCTX ? 0 : 1 + ((m - MCTX) >> 10); }

namespace pg8 {
constexpr int BM = 256, BK = 64, HALF = 128, HTB = HALF * BK * 2, STAGE_BYTES = 8 * HTB, NXCD = 8, WGM = 8;
DI int lds_byte(int r, int c) { const int st = (r >> 4) * 2 + (c >> 5), rr = r & 15, cc = c & 31, ob = rr * 64 + cc * 2; return st * 1024 + (ob ^ (((ob >> 9) & 1) << 5)); }
DI void stage_rc(int b, int& R, int& C) { const int st = b / 1024, sb = b % 1024, swz = sb ^ (((sb >> 9) & 1) << 5); R = (st >> 1) * 16 + swz / 64; C = (st & 1) * 32 + (swz % 64) / 2; }
DI int perm32(int rho) { const int n = rho >> 4, i = rho & 15; return 8 * (i >> 2) + 4 * n + (i & 3); }
struct Unit { int pm, pn, seg; };
struct Gemm { const bf16_t* A; const bf16_t* Bt; int lda, ldb, K; int nM, nN, nSeg, pn0; long a_pn_stride, a_seg1, a_seg2, b_seg_stride; };
DI bool next_unit(const Gemm& g, int i, int G, int c, Unit& u) {
    const int nwg = g.nM * g.nN; const int it = i / g.nSeg; u.seg = i - it * g.nSeg;
    const long L = (long)it * G + c; if (L >= nwg) return false;
    int wgid = (int)L; { const int q = nwg / NXCD, r = nwg % NXCD, xcd = wgid % NXCD, off = wgid / NXCD; wgid = (xcd < r ? xcd * (q + 1) : r * (q + 1) + (xcd - r) * q) + off; }
    const int nig = WGM * g.nN, gid = wgid / nig, fm = gid * WGM, gsz = (g.nM - fm) < WGM ? (g.nM - fm) : WGM;
    u.pm = fm + ((wgid % nig) % gsz); u.pn = (wgid % nig) / gsz; return true;
}
DI const char* a_ptr(const Gemm& g, const Unit& u) { return (const char*)(g.A + (size_t)u.pm * 256 * g.lda + (size_t)u.pn * g.a_pn_stride + (u.seg == 0 ? 0 : (u.seg == 1 ? g.a_seg1 : g.a_seg2))); }
DI const char* b_ptr(const Gemm& g, const Unit& u) { return (const char*)(g.Bt + (size_t)(g.pn0 + u.pn) * 256 * g.ldb + (size_t)u.seg * g.b_seg_stride); }

template <class Epi>
DI void gemm_phase(LAS unsigned char* lds, const Gemm g, const Epi& E, int Gv = 0, int cv = 0) {
    const int tid = ltid(), wid = __builtin_amdgcn_readfirstlane(tid >> 6), lane = tid & 63, wr = wid >> 2, wc = wid & 3, fr = lane & 15, fq = lane >> 4;
    constexpr bool MERGE = Epi::MERGE;
    const int K = g.K, nt = MERGE ? 3 * (K / BK) : K / BK; const int G = Gv > 0 ? Gv : lgdim(), c = Gv > 0 ? cv : lbid();
    unsigned voffA[2], voffB[2];
#pragma unroll
    for (int i = 0; i < 2; ++i) { int R, C; stage_rc(tid * 16 + i * 8192, R, C); const int Rb = Epi::PERM ? ((R & ~31) + perm32(R & 31)) : R;
        voffA[i] = (unsigned)(R * g.lda + C) * 2u; voffB[i] = (unsigned)(Rb * g.ldb + C) * 2u; }
    const size_t kstep = (size_t)(BK * 2);
    const size_t hstepA = (size_t)HALF * g.lda * 2, hstepB = (size_t)HALF * g.ldb * 2;
    const unsigned ldsw = (unsigned)wid * 1024u;
    const int aoff = lds_byte(wr * 64 + fr, fq * 8), boff = lds_byte(wc * 32 + fr, fq * 8);
#define PG8_SA(b, h) (((b) * 2 + (h)) * HTB)
#define PG8_SB(b, h) ((4 + (b) * 2 + (h)) * HTB)
#define PG8_STAGE(bufoff, gbase, voff) do { _Pragma("unroll") for (int _i = 0; _i < 2; ++_i) \
        __builtin_amdgcn_global_load_lds((const unsigned*)((const char*)(gbase) + (voff)[_i]), (LAS unsigned*)(lds + (bufoff) + ldsw + _i * 8192), 16, 0, 0); } while (0)
#define PG8_LDA(dst, b, h) do { _Pragma("unroll") for (int m = 0; m < 4; ++m) _Pragma("unroll") for (int k = 0; k < 2; ++k) dst[m][k] = *(const LAS bf16x8*)(lds + PG8_SA(b, h) + aoff + m * 2048 + k * 1024); } while (0)
#define PG8_LDB(dst, b, h) do { _Pragma("unroll") for (int n = 0; n < 2; ++n) _Pragma("unroll") for (int k = 0; k < 2; ++k) dst[n][k] = *(const LAS bf16x8*)(lds + PG8_SB(b, h) + boff + n * 2048 + k * 1024); } while (0)
#define PG8_MMA(ai, bj, At, Bt) do { __builtin_amdgcn_s_setprio(1); _Pragma("unroll") for (int m = 0; m < 4; ++m) _Pragma("unroll") for (int n = 0; n < 2; ++n) _Pragma("unroll") for (int k = 0; k < 2; ++k) \
        acc[ai][bj][m][n] = __builtin_amdgcn_mfma_f32_16x16x32_bf16(Bt[n][k], At[m][k], acc[ai][bj][m][n], 0, 0, 0); __builtin_amdgcn_s_setprio(0); } while (0)
#define PG8_WAIT_V(n) asm volatile("s_waitcnt vmcnt(" #n ")" ::: "memory")
#define PG8_WAIT_L(n) asm volatile("s_waitcnt lgkmcnt(" #n ")" ::: "memory")
#define PG8_BAR __builtin_amdgcn_s_barrier()
#define PG8_SCHED __builtin_amdgcn_sched_barrier(0)
    Unit cur, nxt; int ui = 0;
    if (!next_unit(g, 0, G, c, cur)) return;
    f32x4 acc[2][2][4][2];
#pragma unroll
    for (int a = 0; a < 2; ++a)
#pragma unroll
        for (int b = 0; b < 2; ++b)
#pragma unroll
            for (int m = 0; m < 4; ++m)
#pragma unroll
                for (int n = 0; n < 2; ++n) acc[a][b][m][n] = (f32x4){0.f, 0.f, 0.f, 0.f};
    bf16x8 At[4][2], B0[2][2], B1[2][2];
    const char* cA = a_ptr(g, cur); const char* cB = b_ptr(g, cur);
    PG8_STAGE(PG8_SB(0, 0), cB, voffB); PG8_STAGE(PG8_SA(0, 0), cA, voffA); PG8_STAGE(PG8_SB(0, 1), cB + hstepB, voffB); PG8_STAGE(PG8_SA(0, 1), cA + hstepA, voffA);
    if (wr == 1) PG8_BAR;
    PG8_WAIT_V(4); PG8_BAR;
    PG8_STAGE(PG8_SB(1, 0), cB + kstep, voffB); PG8_STAGE(PG8_SA(1, 0), cA + kstep, voffA); PG8_STAGE(PG8_SB(1, 1), cB + hstepB + kstep, voffB);
    PG8_WAIT_V(6); PG8_BAR;
    for (;;) {
        const bool has_next = next_unit(g, ui + 1, G, c, nxt);
        const char* nA = has_next ? a_ptr(g, nxt) : cA; const char* nB = has_next ? b_ptr(g, nxt) : cB;
        for (int t = 0; t < nt; t += 2) {
            const bool last = (t == nt - 2);
            const char* a1; const char* a2; const char* b2; const char* a3; const char* b3;
            if constexpr (!MERGE) { a1 = cA + (size_t)(t + 1) * kstep; a2 = last ? nA : cA + (size_t)(t + 2) * kstep; b2 = last ? nB : cB + (size_t)(t + 2) * kstep; }
            else { const int ntk = K / BK; const int sg1 = (t + 1) / ntk, sg2 = (t + 2) / ntk;
                a1 = cA + (sg1 == 0 ? 0 : (sg1 == 1 ? g.a_seg1 : g.a_seg2)) * 2 + (size_t)(t + 1 - sg1 * ntk) * kstep;
                a2 = last ? nA : cA + (sg2 == 0 ? 0 : (sg2 == 1 ? g.a_seg1 : g.a_seg2)) * 2 + (size_t)(t + 2 - sg2 * ntk) * kstep;
                b2 = last ? nB : cB + (size_t)sg2 * g.b_seg_stride * 2 + (size_t)(t + 2 - sg2 * ntk) * kstep;
                if (t > 0 && t % ntk == 0) E.rescale(acc, cur, t / ntk, wr, wc, fr, fq); }
            a3 = a2 + kstep; b3 = b2 + kstep;
            PG8_LDB(B0, 0, 0); PG8_SCHED; PG8_LDA(At, 0, 0); PG8_STAGE(PG8_SA(1, 1), a1 + hstepA, voffA);
            PG8_WAIT_L(8); PG8_BAR; PG8_WAIT_L(0); PG8_MMA(0, 0, At, B0); PG8_BAR; PG8_SCHED;
            PG8_LDB(B1, 0, 1); PG8_STAGE(PG8_SB(0, 0), b2, voffB);
            PG8_BAR; PG8_WAIT_L(0); PG8_MMA(0, 1, At, B1); PG8_BAR;
            PG8_LDA(At, 0, 1); PG8_STAGE(PG8_SA(0, 0), a2, voffA);
            PG8_BAR; PG8_WAIT_L(0); PG8_MMA(1, 0, At, B0); PG8_BAR; PG8_SCHED;
            PG8_STAGE(PG8_SB(0, 1), b2 + hstepB, voffB);
            PG8_WAIT_V(6); PG8_BAR; PG8_MMA(1, 1, At, B1); PG8_BAR;
            PG8_LDB(B0, 1, 0); PG8_SCHED; PG8_LDA(At, 1, 0); PG8_STAGE(PG8_SA(0, 1), a2 + hstepA, voffA);
            PG8_WAIT_L(8); PG8_BAR; PG8_WAIT_L(0); PG8_MMA(0, 0, At, B0); PG8_BAR; PG8_SCHED;
            PG8_LDB(B1, 1, 1); PG8_STAGE(PG8_SB(1, 0), b3, voffB);
            PG8_BAR; PG8_WAIT_L(0); PG8_MMA(0, 1, At, B1); PG8_BAR;
            PG8_LDA(At, 1, 1); PG8_STAGE(PG8_SA(1, 0), a3, voffA);
            PG8_BAR; PG8_WAIT_L(0); PG8_MMA(1, 0, At, B0); PG8_BAR; PG8_SCHED;
            PG8_STAGE(PG8_SB(1, 1), b3 + hstepB, voffB);
            PG8_WAIT_V(6); PG8_BAR; PG8_MMA(1, 1, At, B1); PG8_BAR;
        }
        if constexpr (!Epi::AFTER_DRAIN) E(acc, cur, wr, wc, fr, fq);
        if (!has_next) break;
#pragma unroll
        for (int a = 0; a < 2; ++a)
#pragma unroll
            for (int b = 0; b < 2; ++b)
#pragma unroll
                for (int m = 0; m < 4; ++m)
#pragma unroll
                    for (int n = 0; n < 2; ++n) acc[a][b][m][n] = (f32x4){0.f, 0.f, 0.f, 0.f};
        cur = nxt; cA = nA; cB = nB; ++ui;
    }
    PG8_WAIT_V(0);
    if (wr == 0) PG8_BAR;
    PG8_BAR;
    if constexpr (Epi::AFTER_DRAIN) E.fused(acc, cur, wr, wc, fr, fq);
#undef PG8_SA
#undef PG8_SB
#undef PG8_STAGE
#undef PG8_LDA
#undef PG8_LDB
#undef PG8_MMA
#undef PG8_WAIT_V
#undef PG8_WAIT_L
#undef PG8_BAR
#undef PG8_SCHED
}
}
using pg8::Unit;
typedef f32x4 AccT[2][2][4][2];

struct EpiInProj {
    static constexpr bool PERM = true, MERGE = false, AFTER_DRAIN = false;
    bf16_t* slots; bf16_t* kraw; bf16_t* vraw; const float* b_gate;
    DI void operator()(const AccT& acc, const Unit& u, int wr, int wc, int fr, int fq) const {
        const int pn = u.pn; bf16_t* base; int ld = 1024, ccol, mode = 0; const float* bias = b_gate;
        if (pn < 4) { base = slots + 1 * SLOT_E; ccol = pn * 256; }
        else if (pn < 8) { base = slots + 2 * SLOT_E; ccol = (pn - 4) * 256; mode = 1; }
        else if (pn < 12) { base = slots + 3 * SLOT_E; ccol = (pn - 8) * 256; }
        else if (pn == 12) { base = kraw; ld = 256; ccol = 0; }
        else if (pn == 13) { base = vraw; ld = 256; ccol = 0; }
        else if (pn < 18) { base = slots + 4 * SLOT_E; ccol = (pn - 14) * 256; }
        else { const int sec = (pn - 18) >> 2; base = slots + (size_t)(5 + sec) * SLOT_E; ccol = ((pn - 18) & 3) * 256; mode = 2; bias = b_gate + (pn - 18) * 256; }
        const int row0 = u.pm * 256 + wr * 64 + fr, cl = wc * 32 + 8 * fq;
#pragma unroll
        for (int bj = 0; bj < 2; ++bj) {
            float bv[8];
#pragma unroll
            for (int e = 0; e < 8; ++e) bv[e] = (mode == 2) ? bias[cl + bj * 128 + e] : 0.f;
#pragma unroll
            for (int ai = 0; ai < 2; ++ai)
#pragma unroll
                for (int m = 0; m < 4; ++m) {
                    float v[8];
#pragma unroll
                    for (int e = 0; e < 4; ++e) { v[e] = acc[ai][bj][m][0][e]; v[4 + e] = acc[ai][bj][m][1][e]; }
                    if (mode == 1) {
#pragma unroll
                        for (int e = 0; e < 8; ++e) v[e] = gelu_tanh(v[e]);
                    } else if (mode == 2) {
#pragma unroll
                        for (int e = 0; e < 8; ++e) v[e] = sigmoidf_(v[e] + bv[e]);
                    }
                    *(u32x4*)(base + (size_t)(row0 + ai * 128 + m * 16) * ld + ccol + bj * 128 + cl) = pack8(v);
                }
        }
    }
};
struct EpiScaleBf16 {
    static constexpr bool PERM = true, MERGE = false, AFTER_DRAIN = false;
    bf16_t* O; int ldc; int pn_base; const float* scale;
    DI void operator()(const AccT& acc, const Unit& u, int wr, int wc, int fr, int fq) const {
        const int row0 = u.pm * 256 + wr * 64 + fr, cl = (u.pn + pn_base) * 256 + wc * 32 + 8 * fq;
#pragma unroll
        for (int bj = 0; bj < 2; ++bj) {
            float sv[8];
#pragma unroll
            for (int e = 0; e < 8; ++e) sv[e] = scale ? scale[cl + bj * 128 + e] : 1.0f;
#pragma unroll
            for (int ai = 0; ai < 2; ++ai)
#pragma unroll
                for (int m = 0; m < 4; ++m) {
                    float v[8];
#pragma unroll
                    for (int e = 0; e < 4; ++e) { v[e] = acc[ai][bj][m][0][e] * sv[e]; v[4 + e] = acc[ai][bj][m][1][e] * sv[4 + e]; }
                    *(u32x4*)(O + (size_t)(row0 + ai * 128 + m * 16) * ldc + cl + bj * 128) = pack8(v);
                }
        }
    }
};
struct EpiMerge {
    static constexpr bool PERM = true, MERGE = true, AFTER_DRAIN = false;
    bf16_t* gates; bool dry;
    DI void rescale(AccT& acc, const Unit& u, int sb, int wr, int wc, int fr, int fq) const {
        const int row0 = u.pm * 256 + wr * 64 + fr, cl = u.pn * 256 + wc * 32 + 8 * fq;
        const bf16_t* gp = gates + (size_t)(sb - 1) * SLOT_E + (size_t)row0 * 1024 + cl;
#pragma unroll
        for (int ai = 0; ai < 2; ++ai)
#pragma unroll
            for (int m = 0; m < 4; ++m) {
                asm volatile("" : "+v"(gp));
#pragma unroll
                for (int bj = 0; bj < 2; ++bj) {
                    float a[8], b[8]; unpack8(*(const u32x4*)(gp + bj * 128), a); unpack8(*(const u32x4*)(gp + SLOT_E + bj * 128), b);
#pragma unroll
                    for (int e = 0; e < 4; ++e) { acc[ai][bj][m][0][e] *= a[e] * __builtin_amdgcn_rcpf(b[e]); acc[ai][bj][m][1][e] *= a[4 + e] * __builtin_amdgcn_rcpf(b[4 + e]); }
                }
                gp += (m == 3 ? (128 - 48) : 16) * 1024;
            }
    }
    DI void operator()(const AccT& acc, const Unit& u, int wr, int wc, int fr, int fq) const {
        const int row0 = u.pm * 256 + wr * 64 + fr, cl = u.pn * 256 + wc * 32 + 8 * fq;
        bf16_t* gs = gates + 2 * SLOT_E;
#pragma unroll
        for (int ai = 0; ai < 2; ++ai)
#pragma unroll
            for (int m = 0; m < 4; ++m)
#pragma unroll
                for (int bj = 0; bj < 2; ++bj) {
                    const size_t idx = (size_t)(row0 + ai * 128 + m * 16) * 1024 + cl + bj * 128;
                    float gv[8]; unpack8(*(const u32x4*)(gs + idx), gv);
                    float v[8];
#pragma unroll
                    for (int e = 0; e < 4; ++e) { v[e] = acc[ai][bj][m][0][e] * gv[e]; v[4 + e] = acc[ai][bj][m][1][e] * gv[4 + e]; }
                    if (!dry) *(u32x4*)(gs + idx) = pack8(v);
                }
    }
};
DI float dpp_ror1(float v) { return __builtin_bit_cast(float, __builtin_amdgcn_update_dpp(0, __builtin_bit_cast(int, v), 0x121, 0xf, 0xf, false)); }
DI float dpp_ror15(float v) { return __builtin_bit_cast(float, __builtin_amdgcn_update_dpp(0, __builtin_bit_cast(int, v), 0x12f, 0xf, 0xf, false)); }
struct EpiUpFused {
    static constexpr bool PERM = true, MERGE = false, AFTER_DRAIN = false;
    bf16_t* act; float* zedge; float* zpart; const float* cw; const float* cb;
    DI void operator()(const AccT& acc, const Unit& u, int wr, int wc, int fr, int fq) const {
        const int j = u.pn, cl = wc * 32 + 8 * fq;
#pragma unroll
        for (int n = 0; n < 2; ++n) {
            const int ch0 = 128 * j + cl + 4 * n;
            const f32x4 bg = *(const f32x4*)(cb + ch0), w0g = *(const f32x4*)(cw + ch0), w1g = *(const f32x4*)(cw + 6144 + ch0), w2g = *(const f32x4*)(cw + 2 * 6144 + ch0);
            const f32x4 bv = *(const f32x4*)(cb + 3072 + ch0), w0v = *(const f32x4*)(cw + 3072 + ch0), w1v = *(const f32x4*)(cw + 6144 + 3072 + ch0), w2v = *(const f32x4*)(cw + 2 * 6144 + 3072 + ch0);
#pragma unroll
            for (int ai = 0; ai < 2; ++ai) {
                const int rowblk = u.pm * 256 + ai * 128 + wr * 64;
#pragma unroll
                for (int m = 0; m < 4; ++m) {
                    const f32x4 zg = acc[ai][0][m][n], zv = acc[ai][1][m][n];
                    f32x4 pg, pv, ng, nv;
#pragma unroll
                    for (int e = 0; e < 4; ++e) {
                        const float pgs = dpp_ror1(zg[e]), pvs = dpp_ror1(zv[e]), ngs = dpp_ror15(zg[e]), nvs = dpp_ror15(zv[e]);
                        const float pgw = m > 0 ? dpp_ror1(acc[ai][0][m > 0 ? m - 1 : 0][n][e]) : 0.f, pvw = m > 0 ? dpp_ror1(acc[ai][1][m > 0 ? m - 1 : 0][n][e]) : 0.f;
                        const float ngw = m < 3 ? dpp_ror15(acc[ai][0][m < 3 ? m + 1 : 3][n][e]) : 0.f, nvw = m < 3 ? dpp_ror15(acc[ai][1][m < 3 ? m + 1 : 3][n][e]) : 0.f;
                        pg[e] = fr == 0 ? pgw : pgs; pv[e] = fr == 0 ? pvw : pvs; ng[e] = fr == 15 ? ngw : ngs; nv[e] = fr == 15 ? nvw : nvs; }
                    const f32x4 preg = bg + w0g * pg + w1g * zg + w2g * ng, prev = bv + w0v * pv + w1v * zv + w2v * nv;
                    const bool e0 = (m == 0 && fr == 0), e1 = (m == 3 && fr == 15);
                    if (e0 || e1) { const size_t o = ((size_t)((rowblk >> 6) * 2 + (e1 ? 1 : 0))) * 6144 + j * 256 + cl + 4 * n;
                        *(f32x4*)(zpart + o) = preg; *(f32x4*)(zpart + o + 128) = prev; *(f32x4*)(zedge + o) = zg; *(f32x4*)(zedge + o + 128) = zv; }
                    else { u32x2 ov; ov[0] = pk2(preg[0] * sigmoidf_(preg[0]) * prev[0], preg[1] * sigmoidf_(preg[1]) * prev[1]); ov[1] = pk2(preg[2] * sigmoidf_(preg[2]) * prev[2], preg[3] * sigmoidf_(preg[3]) * prev[3]);
                        *(u32x2*)(act + (size_t)(rowblk + 16 * m + fr) * 3072 + ch0) = ov; }
                }
            }
        }
    }
};
DI void ffn_fixup(int pm, bf16_t* act, const float* zedge, const float* zpart, const float* cw, const float* cb) {
    const int tid = ltid();
    for (int pc = tid; pc < 8 * 768; pc += 512) {
        const int er = pc / 768, ch0 = (pc - er * 768) * 4; const int B = 4 * pm + (er >> 1), edge = er & 1;
        const int zc = (ch0 >> 7) * 256 + (ch0 & 127);
        const size_t o = ((size_t)(B * 2 + edge)) * 6144 + zc;
        f32x4 pg = *(const f32x4*)(zpart + o), pv = *(const f32x4*)(zpart + o + 128);
        const int row = B * 64 + (edge ? 63 : 0); const int s0 = seq_start(row), S = seq_len(row), t = row - s0;
        if (edge == 0 && t > 0) { const size_t q = ((size_t)((B - 1) * 2 + 1)) * 6144 + zc; pg += *(const f32x4*)(cw + ch0) * *(const f32x4*)(zedge + q); pv += *(const f32x4*)(cw + 3072 + ch0) * *(const f32x4*)(zedge + q + 128); }
        if (edge == 1 && t < S - 1) { const size_t q = ((size_t)((B + 1) * 2 + 0)) * 6144 + zc; pg += *(const f32x4*)(cw + 2 * 6144 + ch0) * *(const f32x4*)(zedge + q); pv += *(const f32x4*)(cw + 2 * 6144 + 3072 + ch0) * *(const f32x4*)(zedge + q + 128); }
        u32x2 ov; ov[0] = pk2(pg[0] * sigmoidf_(pg[0]) * pv[0], pg[1] * sigmoidf_(pg[1]) * pv[1]); ov[1] = pk2(pg[2] * sigmoidf_(pg[2]) * pv[2], pg[3] * sigmoidf_(pg[3]) * pv[3]);
        *(u32x2*)(act + (size_t)row * 3072 + ch0) = ov;
    }
    asm volatile("s_waitcnt vmcnt(0)" ::: "memory");
    __syncthreads();
}
struct EpiResid {
    static constexpr bool PERM = false, MERGE = false, AFTER_DRAIN = false;
    float* x; const float* modl; int gate_off; bool dry;
    DI void operator()(const AccT& acc, const Unit& u, int wr, int wc, int fr, int fq) const {
        const int row0 = u.pm * 256 + wr * 64 + fr, col0 = u.pn * 256 + wc * 32 + 4 * fq;
        const float* gp = modl + (size_t)mod_row(u.pm * 256) * 6144 + gate_off;
#pragma unroll
        for (int bj = 0; bj < 2; ++bj)
#pragma unroll
            for (int n = 0; n < 2; ++n) {
                const int col = col0 + bj * 128 + n * 16; const f32x4 gv = *(const f32x4*)(gp + col);
#pragma unroll
                for (int ai = 0; ai < 2; ++ai)
#pragma unroll
                    for (int m = 0; m < 4; ++m) { float* xp = x + (size_t)(row0 + ai * 128 + m * 16) * 1024 + col; f32x4 xv = *(const f32x4*)xp; xv += gv * acc[ai][bj][m][n]; if (!dry) *(f32x4*)xp = xv; }
            }
    }
};


#define XB_TMO      128
#define XB_XCNT(j)  (256  + 64 * (j))
#define XB_XSUB(j)  (1280 + 64 * (j))
#define XB_XGEN(j)  (2304 + 64 * (j))
#define XB_TOP      3328
#define XB_TOPGEN   3392
#define XB_SPIN_CAP (1u << 18)
DI unsigned xb_ld(unsigned* p) { return __hip_atomic_load(p, __ATOMIC_RELAXED, __HIP_MEMORY_SCOPE_AGENT); }
DI unsigned xb_add(unsigned* p, unsigned v) { return __hip_atomic_fetch_add(p, v, __ATOMIC_RELAXED, __HIP_MEMORY_SCOPE_AGENT); }
DI unsigned xb_xcc_id() { return (unsigned)__builtin_amdgcn_s_getreg((3 << 11) | 20) & 0xFu; }
#define XB_SPIN(cond, bar) do { unsigned _sp = 0; while (cond) { __builtin_amdgcn_s_sleep(1); \
    if ((++_sp & 255u) == 0u) { if (xb_ld(&(bar)[XB_TMO])) break; if (_sp > XB_SPIN_CAP) { atomicAdd(&(bar)[XB_TMO], 1u); break; } } } } while (0)
DI void xcd_barrier_complete(unsigned* bar, unsigned x, unsigned& nloc, unsigned& nx) {
    const unsigned G = gridDim.x;
    unsigned sum, cnt, mine, sp = 0u;
    for (;;) {
        sum = 0u; cnt = 0u; mine = 0u;
#pragma unroll
        for (unsigned j = 0; j < 16; ++j) { const unsigned c = xb_ld(&bar[XB_XCNT(j)]); sum += c; cnt += (c > 0u) ? 1u : 0u; mine = (j == x) ? c : mine; }
        if (sum == G) break;
        __builtin_amdgcn_s_sleep(1);
        if ((++sp & 255u) == 0u) { if (xb_ld(&bar[XB_TMO])) break; if (sp > XB_SPIN_CAP) { atomicAdd(&bar[XB_TMO], 1u); break; } }
    }
    nloc = mine > 0u ? mine : 1u; nx = cnt > 0u ? cnt : 1u;
}
DI void gbar_post(const KP p, unsigned char* shm) {
    volatile LAS unsigned* st = (volatile LAS unsigned*)(LAS unsigned char*)(shm + 131072);
    if (threadIdx.x == 0) { st[0] = 0u; st[1] = 0u; (void)xb_add(&((unsigned*)(p.ws() + OFF_BAR))[XB_XCNT(xb_xcc_id())], 1u); }
    __syncthreads();
}
DI void gbar(const KP p, unsigned char* shm) {
    asm volatile("s_waitcnt vmcnt(0)" ::: "memory");
    __syncthreads();
    if (threadIdx.x == 0) {
        unsigned* bar = (unsigned*)(p.ws() + OFF_BAR); const unsigned x = xb_xcc_id();
        volatile LAS unsigned* st = (volatile LAS unsigned*)(LAS unsigned char*)(shm + 131072);
        __builtin_amdgcn_s_waitcnt(0);
        unsigned nloc = st[0], nx = st[1];
        if (nloc == 0u) { xcd_barrier_complete(bar, x, nloc, nx); st[0] = nloc; st[1] = nx; }
        const unsigned old = xb_add(&bar[XB_XSUB(x)], 1u);
        const unsigned gen = old / nloc;
        if (old + 1u == (gen + 1u) * nloc) {
            __builtin_amdgcn_fence(__ATOMIC_RELEASE, "agent");
            asm volatile("s_waitcnt vmcnt(0)" ::: "memory");
            const unsigned og = xb_add(&bar[XB_TOP], 1u);
            const unsigned tg = og / nx;
            if (og + 1u == (tg + 1u) * nx) xb_add(&bar[XB_TOPGEN], 1u);
            else XB_SPIN(xb_ld(&bar[XB_TOPGEN]) == tg, bar);
            __builtin_amdgcn_fence(__ATOMIC_ACQUIRE, "agent");
            xb_add(&bar[XB_XGEN(x)], 1u);
            asm volatile("s_waitcnt vmcnt(0)" ::: "memory");
        } else {
            XB_SPIN(xb_ld(&bar[XB_XGEN(x)]) == gen, bar);
            __builtin_amdgcn_fence(__ATOMIC_ACQUIRE, "agent");
            asm volatile("s_waitcnt vmcnt(0)" ::: "memory");
        }
    }
    __syncthreads();
}

struct EpiResidNorm {
    static constexpr bool PERM = false, MERGE = false, AFTER_DRAIN = true;
    float* x; const float* modl; int gate_off; int mode; const float* gam; const float* modn; int sh_off, sc_off; bf16_t* dst; float* rss; unsigned* cnt; unsigned* bar; float* rsl;
    DI void fused(AccT& acc, const Unit& u, int wr, int wc, int fr, int fq) const {
        const int row0 = u.pm * 256 + wr * 64 + fr, col0 = u.pn * 256 + wc * 32 + 4 * fq;
        const int mrow = mod_row(u.pm * 256);
        const float* gp = modl + (size_t)mrow * 6144 + gate_off + col0;
        { f32x4 gv[2][2];
#pragma unroll
          for (int bj = 0; bj < 2; ++bj)
#pragma unroll
              for (int n = 0; n < 2; ++n) gv[bj][n] = *(const f32x4*)(gp + bj * 128 + n * 16);
          const float* xp = x + (size_t)row0 * 1024 + col0;
#pragma unroll
          for (int ai = 0; ai < 2; ++ai)
#pragma unroll
              for (int m = 0; m < 4; ++m) {
                  asm volatile("" : "+v"(xp));
                  float sq = 0.f;
#pragma unroll
                  for (int bj = 0; bj < 2; ++bj)
#pragma unroll
                      for (int n = 0; n < 2; ++n) { f32x4 xv = *(const f32x4*)(xp + bj * 128 + n * 16); xv += gv[bj][n] * acc[ai][bj][m][n]; acc[ai][bj][m][n] = xv; sq += xv[0] * xv[0] + xv[1] * xv[1] + xv[2] * xv[2] + xv[3] * xv[3]; }
                  sq += __shfl_xor(sq, 16); sq += __shfl_xor(sq, 32);
                  if (fq == 0) __hip_atomic_store(&rss[(size_t)(row0 + ai * 128 + m * 16) * 16 + u.pn * 4 + wc], sq, __ATOMIC_RELAXED, __HIP_MEMORY_SCOPE_AGENT);
                  xp += (m == 3 ? (128 - 48) : 16) * 1024;
              } }
        asm volatile("s_waitcnt vmcnt(0)" ::: "memory");
        __syncthreads();
        if (threadIdx.x == 0) { (void)xb_add(&cnt[u.pm], 1u); XB_SPIN(xb_ld(&cnt[u.pm]) < 4u, bar); }
        __syncthreads();
        float rs[2][4];
        { const int L = fq * 16 + fr; float* rw = rsl + (wr * 4 + wc) * 128;
#pragma unroll
          for (int ai = 0; ai < 2; ++ai) { const float* rp = rss + (size_t)(u.pm * 256 + ai * 128 + wr * 64 + L) * 16;
              float t = 0.f;
#pragma unroll
              for (int q = 0; q < 8; ++q) { const unsigned long long w = __hip_atomic_load((const unsigned long long*)rp + q, __ATOMIC_RELAXED, __HIP_MEMORY_SCOPE_AGENT); t += __uint_as_float((unsigned)w) + __uint_as_float((unsigned)(w >> 32)); }
              rw[ai * 64 + L] = rsqrtf(t * (1.0f / 1024.0f) + 1e-6f); }
#pragma unroll
          for (int ai = 0; ai < 2; ++ai)
#pragma unroll
              for (int m = 0; m < 4; ++m) rs[ai][m] = rw[ai * 64 + 16 * m + fr]; }
        { const float* mn = modn + (size_t)mrow * 6144 + col0;
          f32x4 ms[2][2], sh[2][2];
#pragma unroll
          for (int bj = 0; bj < 2; ++bj)
#pragma unroll
              for (int n = 0; n < 2; ++n) { const int cc = bj * 128 + n * 16; ms[bj][n] = *(const f32x4*)(gam + col0 + cc); sh[bj][n] = (f32x4){0.f, 0.f, 0.f, 0.f};
                  if (mode == 0) { ms[bj][n] = ms[bj][n] * (*(const f32x4*)(mn + sc_off + cc) + 1.0f); sh[bj][n] = *(const f32x4*)(mn + sh_off + cc); } }
          float* xq = x + (size_t)row0 * 1024 + col0; bf16_t* dq = dst + (size_t)row0 * 1024 + col0;
#pragma unroll
          for (int ai = 0; ai < 2; ++ai)
#pragma unroll
              for (int m = 0; m < 4; ++m) {
                  asm volatile("" : "+v"(xq), "+v"(dq));
#pragma unroll
                  for (int bj = 0; bj < 2; ++bj)
#pragma unroll
                      for (int n = 0; n < 2; ++n) { const int cc = bj * 128 + n * 16; const f32x4 y = acc[ai][bj][m][n] * rs[ai][m] * ms[bj][n] + sh[bj][n];
                          if (mode == 0) { *(f32x4*)(xq + cc) = acc[ai][bj][m][n]; u32x2 ob; ob[0] = pk2(y[0], y[1]); ob[1] = pk2(y[2], y[3]); *(u32x2*)(dq + cc) = ob; } else *(f32x4*)(xq + cc) = y; }
                  xq += (m == 3 ? (128 - 48) : 16) * 1024; dq += (m == 3 ? (128 - 48) : 16) * 1024;
              } }
    }
};

DI float wave_sum(float v) {
#pragma unroll
    for (int o = 32; o > 0; o >>= 1) v += __shfl_xor(v, o);
    return v;
}

DI void phase_mod(const KP p, unsigned char* shm) {
    float* sc = (float*)shm; float* red = sc + 9 * 1024;
    const int tid = ltid(); bool inited = false;
    const float* cond = p.in(5); const float* cctx = p.in(6);
    for (int it = lbid(); it < 192; it += lgdim()) {
        if (!inited) { for (int e = tid; e < 9 * 1024; e += 512) { const int r = e >> 10, k = e & 1023; const float v = r == 0 ? cctx[k] : cond[(r - 1) * 1024 + k]; sc[e] = v / (1.0f + expf(-v)); } __syncthreads(); inited = true; }
        const int l = it / 96, j0 = (it % 96) * 64, j = tid & 63, kq = tid >> 6;
        const float* w = p.in(9) + (size_t)l * 1024 * 6144 + j0 + j;
        float a0 = 0, a1 = 0, a2 = 0, a3 = 0, a4 = 0, a5 = 0, a6 = 0, a7 = 0, a8 = 0;
        for (int k = kq * 128; k < kq * 128 + 128; ++k) { const float wv = w[(size_t)k * 6144];
            a0 += sc[k] * wv; a1 += sc[1024 + k] * wv; a2 += sc[2048 + k] * wv; a3 += sc[3072 + k] * wv; a4 += sc[4096 + k] * wv; a5 += sc[5120 + k] * wv; a6 += sc[6144 + k] * wv; a7 += sc[7168 + k] * wv; a8 += sc[8192 + k] * wv; }
        float* rp = red + (kq * 9) * 64 + j;
        rp[0] = a0; rp[64] = a1; rp[128] = a2; rp[192] = a3; rp[256] = a4; rp[320] = a5; rp[384] = a6; rp[448] = a7; rp[512] = a8;
        __syncthreads();
        for (int e = tid; e < 576; e += 512) { const int r = e >> 6, jj = e & 63; float s = p.in(10)[(size_t)l * 6144 + j0 + jj];
            for (int q = 0; q < 8; ++q) s += red[(q * 9 + r) * 64 + jj];
            ((float*)(p.ws() + OFF_MOD))[((size_t)l * 9 + r) * 6144 + j0 + jj] = s; }
        __syncthreads();
    }
    __syncthreads();
}

DI void phase_kbound(const KP p, unsigned char* shm) {
    const int tid = ltid(), lane = tid & 63, wid = tid >> 6; float* red = (float*)shm; float* out = (float*)(p.ws() + OFF_KMAX);
    for (int it = lbid(); it < 64; it += lgdim()) {
        const int l = it >> 5, b = (it >> 2) & 7, hk = it & 3; const int key = tid >> 1, half = tid & 1;
        const float* src = p.in(2) + ((((size_t)b * 2 + l) * 256 + key) * 256) + hk * 64 + half * 32;
        float ss = 0.f;
#pragma unroll
        for (int i = 0; i < 8; ++i) { const f32x4 v = *(const f32x4*)(src + i * 4); ss += v[0] * v[0] + v[1] * v[1] + v[2] * v[2] + v[3] * v[3]; }
        ss += __shfl_xor(ss, 1);
#pragma unroll
        for (int o = 2; o < 64; o <<= 1) ss = fmaxf(ss, __shfl_xor(ss, o));
        if (lane == 0) red[wid] = ss;
        __syncthreads();
        if (tid == 0) { float m = red[0]; for (int w = 1; w < 8; ++w) m = fmaxf(m, red[w]); out[it] = m; }
        __syncthreads();
    }
    if (lbid() == lgdim() - 1 && tid < 2) { float g2 = 0.f; for (int d = 0; d < 64; ++d) { const float g = p.in(21)[tid * 64 + d]; g2 = fmaxf(g2, g * g); } out[64 + tid] = 64.0f * g2; }
}

DI void transpose_tile(const float* src, int N, int k0, int scol0, bf16_t* dst, int ldd, int drow0, float* tile) {
    const int tid = ltid();
#pragma unroll
    for (int i = 0; i < 2; ++i) { const int idx = tid + i * 512, k = idx >> 4, n4 = idx & 15; const f32x4 v = *(const f32x4*)(src + (size_t)(k0 + k) * N + scol0 + n4 * 4);
        float* t = tile + k * 65 + n4 * 4; t[0] = v[0]; t[1] = v[1]; t[2] = v[2]; t[3] = v[3]; }
    __syncthreads();
    { const int n = tid >> 3, kg = tid & 7; float f[8];
#pragma unroll
      for (int j = 0; j < 8; ++j) f[j] = tile[(kg * 8 + j) * 65 + n];
      *(u32x4*)(dst + (size_t)(drow0 + n) * ldd + k0 + kg * 8) = pack8(f); }
    __syncthreads();
}
DI void phase_weights(const KP p, int l, unsigned char* shm, int mask = 31, int Gw = 0, int cw = 0) {
    float* tile = (float*)shm; unsigned char* W = p.ws() + OFF_W;
    const int G = Gw > 0 ? Gw : lgdim(), c = Gw > 0 ? cw : lbid(); int base = 0;
    auto run = [&](const float* src, int K, int N, bf16_t* dst, int ldd, int mode) {
        const int ntn = N / 64, ntk = K / 64, nt = ntn * ntk;
        int first = (c - base) % G; if (first < 0) first += G;
        for (int ti = first; ti < nt; ti += G) { const int kt = ti / ntn, nn = ti - kt * ntn; const int drow0 = nn * 64; int scol0 = drow0;
            if (mode == 1) { const int j = drow0 >> 8, w = drow0 & 255; scol0 = w < 128 ? 128 * j + w : 3072 + 128 * j + (w - 128); }
            transpose_tile(src, N, kt * 64, scol0, dst, ldd, drow0, tile); }
        base += nt;
    };
    if (mask & 1) run(p.in(11) + (size_t)l * 1024 * 7680, 1024, 7680, (bf16_t*)(W + W_IN), 1024, 0);
    if (mask & 2) run(p.in(28) + (size_t)l * 1024 * 6144, 1024, 6144, (bf16_t*)(W + W_UP), 1024, 1);
    if (mask & 4) run(p.in(31) + (size_t)l * 3072 * 1024, 3072, 1024, (bf16_t*)(W + W_DOWN), 3072, 0);
    if (mask & 8) {
    run(p.in(24) + (size_t)l * 1024 * 1024, 1024, 1024, (bf16_t*)(W + W_BR), 1024, 0);
    run(p.in(25) + (size_t)l * 1024 * 1024, 1024, 1024, (bf16_t*)(W + W_BR) + (size_t)1024 * 1024, 1024, 0);
    run(p.in(26) + (size_t)l * 1024 * 1024, 1024, 1024, (bf16_t*)(W + W_BR) + (size_t)2 * 1024 * 1024, 1024, 0);
    run(p.in(27) + (size_t)l * 1024 * 1024, 1024, 1024, (bf16_t*)(W + W_O), 1024, 0); }
    if (mask & 16) {
    for (int g = 0; g < 4; ++g) run(p.in(22) + ((size_t)l * 4 + g) * 256 * 256, 256, 256, (bf16_t*)(W + W_POOL) + (size_t)g * 256 * 256, 256, 0);
    bf16_t* wg = (bf16_t*)(W + W_GATE);
    for (int e = c * 512 + ltid(); e < 16 * 2 * 128 * 64; e += G * 512) {
        const int k = e & 63, col = (e >> 6) & 127, dir = (e >> 13) & 1, n = e >> 14;
        const float* src = (col < 64 ? p.in(15) : p.in(17)) + ((((size_t)l * 2 + dir) * 16 + n) * 64 + k) * 64 + (col & 63);
        wg[e] = (bf16_t)(pk2(*src, 0.f) & 0xffffu);
    } }
}

DI void phase_norm(const KP p, int l, bool from_input, const float* gam, int sh_off, int sc_off, bf16_t* dst, bool final_) {
    const int tid_ = ltid(); const int lane = tid_ & 63, wid = tid_ >> 6;
    const float* modl = (const float*)(p.ws() + OFF_MOD) + (size_t)l * 9 * 6144;
    const int stride = lgdim() * 8;
    f32x4 gv[4];
#pragma unroll
    for (int i = 0; i < 4; ++i) gv[i] = *(const f32x4*)(gam + i * 256 + lane * 4);
    for (int mb = lbid() * 8 + wid; mb < MT; mb += 3 * stride) {
        f32x4 xv[3][4]; float ss[3];
#pragma unroll
        for (int r = 0; r < 3; ++r) { const int m = mb + r * stride; ss[r] = 0.f;
            if (m < MT) { const float* xr = from_input ? (m < MCTX ? p.in(0) + (size_t)m * 1024 : p.in(1) + (size_t)(m - MCTX) * 1024) : p.out() + (size_t)m * 1024;
#pragma unroll
                for (int i = 0; i < 4; ++i) xv[r][i] = *(const f32x4*)(xr + i * 256 + lane * 4); }
            else {
#pragma unroll
                for (int i = 0; i < 4; ++i) xv[r][i] = (f32x4){0.f, 0.f, 0.f, 0.f}; } }
#pragma unroll
        for (int r = 0; r < 3; ++r) {
#pragma unroll
            for (int i = 0; i < 4; ++i) ss[r] += xv[r][i][0] * xv[r][i][0] + xv[r][i][1] * xv[r][i][1] + xv[r][i][2] * xv[r][i][2] + xv[r][i][3] * xv[r][i][3];
            ss[r] = wave_sum(ss[r]); }
#pragma unroll
        for (int r = 0; r < 3; ++r) { const int m = mb + r * stride; if (m >= MT) continue;
            const float rs = rsqrtf(ss[r] * (1.0f / 1024.0f) + 1e-6f);
            const float* mr = modl + (size_t)mod_row(m) * 6144;
#pragma unroll
            for (int i = 0; i < 4; ++i) { const int cc = i * 256 + lane * 4;
                if (final_) { f32x4 y = xv[r][i] * rs * gv[i]; *(f32x4*)(p.out() + (size_t)m * 1024 + cc) = y; }
                else { const f32x4 scv = *(const f32x4*)(mr + sc_off + cc), shv = *(const f32x4*)(mr + sh_off + cc);
                    f32x4 y = xv[r][i] * rs * gv[i] * (scv + 1.0f) + shv; u32x2 o; o[0] = pk2(y[0], y[1]); o[1] = pk2(y[2], y[3]);
                    *(u32x2*)(dst + (size_t)m * 1024 + cc) = o;
                    if (from_input) *(f32x4*)(p.out() + (size_t)m * 1024 + cc) = xv[r][i]; }
            }
        }
    }
}

DI void phase_e1_elem(const KP p, int l, unsigned char* shm, int parts = 15) {
    float* tab = (float*)shm;
    const int tid = ltid();
    for (int e = tid; e < 1024; e += 512) { const int pos = e >> 4, j = e & 15; const float inv = exp2f(-(float)j * (13.287712379549449f / 16.0f)); const float ang = (float)pos * inv; tab[2 * e] = __cosf(ang); tab[2 * e + 1] = __sinf(ang); }
    __syncthreads();
    bf16_t* slots = (bf16_t*)(p.ws() + OFF_SLOTS);
    bf16_t* qb = slots + 3 * SLOT_E; bf16_t* kraw = (bf16_t*)(p.ws() + OFF_KRAW); bf16_t* vraw = (bf16_t*)(p.ws() + OFF_VRAW);
    const size_t gtid = (size_t)lbid() * 512 + tid, gsz = (size_t)lgdim() * 512;
    if (parts & 1) {
        auto qk_ptr = [&](size_t e) -> bf16_t* { const int i = (int)(e & 7); const int hh = 16 + (int)((e >> 3) & 3); const int m = (int)(e >> 5);
            return kraw + (size_t)m * 256 + (hh - 16) * 64 + i * 8; };
        auto qk_proc = [&](size_t e, u32x4 rawv, bf16_t* ptr) {
            const int i = (int)(e & 7); const int hh = 16 + (int)((e >> 3) & 3); const int m = (int)(e >> 5); const bool isq = false;
            float x[8]; unpack8(rawv, x);
            float ss = 0.f;
#pragma unroll
            for (int j = 0; j < 8; ++j) ss += x[j] * x[j];
            ss += __shfl_xor(ss, 1); ss += __shfl_xor(ss, 2); ss += __shfl_xor(ss, 4);
            const float rs = rsqrtf(ss * (1.0f / 64.0f) + 1e-6f);
            const float* g = (isq ? p.in(20) : p.in(21)) + l * 64 + i * 8; const f32x4 g0 = *(const f32x4*)g, g1 = *(const f32x4*)(g + 4);
#pragma unroll
            for (int j = 0; j < 4; ++j) { x[j] = x[j] * rs * g0[j]; x[4 + j] = x[4 + j] * rs * g1[j]; }
            const bool lat = m >= MCTX;
            float part[8];
#pragma unroll
            for (int j = 0; j < 8; ++j) part[j] = __shfl_xor(x[j], 2);
            if (lat) { const int t = (m - MCTX) & 1023; const int pos = (i < 4) ? (t >> 6) : (t & 63);
#pragma unroll
                for (int j = 0; j < 8; ++j) { const int jj = (i & 1) * 8 + j; const float cs = tab[2 * (pos * 16 + jj)], sn = tab[2 * (pos * 16 + jj) + 1];
                    x[j] = (i & 2) ? (part[j] * sn + x[j] * cs) : (x[j] * cs - part[j] * sn); }
            } else if (!isq) { float* o = p.out() + OUT_CK + ((((size_t)(m >> 8) * 2 + l) * 256 + (m & 255)) * 256) + (hh - 16) * 64 + i * 8;
                *(f32x4*)o = (f32x4){x[0], x[1], x[2], x[3]}; *(f32x4*)(o + 4) = (f32x4){x[4], x[5], x[6], x[7]}; }
            *(u32x4*)ptr = pack8(x); };
        const size_t N = (size_t)MT * 4 * 8;
        for (size_t e = gtid; e < N; e += 2 * gsz) { const size_t e1 = e + gsz; const bool has1 = e1 < N;
            bf16_t* p0 = qk_ptr(e); bf16_t* p1 = qk_ptr(has1 ? e1 : e);
            const u32x4 r0 = *(const u32x4*)p0, r1 = *(const u32x4*)p1;
            qk_proc(e, r0, p0); if (has1) qk_proc(e1, r1, p1); }
    }
    bf16_t* vT = (bf16_t*)(p.ws() + OFF_VT);
    if (parts & 2)
    for (size_t e = gtid; e < (size_t)MT * 32; e += gsz) {
        int seq, t, grp;
        if (e < (size_t)MCTX * 32) { t = (int)(e & 255); grp = (int)((e >> 8) & 31); seq = (int)(e >> 13); }
        else { const size_t e2 = e - (size_t)MCTX * 32; t = (int)(e2 & 1023); grp = (int)((e2 >> 10) & 31); seq = 16 + (int)(e2 >> 15); }
        const int hk = grp >> 3, dg = grp & 7; const int m = seq < 16 ? seq * 256 + t : MCTX + (seq - 16) * 1024 + t;
        const u32x4 raw = *(const u32x4*)(vraw + (size_t)m * 256 + hk * 64 + dg * 8);
        bf16_t* dstp; int Sk;
        if (seq < 16) { Sk = 256; dstp = vT + ((size_t)(seq * 4 + hk) * 64 + dg * 8) * 256 + t; }
        else { Sk = 1280; dstp = vT + VT_LAT_E + ((size_t)((seq - 16) * 4 + hk) * 64 + dg * 8) * 1280 + 256 + t; }
#pragma unroll
        for (int j = 0; j < 8; ++j) dstp[(size_t)j * Sk] = (bf16_t)((j & 1) ? (raw[j >> 1] >> 16) : (raw[j >> 1] & 0xffffu));
        if (seq < 16) { float f[8]; unpack8(raw, f); float* o = p.out() + OUT_CV + ((((size_t)seq * 2 + l) * 256 + t) * 256) + hk * 64 + dg * 8;
            *(f32x4*)o = (f32x4){f[0], f[1], f[2], f[3]}; *(f32x4*)(o + 4) = (f32x4){f[4], f[5], f[6], f[7]}; }
    }
    bf16_t* ck = (bf16_t*)(p.ws() + OFF_CK);
    if (parts & 4)
    for (size_t e = gtid; e < (size_t)8 * 256 * 32; e += gsz) {
        const int c8 = (int)(e & 31), t = (int)((e >> 5) & 255), b = (int)(e >> 13);
        const float* src = p.in(2) + ((((size_t)b * 2 + l) * 256 + t) * 256) + c8 * 8;
        float f[8]; const f32x4 a = *(const f32x4*)src, bb = *(const f32x4*)(src + 4); f[0] = a[0]; f[1] = a[1]; f[2] = a[2]; f[3] = a[3]; f[4] = bb[0]; f[5] = bb[1]; f[6] = bb[2]; f[7] = bb[3];
        *(u32x4*)(ck + ((size_t)b * 256 + t) * 256 + c8 * 8) = pack8(f);
    }
    if (parts & 4)
    for (size_t e = gtid; e < (size_t)8 * 32 * 256; e += gsz) {
        const int t = (int)(e & 255), grp = (int)((e >> 8) & 31), b = (int)(e >> 13); const int hk = grp >> 3, dg = grp & 7;
        const float* src = p.in(3) + ((((size_t)b * 2 + l) * 256 + t) * 256) + hk * 64 + dg * 8;
        bf16_t* dstp = vT + VT_LAT_E + ((size_t)(b * 4 + hk) * 64 + dg * 8) * 1280 + t;
#pragma unroll
        for (int j = 0; j < 8; ++j) dstp[(size_t)j * 1280] = (bf16_t)(pk2(src[j], 0.f) & 0xffffu);
    }
    const bf16_t* up = slots + 4 * SLOT_E; bf16_t* dd = slots;
    if (parts & 8) {
#define POOL_GROUP(GI, WW) \
        for (size_t e = gtid; e < (size_t)MT * 32; e += gsz) { \
            const int c8 = (GI) * 32 + (int)(e & 31), m = (int)(e >> 5); const int s0 = seq_start(m), S = seq_len(m), t = m - s0; \
            u32x4 rv[WW]; \
            _Pragma("unroll") for (int k = 0; k < (WW); ++k) { int tt = t - (WW) / 2 + k; tt = tt < 0 ? 0 : (tt >= S ? S - 1 : tt); rv[k] = *(const u32x4*)(up + (size_t)(s0 + tt) * 1024 + c8 * 8); } \
            float sum[8] = {0, 0, 0, 0, 0, 0, 0, 0}, self[8]; int cnt = 0; \
            _Pragma("unroll") for (int k = 0; k < (WW); ++k) { const int tt = t - (WW) / 2 + k; const bool ok = tt >= 0 && tt < S; cnt += ok ? 1 : 0; float f[8]; unpack8(rv[k], f); \
                _Pragma("unroll") for (int j = 0; j < 8; ++j) sum[j] += ok ? f[j] : 0.f; } \
            unpack8(rv[(WW) / 2], self); \
            const float inv = 1.0f / (float)cnt; \
            _Pragma("unroll") for (int j = 0; j < 8; ++j) sum[j] = sum[j] * inv - self[j]; \
            *(u32x4*)(dd + (size_t)m * 1024 + c8 * 8) = pack8(sum); }
        POOL_GROUP(0, 2) POOL_GROUP(1, 4) POOL_GROUP(2, 8) POOL_GROUP(3, 16)
#undef POOL_GROUP
    }
}

DI void phase_e2(const KP p, int l, const bf16_t* z, int ntl, int j0, bf16_t* act) {
    const float* cw = p.in(29) + (size_t)l * 3 * 6144; const float* cb = p.in(30) + (size_t)l * 6144;
    const int ldz = ntl * 256;
    const int gtid = lbid() * 512 + ltid(), gsz = lgdim() * 512;
    const int per_m = ntl * 16, rpt = gsz / per_m;
    const int r = gtid % per_m, mrow0 = gtid / per_m; const int jl = r >> 4, cg8 = r & 15;
    if (mrow0 >= rpt) return;
    f32x4 wv[2][4][2];
#pragma unroll
    for (int h = 0; h < 2; ++h) { const int wcol = h * 3072 + (j0 + jl) * 128 + cg8 * 8;
#pragma unroll
        for (int q = 0; q < 2; ++q) { wv[h][0][q] = *(const f32x4*)(cb + wcol + q * 4); wv[h][1][q] = *(const f32x4*)(cw + wcol + q * 4); wv[h][2][q] = *(const f32x4*)(cw + 6144 + wcol + q * 4); wv[h][3][q] = *(const f32x4*)(cw + 2 * 6144 + wcol + q * 4); } }
    const u32x4 zero = (u32x4){0, 0, 0, 0};
    for (int mb = mrow0; mb < MT; mb += 2 * rpt) {
        u32x4 zr[2][2][3];
#pragma unroll
        for (int u = 0; u < 2; ++u) { const int m = mb + u * rpt; const bool ok = m < MT; const int mm = ok ? m : mb;
            const int s0 = seq_start(mm), S = seq_len(mm), t = mm - s0; const bool hp = t > 0, hn = t < S - 1;
#pragma unroll
            for (int h = 0; h < 2; ++h) { const bf16_t* zp = z + (size_t)mm * ldz + jl * 256 + h * 128 + cg8 * 8;
                zr[u][h][0] = hp ? *(const u32x4*)(zp - ldz) : zero; zr[u][h][1] = *(const u32x4*)zp; zr[u][h][2] = hn ? *(const u32x4*)(zp + ldz) : zero; } }
#pragma unroll
        for (int u = 0; u < 2; ++u) { const int m = mb + u * rpt; if (m >= MT) continue;
            float res[2][8];
#pragma unroll
            for (int h = 0; h < 2; ++h) { float z0[8], z1[8], z2[8]; unpack8(zr[u][h][0], z0); unpack8(zr[u][h][1], z1); unpack8(zr[u][h][2], z2);
#pragma unroll
                for (int j = 0; j < 8; ++j) res[h][j] = wv[h][0][j >> 2][j & 3] + wv[h][1][j >> 2][j & 3] * z0[j] + wv[h][2][j >> 2][j & 3] * z1[j] + wv[h][3][j >> 2][j & 3] * z2[j]; }
            float o[8];
#pragma unroll
            for (int j = 0; j < 8; ++j) o[j] = res[0][j] * sigmoidf_(res[0][j]) * res[1][j];
            *(u32x4*)(act + (size_t)m * 3072 + (j0 + jl) * 128 + cg8 * 8) = pack8(o); }
    }
}

DI int crow(int reg, int h) { return (reg & 3) + 8 * (reg >> 2) + 4 * h; }
DI float fsig(float x) { return __builtin_amdgcn_rcpf(1.0f + __builtin_amdgcn_exp2f(-1.4426950408889634f * x)); }
constexpr int L2_XW = 0, L2_SEG = 8 * 16 * 68 * 4, L2_CST = L2_SEG + 8192, L2_CW = L2_CST + 512, L2_WG = L2_CW + 1280, L2_RAW = L2_WG + 128 * 144, L2_END = L2_RAW + 8 * 19 * 64 * 2;
static_assert(L2_END <= 131072, "lds");
template <int DIR>
DI void lru_sweep(const KP p, int l, int seq, int n, unsigned char* shm, bool wet) {
    const int tid = ltid(), lane = tid & 63, wid = tid >> 6, l16 = lane & 15, kg = lane >> 4;
    const int S = seq < 16 ? 256 : 1024, m0 = seq < 16 ? seq * 256 : MCTX + (seq - 16) * 1024, nst = S >> 7;
    bf16_t* slots = (bf16_t*)(p.ws() + OFF_SLOTS);
    const bf16_t* xr = slots + 1 * SLOT_E + n * 64; const bf16_t* yv = slots + 2 * SLOT_E + n * 64; bf16_t* yo = slots + 4 * SLOT_E + n * 64;
    float* xw = (float*)(shm + L2_XW) + wid * 16 * 68; float* segs = (float*)(shm + L2_SEG); float* cst = (float*)(shm + L2_CST);
    bf16_t* wgl = (bf16_t*)(shm + L2_WG);
    { const bf16_t* wg = (const bf16_t*)(p.ws() + OFF_W + W_GATE) + ((size_t)n * 2 + DIR) * 128 * 64;
#pragma unroll
      for (int i = 0; i < 2; ++i) { const int pc = tid + i * 512, col = pc >> 3, part = pc & 7; *(u32x4*)(wgl + col * 72 + part * 8) = *(const u32x4*)(wg + col * 64 + part * 8); } }
    float br[4], bi[4], ls8[4];
#pragma unroll
    for (int cq = 0; cq < 4; ++cq) { const size_t o = ((size_t)l * 2 + DIR) * 1024 + n * 64 + cq * 16 + l16; br[cq] = p.in(16)[o]; bi[cq] = p.in(18)[o];
        ls8[cq] = -8.0f * 1.4426950408889634f * log1pf(expf(-p.in(19)[o])); }
    const float w0 = p.in(13)[((size_t)l * 4 + 0) * 1024 + n * 64 + lane], w1 = p.in(13)[((size_t)l * 4 + 1) * 1024 + n * 64 + lane], w2 = p.in(13)[((size_t)l * 4 + 2) * 1024 + n * 64 + lane],
                w3 = p.in(13)[((size_t)l * 4 + 3) * 1024 + n * 64 + lane], wb = p.in(14)[(size_t)l * 1024 + n * 64 + lane];
    if (tid < 64) cst[tid] = seq < 16 ? 0.f : p.in(4)[(((size_t)(seq - 16) * 2 + l) * 2 + DIR) * 1024 + n * 64 + tid];
    __syncthreads();
    bf16_t* rawt = (bf16_t*)(shm + L2_RAW) + wid * 19 * 64;
    u32x4 rr[3];
    auto load_raw = [&](int base) {
#pragma unroll
        for (int i = 0; i < 3; ++i) { const int pc = lane + i * 64, r = pc >> 3, part = pc & 7; const int tt = base + wid * 16 - 1 + r; rr[i] = (u32x4){0, 0, 0, 0};
            if (pc < 152 && tt >= 0 && tt < S) rr[i] = *(const u32x4*)(xr + (size_t)(m0 + tt) * 1024 + part * 8); } };
    load_raw(DIR == 0 ? 0 : (nst - 1) * 128);
#pragma unroll 1
    for (int s = 0; s < nst; ++s) {
        const int base = (DIR == 0 ? s : nst - 1 - s) * 128; const int par = s & 1;
        u32x4 yv4[2], tv4[2];
#pragma unroll
        for (int i = 0; i < 2; ++i) { const int pc = lane + i * 64; const size_t o = (size_t)(m0 + base + wid * 16 + (pc >> 3)) * 1024 + (pc & 7) * 8;
            yv4[i] = *(const u32x4*)(yv + o); tv4[i] = DIR == 1 ? *(const u32x4*)(yo + o) : (u32x4){0, 0, 0, 0}; }
#pragma unroll
        for (int i = 0; i < 3; ++i) { const int pc = lane + i * 64; if (pc < 152) *(u32x4*)(rawt + pc * 8) = rr[i]; }
        { float xf[19];
#pragma unroll
          for (int r = 0; r < 19; ++r) xf[r] = bflo((unsigned)rawt[r * 64 + lane]);
#pragma unroll
          for (int tk = 0; tk < 16; ++tk) xw[tk * 68 + lane] = wb + w0 * xf[tk] + w1 * xf[tk + 1] + w2 * xf[tk + 2] + w3 * xf[tk + 3]; }
        if (s + 1 < nst) load_raw((DIR == 0 ? s + 1 : nst - 2 - s) * 128);
        bf16x8 Af[2];
#pragma unroll
        for (int ks = 0; ks < 2; ++ks) { const f32x4 a0 = *(const f32x4*)(xw + l16 * 68 + ks * 32 + kg * 8), a1 = *(const f32x4*)(xw + l16 * 68 + ks * 32 + kg * 8 + 4);
            u32x4 pk; pk[0] = pk2(a0[0], a0[1]); pk[1] = pk2(a0[2], a0[3]); pk[2] = pk2(a1[0], a1[1]); pk[3] = pk2(a1[2], a1[3]); Af[ks] = __builtin_bit_cast(bf16x8, pk); }
        float hh[4][4], pp[4][4], Pl[4], Hl[4];
#pragma unroll
        for (int cq = 0; cq < 4; ++cq) { f32x4 ar = (f32x4){0.f, 0.f, 0.f, 0.f}, ai = (f32x4){0.f, 0.f, 0.f, 0.f};
#pragma unroll
            for (int ks = 0; ks < 2; ++ks) { const bf16x8 Br = *(const bf16x8*)(wgl + (cq * 16 + l16) * 72 + ks * 32 + kg * 8), Bi = *(const bf16x8*)(wgl + ((4 + cq) * 16 + l16) * 72 + ks * 32 + kg * 8);
                ar = __builtin_amdgcn_mfma_f32_16x16x32_bf16(Af[ks], Br, ar, 0, 0, 0); ai = __builtin_amdgcn_mfma_f32_16x16x32_bf16(Af[ks], Bi, ai, 0, 0, 0); }
            float H = 0.f, P = 1.f;
#pragma unroll
            for (int jj = 0; jj < 4; ++jj) { const int i = DIR == 0 ? jj : 3 - jj;
                const float r = fsig(ar[i] + br[cq]), ig = fsig(ai[i] + bi[cq]), x = xw[(kg * 4 + i) * 68 + cq * 16 + l16];
                const float a = __builtin_amdgcn_exp2f(r * ls8[cq]); const float u = __builtin_amdgcn_sqrtf(fmaf(-a, a, 1.0f)) * ig * x; H = fmaf(a, H, u); P *= a; hh[cq][i] = H; pp[cq][i] = P; }
            Pl[cq] = P; Hl[cq] = H; }
        float Pe[4], He[4];
#pragma unroll
        for (int cq = 0; cq < 4; ++cq) {
#pragma unroll
            for (int d = 1; d <= 2; d <<= 1) { const int src = (DIR == 0 ? lane - 16 * d : lane + 16 * d) & 63; const bool ok = DIR == 0 ? kg >= d : kg <= 3 - d;
                const float Pp = __shfl(Pl[cq], src), Hp = __shfl(Hl[cq], src);
                if (ok) { Hl[cq] = fmaf(Pl[cq], Hp, Hl[cq]); Pl[cq] *= Pp; } }
            const int src = (DIR == 0 ? lane - 16 : lane + 16) & 63; const bool ok = DIR == 0 ? kg >= 1 : kg <= 2;
            const float Pp = __shfl(Pl[cq], src), Hp = __shfl(Hl[cq], src); Pe[cq] = ok ? Pp : 1.0f; He[cq] = ok ? Hp : 0.0f; }
        if (kg == (DIR == 0 ? 3 : 0)) {
#pragma unroll
            for (int cq = 0; cq < 4; ++cq) { float* sp = segs + ((par * 8 + wid) * 64 + cq * 16 + l16) * 2; sp[0] = Pl[cq]; sp[1] = Hl[cq]; } }
        __syncthreads();
        float cwl = cst[par * 64 + lane];
        { float sP[8], sH[8];
#pragma unroll
          for (int w2 = 0; w2 < 8; ++w2) { const f32x2_t v = *(const f32x2_t*)(segs + ((par * 8 + w2) * 64 + lane) * 2); sP[w2] = v[0]; sH[w2] = v[1]; }
#pragma unroll
          for (int jj = 0; jj < 8; ++jj) { const int w2 = DIR == 0 ? jj : 7 - jj; const bool before = DIR == 0 ? w2 < wid : w2 > wid; if (before) cwl = fmaf(sP[w2], cwl, sH[w2]); } }
#pragma unroll
        for (int cq = 0; cq < 4; ++cq) { const int c = cq * 16 + l16; const float cwv = __shfl(cwl, c);
            const float cl = fmaf(Pe[cq], cwv, He[cq]);
#pragma unroll
            for (int i = 0; i < 4; ++i) hh[cq][i] = fmaf(pp[cq][i], cl, hh[cq][i]);
            if (wid == (DIR == 0 ? 7 : 0) && kg == (DIR == 0 ? 3 : 0)) cst[(par ^ 1) * 64 + c] = hh[cq][DIR == 0 ? 3 : 0];
#pragma unroll
            for (int i = 0; i < 4; ++i) xw[(kg * 4 + i) * 68 + c] = hh[cq][i];
        }
#pragma unroll
        for (int i = 0; i < 2; ++i) { const int pc = lane + i * 64, tk = pc >> 3, part = pc & 7; const f32x4 h0 = *(const f32x4*)(xw + tk * 68 + part * 8), h1 = *(const f32x4*)(xw + tk * 68 + part * 8 + 4);
            float y[8], t[8], o[8]; unpack8(yv4[i], y); unpack8(tv4[i], t);
#pragma unroll
            for (int e = 0; e < 4; ++e) { o[e] = fmaf(h0[e], y[e], t[e]); o[4 + e] = fmaf(h1[e], y[4 + e], t[4 + e]); }
            if (wet) *(u32x4*)(yo + (size_t)(m0 + base + wid * 16 + tk) * 1024 + part * 8) = pack8(o); }
    }
    __syncthreads();
    if (wet && seq < 16 && tid < 64) p.out()[OUT_ST + (((size_t)seq * 2 + l) * 2 + DIR) * 1024 + n * 64 + tid] = cst[(nst & 1) * 64 + tid];
    __syncthreads();
}
DI void lru_item(const KP p, int l, int seq, int n, unsigned char* shm, bool wet = true) {
    __syncthreads();
    lru_sweep<0>(p, l, seq, n, shm, wet);
    lru_sweep<1>(p, l, seq, n, shm, wet);
}

DI void attn_item(const KP p, int l, int seq, int hk, int qb, unsigned char* shm, bool wet = true) {
    const int tid = ltid(), lane = tid & 63, wid = tid >> 6, h = lane >> 5, l32 = lane & 31;
    const bool lat = seq >= 16; const int m0 = lat ? MCTX + (seq - 16) * 1024 : seq * 256; const int Sk = lat ? 1280 : 256, nt = Sk >> 6;
    bf16_t* slots = (bf16_t*)(p.ws() + OFF_SLOTS); bf16_t* qbuf = slots + 3 * SLOT_E;
    const bf16_t* kraw = (const bf16_t*)(p.ws() + OFF_KRAW); const bf16_t* ck = (const bf16_t*)(p.ws() + OFF_CK);
    const bf16_t* vT = (const bf16_t*)(p.ws() + OFF_VT) + (lat ? VT_LAT_E + (size_t)((seq - 16) * 4 + hk) * 64 * 1280 : (size_t)(seq * 4 + hk) * 64 * 256);
    bf16_t* Kt = (bf16_t*)shm; bf16_t* Vt = (bf16_t*)(shm + 4 * 9216);
    const int head = hk * 4 + (wid >> 1); const int mq = m0 + qb * 64 + (wid & 1) * 32 + l32;
    bf16x8 Qf[4];
    { float qv[4][8]; float ss = 0.f;
#pragma unroll
      for (int ks = 0; ks < 4; ++ks) { unpack8(*(const u32x4*)(qbuf + (size_t)mq * 1024 + head * 64 + ks * 16 + h * 8), qv[ks]);
#pragma unroll
          for (int j = 0; j < 8; ++j) ss += qv[ks][j] * qv[ks][j]; }
      ss += __shfl_xor(ss, 32);
      const float rs = rsqrtf(ss * (1.0f / 64.0f) + 1e-6f);
      const float* gq = p.in(20) + l * 64 + h * 8;
#pragma unroll
      for (int ks = 0; ks < 4; ++ks) { const f32x4 g0 = *(const f32x4*)(gq + ks * 16), g1 = *(const f32x4*)(gq + ks * 16 + 4);
#pragma unroll
          for (int j = 0; j < 4; ++j) { qv[ks][j] *= rs * g0[j]; qv[ks][4 + j] *= rs * g1[j]; } }
      if (lat) { const int t = mq - m0;
#pragma unroll
          for (int j = 0; j < 8; ++j) { const float inv = exp2f(-(float)(h * 8 + j) * (13.287712379549449f / 16.0f));
              const float ar = (float)(t >> 6) * inv, ac = (float)(t & 63) * inv; const float cr = __cosf(ar), sr = __sinf(ar), cc = __cosf(ac), sc = __sinf(ac);
              const float a1 = qv[0][j], a2 = qv[1][j], b1 = qv[2][j], b2 = qv[3][j];
              qv[0][j] = a1 * cr - a2 * sr; qv[1][j] = a1 * sr + a2 * cr; qv[2][j] = b1 * cc - b2 * sc; qv[3][j] = b1 * sc + b2 * cc; } }
#pragma unroll
      for (int ks = 0; ks < 4; ++ks) Qf[ks] = __builtin_bit_cast(bf16x8, pack8(qv[ks])); }
    float offs;
    { float qq = 0.f;
#pragma unroll
      for (int ks = 0; ks < 4; ++ks)
#pragma unroll
          for (int j = 0; j < 8; ++j) { const float v = __uint_as_float(((unsigned)(unsigned short)Qf[ks][j]) << 16); qq += v * v; }
      qq += __shfl_xor(qq, 32);
      const float* kb = (const float*)(p.ws() + OFF_KMAX); float kmx = kb[64 + l]; if (lat) kmx = fmaxf(kmx, kb[(l * 8 + (seq - 16)) * 4 + hk]);
      offs = 1.01f * 0.125f * 1.4426950408889634f * sqrtf(qq * kmx); }
    const int lr = tid >> 3, lp = tid & 7;
    auto kaddr = [&](int kt) -> const bf16_t* { if (lat) { return kt < 4 ? ck + ((size_t)(seq - 16) * 256 + kt * 64 + lr) * 256 + hk * 64 + lp * 8 : kraw + (size_t)(m0 + (kt - 4) * 64 + lr) * 256 + hk * 64 + lp * 8; }
                                                  return kraw + (size_t)(m0 + kt * 64 + lr) * 256 + hk * 64 + lp * 8; };
    u32x4 kA = *(const u32x4*)kaddr(0), vA = *(const u32x4*)(vT + (size_t)lr * Sk + lp * 8);
    u32x4 kB = *(const u32x4*)kaddr(1), vB = *(const u32x4*)(vT + (size_t)lr * Sk + 64 + lp * 8);
    f32x16 O0, O1;
#pragma unroll
    for (int r = 0; r < 16; ++r) { O0[r] = 0.f; O1[r] = 0.f; }
    float lrun = 0.f; const float cs = 0.125f * 1.4426950408889634f;
    auto compute = [&](const bf16_t* Kb, const bf16_t* Vb) {
        f32x16 st0, st1;
#pragma unroll
        for (int r = 0; r < 16; ++r) { st0[r] = 0.f; st1[r] = 0.f; }
        bf16x8 ka[4][2];
#pragma unroll
        for (int ks = 0; ks < 4; ++ks) { ka[ks][0] = *(const bf16x8*)(Kb + (l32) * 72 + ks * 16 + h * 8); ka[ks][1] = *(const bf16x8*)(Kb + (32 + l32) * 72 + ks * 16 + h * 8); }
        __builtin_amdgcn_s_setprio(1);
#pragma unroll
        for (int ks = 0; ks < 4; ++ks) { st0 = __builtin_amdgcn_mfma_f32_32x32x16_bf16(ka[ks][0], Qf[ks], st0, 0, 0, 0); st1 = __builtin_amdgcn_mfma_f32_32x32x16_bf16(ka[ks][1], Qf[ks], st1, 0, 0, 0); }
        __builtin_amdgcn_s_setprio(0);
        float psum = 0.f;
#pragma unroll
        for (int r = 0; r < 16; ++r) { const float p0 = __builtin_amdgcn_exp2f(fmaf(st0[r], cs, -offs)), p1 = __builtin_amdgcn_exp2f(fmaf(st1[r], cs, -offs)); st0[r] = p0; st1[r] = p1; psum += p0 + p1; }
        lrun += psum;
#pragma unroll
        for (int kb = 0; kb < 2; ++kb)
#pragma unroll
            for (int s = 0; s < 2; ++s) {
                u32x4 pb;
                if (kb == 0) { pb[0] = pk2(st0[8 * s + 0], st0[8 * s + 1]); pb[1] = pk2(st0[8 * s + 2], st0[8 * s + 3]); pb[2] = pk2(st0[8 * s + 4], st0[8 * s + 5]); pb[3] = pk2(st0[8 * s + 6], st0[8 * s + 7]); }
                else { pb[0] = pk2(st1[8 * s + 0], st1[8 * s + 1]); pb[1] = pk2(st1[8 * s + 2], st1[8 * s + 3]); pb[2] = pk2(st1[8 * s + 4], st1[8 * s + 5]); pb[3] = pk2(st1[8 * s + 6], st1[8 * s + 7]); }
                const bf16x8 Pb = __builtin_bit_cast(bf16x8, pb);
                { const bf16_t* vp = Vb + (l32) * 68 + kb * 32 + 16 * s + 4 * h; const u32x2 v0 = *(const u32x2*)vp, v1 = *(const u32x2*)(vp + 8); u32x4 va; va[0] = v0[0]; va[1] = v0[1]; va[2] = v1[0]; va[3] = v1[1];
                  O0 = __builtin_amdgcn_mfma_f32_32x32x16_bf16(__builtin_bit_cast(bf16x8, va), Pb, O0, 0, 0, 0); }
                { const bf16_t* vp = Vb + (32 + l32) * 68 + kb * 32 + 16 * s + 4 * h; const u32x2 v0 = *(const u32x2*)vp, v1 = *(const u32x2*)(vp + 8); u32x4 va; va[0] = v0[0]; va[1] = v0[1]; va[2] = v1[0]; va[3] = v1[1];
                  O1 = __builtin_amdgcn_mfma_f32_32x32x16_bf16(__builtin_bit_cast(bf16x8, va), Pb, O1, 0, 0, 0); }
            }
    };
#pragma unroll 1
    for (int it = 0; it < (nt >> 1); ++it) {
        const int sb = (it & 1) * 2; bf16_t* K0 = Kt + sb * 4608; bf16_t* K1 = K0 + 4608; bf16_t* V0 = Vt + sb * 4352; bf16_t* V1 = V0 + 4352;
        *(u32x4*)(K0 + lr * 72 + lp * 8) = kA; *(u32x4*)(K1 + lr * 72 + lp * 8) = kB;
        { u32x2 w0, w1; w0[0] = vA[0]; w0[1] = vA[1]; w1[0] = vA[2]; w1[1] = vA[3]; *(u32x2*)(V0 + lr * 68 + lp * 8) = w0; *(u32x2*)(V0 + lr * 68 + lp * 8 + 4) = w1; }
        { u32x2 w0, w1; w0[0] = vB[0]; w0[1] = vB[1]; w1[0] = vB[2]; w1[1] = vB[3]; *(u32x2*)(V1 + lr * 68 + lp * 8) = w0; *(u32x2*)(V1 + lr * 68 + lp * 8 + 4) = w1; }
        __syncthreads();
        const int kt = it * 2;
        if (kt + 2 < nt) { kA = *(const u32x4*)kaddr(kt + 2); vA = *(const u32x4*)(vT + (size_t)lr * Sk + (kt + 2) * 64 + lp * 8);
                           kB = *(const u32x4*)kaddr(kt + 3); vB = *(const u32x4*)(vT + (size_t)lr * Sk + (kt + 3) * 64 + lp * 8); }
        compute(K0, V0);
        compute(K1, V1);
    }
    const float ltot = lrun + __shfl_xor(lrun, 32); const float inv = 1.0f / ltot;
    if (wet)
#pragma unroll
    for (int rg = 0; rg < 4; ++rg) { const int d = 8 * rg + 4 * h; u32x2 o;
        o[0] = pk2(O0[4 * rg] * inv, O0[4 * rg + 1] * inv); o[1] = pk2(O0[4 * rg + 2] * inv, O0[4 * rg + 3] * inv); *(u32x2*)(qbuf + (size_t)mq * 1024 + head * 64 + d) = o;
        o[0] = pk2(O1[4 * rg] * inv, O1[4 * rg + 1] * inv); o[1] = pk2(O1[4 * rg + 2] * inv, O1[4 * rg + 3] * inv); *(u32x2*)(qbuf + (size_t)mq * 1024 + head * 64 + 32 + d) = o; }
    __syncthreads();
}

__global__ void __launch_bounds__(512) mega(Params p_unused) {
    KP p = fresh_kp();
    extern __shared__ __attribute__((aligned(16))) unsigned char shm[];
    cg::grid_group grid = cg::this_grid();
    LAS unsigned char* lds = (LAS unsigned char*)shm;
    bf16_t* slots = (bf16_t*)(p.ws() + OFF_SLOTS); unsigned char* W = p.ws() + OFF_W;
    const int G = lgdim(), c = lbid();
    if (lbid() < 0) grid.sync();
    gbar_post(p, shm);
    phase_mod(p, shm);
    phase_kbound(p, shm);
    phase_weights(p, 0, shm);
#if EXP == 5
    phase_mod(p, shm); phase_weights(p, 0, shm);
#endif
    gbar(p, shm); p = fresh_kp();
#pragma unroll 1
    for (int l = 0; l < 2; ++l) {
        const float* modl = (const float*)(p.ws() + OFF_MOD) + (size_t)l * 9 * 6144;
        if (l == 0) { phase_norm(p, 0, true, p.in(7), 0, 1024, slots, false);
#if EXP == 1
        for (int r = 0; r < 12; ++r) gbar(p, shm);
#endif
        gbar(p, shm); p = fresh_kp(); }
        { pg8::Gemm g{slots, (const bf16_t*)(W + W_IN), 1024, 1024, 1024, 48, 30, 1, 0, 0, 0, 0, 0};
          EpiInProj E{slots, (bf16_t*)(p.ws() + OFF_KRAW), (bf16_t*)(p.ws() + OFF_VRAW), p.in(12) + (size_t)l * 3072};
          pg8::gemm_phase(lds, g, E);
#if EXP == 4
          __syncthreads(); pg8::gemm_phase(lds, g, E);
#endif
        }
        gbar(p, shm); p = fresh_kp();
        phase_e1_elem(p, l, shm);
        if (l == 1) { __syncthreads(); phase_weights(p, 1, shm, 4); }
#if EXP == 8
        __syncthreads(); phase_e1_elem(p, l, shm, 14);
#endif
        gbar(p, shm); p = fresh_kp();
        { pg8::Gemm g{slots, (const bf16_t*)(W + W_POOL), 1024, 256, 256, 48, 4, 1, 0, 256, 0, 0, 0};
          EpiScaleBf16 E{slots, 1024, 0, p.in(23) + (size_t)l * 1024};
          if (G != 256) pg8::gemm_phase(lds, g, E); else if (c >= 128) pg8::gemm_phase(lds, g, E, 128, c - 128); }
        __syncthreads();
#if EXP == 3
        { const bool dry = lbid() < 0;
          if (c < 128) lru_item(p, l, 16 + (c >> 4), c & 15, shm, dry); else { for (int k = 0; k < 2; ++k) { const int it = (c - 128) * 2 + k; lru_item(p, l, it >> 4, it & 15, shm, dry); } } }
#endif
        if (G == 256) { if (c < 128) lru_item(p, l, 16 + (c >> 4), c & 15, shm); else { for (int k = 0; k < 2; ++k) { const int it = (c - 128) * 2 + k; lru_item(p, l, it >> 4, it & 15, shm); } } }
        else for (int it = c; it < 384; it += G) { if (it < 128) lru_item(p, l, 16 + (it >> 4), it & 15, shm); else lru_item(p, l, (it - 128) >> 4, (it - 128) & 15, shm); }
#if EXP == 2
        { const bool dry = lbid() < 0;
            for (int it = c; it < 512; it += 256) attn_item(p, l, 16 + (it >> 6), (it >> 4) & 3, it & 15, shm, dry);
            if (c >= 128) for (int k = 0; k < 2; ++k) { const int j = (c - 128) * 2 + k; attn_item(p, l, j >> 4, (j >> 2) & 3, j & 3, shm, dry); } }
#endif
        if (G == 256) {
            for (int it = c; it < 512; it += 256) attn_item(p, l, 16 + (it >> 6), (it >> 4) & 3, it & 15, shm);
            if (c >= 128) for (int k = 0; k < 2; ++k) { const int j = (c - 128) * 2 + k; attn_item(p, l, j >> 4, (j >> 2) & 3, j & 3, shm); }
        } else
        for (int it = c; it < 768; it += G) { if (it < 512) attn_item(p, l, 16 + (it >> 6), (it >> 4) & 3, it & 15, shm); else { const int j = it - 512; attn_item(p, l, j >> 4, (j >> 2) & 3, j & 3, shm); } }
        gbar(p, shm); p = fresh_kp();
        { pg8::Gemm g{slots + 4 * SLOT_E, (const bf16_t*)(W + W_BR), 1024, 1024, 1024, 48, 4, 1, 0, 0, -(long)SLOT_E, -4 * (long)SLOT_E, (long)1024 * 1024};
          EpiMerge E{slots + 5 * SLOT_E, false};
#if EXP == 9
          { EpiMerge E2{slots + 5 * SLOT_E, lbid() >= 0}; pg8::gemm_phase(lds, g, E2); __syncthreads(); }
#endif
          pg8::gemm_phase(lds, g, E); }
        gbar(p, shm); p = fresh_kp();
        { pg8::Gemm g{slots + 7 * SLOT_E, (const bf16_t*)(W + W_O), 1024, 1024, 1024, 48, 4, 1, 0, 0, 0, 0, 0};
          EpiResidNorm E{p.out(), modl, 2048, 0, p.in(8) + l * 1024, modl, 3072, 4096, slots, (float*)(p.ws() + OFF_RSS), (unsigned*)(p.ws() + OFF_CNT) + (l * 2 + 0) * 48, (unsigned*)(p.ws() + OFF_BAR), (float*)(shm + 131072 + 16)};
          pg8::gemm_phase(lds, g, E); }
        gbar(p, shm); p = fresh_kp();
        { pg8::Gemm g{slots, (const bf16_t*)(W + W_UP), 1024, 1024, 1024, 48, 24, 1, 0, 0, 0, 0, 0};
          float* zedge = (float*)(slots + 1 * SLOT_E); float* zpart = zedge + (size_t)192 * 2 * 6144;
          EpiUpFused E{slots + 5 * SLOT_E, zedge, zpart, p.in(29) + (size_t)l * 3 * 6144, p.in(30) + (size_t)l * 6144};
          pg8::gemm_phase(lds, g, E);
          if (l == 0 && G == 256 && c >= 128) { __syncthreads(); phase_weights(p, 1, shm, 1 | 8 | 16, 128, c - 128); }
          else if (l == 0 && G != 256) { __syncthreads(); phase_weights(p, 1, shm, 1 | 8 | 16); } }
        gbar(p, shm); p = fresh_kp();
        { pg8::Gemm g{slots + 5 * SLOT_E, (const bf16_t*)(W + W_DOWN), 3072, 3072, 3072, 48, 4, 1, 0, 0, 0, 0, 0};
          { Unit u0; if (pg8::next_unit(g, 0, G, c, u0)) { const float* zedge = (const float*)(slots + 1 * SLOT_E);
              ffn_fixup(u0.pm, slots + 5 * SLOT_E, zedge, zedge + (size_t)192 * 2 * 6144, p.in(29) + (size_t)l * 3 * 6144, p.in(30) + (size_t)l * 6144); } }
          const float* modn = (const float*)(p.ws() + OFF_MOD) + (size_t)9 * 6144;
          EpiResidNorm E{p.out(), modl, 5120, l == 0 ? 0 : 1, l == 0 ? p.in(7) + 1024 : p.in(32), modn, 0, 1024, slots, (float*)(p.ws() + OFF_RSS), (unsigned*)(p.ws() + OFF_CNT) + (l * 2 + 1) * 48, (unsigned*)(p.ws() + OFF_BAR), (float*)(shm + 131072 + 16)};
          pg8::gemm_phase(lds, g, E);
          if (l == 0 && G == 256 && c >= 192) phase_weights(p, 1, shm, 2, 64, c - 192);
          else if (l == 0 && G != 256) { __syncthreads(); phase_weights(p, 1, shm, 2); } }
        gbar(p, shm); p = fresh_kp();
    }
}

extern "C" void kernel_launch(void* const* d_in, const int* in_sizes, int n_in, void* d_out, int out_size, void* d_ws, size_t ws_size, hipStream_t stream) {
    static int grid_blocks = 0;
    if (!grid_blocks) {
        int dev = 0, cus = 0, per_cu = 0;
        (void)hipGetDevice(&dev);
        (void)hipDeviceGetAttribute(&cus, hipDeviceAttributeMultiprocessorCount, dev);
        if (hipFuncSetAttribute((const void*)mega, hipFuncAttributeMaxDynamicSharedMemorySize, LDS_BYTES) != hipSuccess) { fprintf(stderr, "setattr failed\n"); return; }
        if (hipOccupancyMaxActiveBlocksPerMultiprocessor(&per_cu, (const void*)mega, 512, LDS_BYTES) != hipSuccess || per_cu < 1) { fprintf(stderr, "occupancy query failed\n"); return; }
        grid_blocks = cus;
    }
    if (ws_size < WS_NEED || n_in < 33) { fprintf(stderr, "workspace too small: %zu < %zu\n", ws_size, (size_t)WS_NEED); return; }
    Params p{};
    for (int i = 0; i < 33; ++i) p.in[i] = (const float*)d_in[i];
    p.out = (float*)d_out; p.ws = (unsigned char*)d_ws;
    (void)hipMemsetAsync((unsigned char*)d_ws + OFF_BAR, 0, (size_t)XCD_BAR_WORDS * 4 + 256 * 4 + 256 * 4, stream);
    void* args[] = {&p};
    hipError_t e = hipLaunchCooperativeKernel((void*)mega, dim3(grid_blocks), dim3(512), args, LDS_BYTES, stream);
    if (e != hipSuccess) fprintf(stderr, "cooperative launch failed: %s (grid %d)\n", hipGetErrorString(e), grid_blocks);
}
```

```cpp
#include <hip/hip_runtime.h>
#include <hip/hip_cooperative_groups.h>
#include <cstdio>
namespace cg = cooperative_groups;

#define LAS __attribute__((address_space(3)))
#define DI __device__ __forceinline__
typedef unsigned short bf16_t;
typedef short bf16x8 __attribute__((ext_vector_type(8)));
typedef float f32x4 __attribute__((ext_vector_type(4)));
typedef float f32x16 __attribute__((ext_vector_type(16)));
typedef unsigned u32x4 __attribute__((ext_vector_type(4)));
typedef unsigned u32x2 __attribute__((ext_vector_type(2)));
typedef float f32x2_t __attribute__((ext_vector_type(2)));
typedef __bf16 bfx2 __attribute__((ext_vector_type(2)));

constexpr int MT = 12288, MCTX = 4096, DM = 1024;
constexpr size_t SLOT_E = (size_t)MT * 1024;
constexpr size_t SLOT_B = SLOT_E * 2;
constexpr size_t OFF_SLOTS = 0;
constexpr size_t OFF_KRAW = 8 * SLOT_B;
constexpr size_t OFF_VRAW = OFF_KRAW + (size_t)MT * 256 * 2;
constexpr size_t OFF_CK = OFF_VRAW + (size_t)MT * 256 * 2;
constexpr size_t OFF_VT = OFF_CK + (size_t)8 * 256 * 256 * 2;
constexpr size_t VT_LAT_E = (size_t)16 * 4 * 64 * 256;
constexpr size_t OFF_W = OFF_VT + ((size_t)16 * 4 * 64 * 256 + (size_t)8 * 4 * 64 * 1280) * 2;
constexpr size_t W_IN = 0, W_BR = W_IN + (size_t)7680 * 1024 * 2, W_O = W_BR + (size_t)3 * 1024 * 1024 * 2, W_UP = W_O + (size_t)1024 * 1024 * 2,
                 W_DOWN = W_UP + (size_t)6144 * 1024 * 2, W_POOL = W_DOWN + (size_t)1024 * 3072 * 2, W_GATE = W_POOL + (size_t)1024 * 256 * 2, W_END = W_GATE + (size_t)16 * 2 * 128 * 64 * 2;
constexpr size_t OFF_MOD = OFF_W + W_END;
constexpr size_t OFF_BAR = OFF_MOD + (size_t)2 * 9 * 6144 * 4;
constexpr int XCD_BAR_WORDS = 3456;
constexpr size_t OFF_KMAX = OFF_BAR + (size_t)XCD_BAR_WORDS * 4;
constexpr size_t OFF_CNT = OFF_KMAX + 256 * 4;
constexpr size_t OFF_RSS = OFF_CNT + 256 * 4;
constexpr size_t WS_NEED = OFF_RSS + (size_t)MT * 16 * 4;
#ifndef EXP
#define EXP 0
#endif
constexpr int LDS_BYTES = 131072 + 16 + 4096;
constexpr size_t OUT_CK = (size_t)MT * 1024, OUT_CV = OUT_CK + (size_t)16 * 2 * 256 * 256, OUT_ST = OUT_CV + (size_t)16 * 2 * 256 * 256;

struct Params { const float* in[33]; float* out; unsigned char* ws; };
typedef const __attribute__((address_space(4))) unsigned char* kptr_t;
struct KP { kptr_t k;
    DI const float* in(int i) const { return *(const float* const __attribute__((address_space(4)))*)(k + 8 * i); }
    DI float* out() const { return *(float* const __attribute__((address_space(4)))*)(k + 8 * 33); }
    DI unsigned char* ws() const { return *(unsigned char* const __attribute__((address_space(4)))*)(k + 8 * 34); } };
DI KP fresh_kp() { kptr_t k = (kptr_t)__builtin_amdgcn_kernarg_segment_ptr(); asm volatile("" : "+s"(k)); KP p; p.k = k; return p; }
DI int ltid() { int t = threadIdx.x; asm volatile("" : "+v"(t)); return t; }
DI int lbid() { int t = blockIdx.x; asm volatile("" : "+s"(t)); return t; }
DI int lgdim() { int t = gridDim.x; asm volatile("" : "+s"(t)); return t; }

DI unsigned pk2(float a, float b) { bfx2 v; v[0] = (__bf16)a; v[1] = (__bf16)b; return __builtin_bit_cast(unsigned, v); }
DI float bflo(unsigned u) { return __uint_as_float(u << 16); }
DI float bfhi(unsigned u) { return __uint_as_float(u & 0xffff0000u); }
DI void unpack8(u32x4 v, float* f) { f[0] = bflo(v[0]); f[1] = bfhi(v[0]); f[2] = bflo(v[1]); f[3] = bfhi(v[1]); f[4] = bflo(v[2]); f[5] = bfhi(v[2]); f[6] = bflo(v[3]); f[7] = bfhi(v[3]); }
DI u32x4 pack8(const float* f) { u32x4 r; r[0] = pk2(f[0], f[1]); r[1] = pk2(f[2], f[3]); r[2] = pk2(f[4], f[5]); r[3] = pk2(f[6], f[7]); return r; }
DI float sigmoidf_(float x) { return __builtin_amdgcn_rcpf(1.0f + __builtin_amdgcn_exp2f(-1.4426950408889634f * x)); }
DI float gelu_tanh(float x) { const float z = 0.7978845608028654f * (x + 0.044715f * x * x * x); return x * sigmoidf_(2.0f * z); }
DI int seq_start(int m) { return m < MCTX ? (m & ~255) : (MCTX + ((m - MCTX) & ~1023)); }
DI int seq_len(int m) { return m < MCTX ? 256 : 1024; }
DI int mod_row(int m) { return m < MCTX ? 0 : 1 + ((m - MCTX) >> 10); }

namespace pg8 {
constexpr int BM = 256, BK = 64, HALF = 128, HTB = HALF * BK * 2, STAGE_BYTES = 8 * HTB, NXCD = 8, WGM = 8;
DI int lds_byte(int r, int c) { const int st = (r >> 4) * 2 + (c >> 5), rr = r & 15, cc = c & 31, ob = rr * 64 + cc * 2; return st * 1024 + (ob ^ (((ob >> 9) & 1) << 5)); }
DI void stage_rc(int b, int& R, int& C) { const int st = b / 1024, sb = b % 1024, swz = sb ^ (((sb >> 9) & 1) << 5); R = (st >> 1) * 16 + swz / 64; C = (st & 1) * 32 + (swz % 64) / 2; }
DI int perm32(int rho) { const int n = rho >> 4, i = rho & 15; return 8 * (i >> 2) + 4 * n + (i & 3); }
struct Unit { int pm, pn, seg; };
struct Gemm { const bf16_t* A; const bf16_t* Bt; int lda, ldb, K; int nM, nN, nSeg, pn0; long a_pn_stride, a_seg1, a_seg2, b_seg_stride; };
DI bool next_unit(const Gemm& g, int i, int G, int c, Unit& u) {
    const int nwg = g.nM * g.nN; const int it = i / g.nSeg; u.seg = i - it * g.nSeg;
    const long L = (long)it * G + c; if (L >= nwg) return false;
    int wgid = (int)L; { const int q = nwg / NXCD, r = nwg % NXCD, xcd = wgid % NXCD, off = wgid / NXCD; wgid = (xcd < r ? xcd * (q + 1) : r * (q + 1) + (xcd - r) * q) + off; }
    const int nig = WGM * g.nN, gid = wgid / nig, fm = gid * WGM, gsz = (g.nM - fm) < WGM ? (g.nM - fm) : WGM;
    u.pm = fm + ((wgid % nig) % gsz); u.pn = (wgid % nig) / gsz; return true;
}
DI const char* a_ptr(const Gemm& g, const Unit& u) { return (const char*)(g.A + (size_t)u.pm * 256 * g.lda + (size_t)u.pn * g.a_pn_stride + (u.seg == 0 ? 0 : (u.seg == 1 ? g.a_seg1 : g.a_seg2))); }
DI const char* b_ptr(const Gemm& g, const Unit& u) { return (const char*)(g.Bt + (size_t)(g.pn0 + u.pn) * 256 * g.ldb + (size_t)u.seg * g.b_seg_stride); }

template <class Epi>
DI void gemm_phase(LAS unsigned char* lds, const Gemm g, const Epi& E, int Gv = 0, int cv = 0) {
    const int tid = ltid(), wid = __builtin_amdgcn_readfirstlane(tid >> 6), lane = tid & 63, wr = wid >> 2, wc = wid & 3, fr = lane & 15, fq = lane >> 4;
    constexpr bool MERGE = Epi::MERGE;
    const int K = g.K, nt = MERGE ? 3 * (K / BK) : K / BK; const int G = Gv > 0 ? Gv : lgdim(), c = Gv > 0 ? cv : lbid();
    unsigned voffA[2], voffB[2];
#pragma unroll
    for (int i = 0; i < 2; ++i) { int R, C; stage_rc(tid * 16 + i * 8192, R, C); const int Rb = Epi::PERM ? ((R & ~31) + perm32(R & 31)) : R;
        voffA[i] = (unsigned)(R * g.lda + C) * 2u; voffB[i] = (unsigned)(Rb * g.ldb + C) * 2u; }
    const size_t kstep = (size_t)(BK * 2);
    const size_t hstepA = (size_t)HALF * g.lda * 2, hstepB = (size_t)HALF * g.ldb * 2;
    const unsigned ldsw = (unsigned)wid * 1024u;
    const int aoff = lds_byte(wr * 64 + fr, fq * 8), boff = lds_byte(wc * 32 + fr, fq * 8);
#define PG8_SA(b, h) (((b) * 2 + (h)) * HTB)
#define PG8_SB(b, h) ((4 + (b) * 2 + (h)) * HTB)
#define PG8_STAGE(bufoff, gbase, voff) do { _Pragma("unroll") for (int _i = 0; _i < 2; ++_i) \
        __builtin_amdgcn_global_load_lds((const unsigned*)((const char*)(gbase) + (voff)[_i]), (LAS unsigned*)(lds + (bufoff) + ldsw + _i * 8192), 16, 0, 0); } while (0)
#define PG8_LDA(dst, b, h) do { _Pragma("unroll") for (int m = 0; m < 4; ++m) _Pragma("unroll") for (int k = 0; k < 2; ++k) dst[m][k] = *(const LAS bf16x8*)(lds + PG8_SA(b, h) + aoff + m * 2048 + k * 1024); } while (0)
#define PG8_LDB(dst, b, h) do { _Pragma("unroll") for (int n = 0; n < 2; ++n) _Pragma("unroll") for (int k = 0; k < 2; ++k) dst[n][k] = *(const LAS bf16x8*)(lds + PG8_SB(b, h) + boff + n * 2048 + k * 1024); } while (0)
#define PG8_MMA(ai, bj, At, Bt) do { __builtin_amdgcn_s_setprio(1); _Pragma("unroll") for (int m = 0; m < 4; ++m) _Pragma("unroll") for (int n = 0; n < 2; ++n) _Pragma("unroll") for (int k = 0; k < 2; ++k) \
        acc[ai][bj][m][n] = __builtin_amdgcn_mfma_f32_16x16x32_bf16(Bt[n][k], At[m][k], acc[ai][bj][m][n], 0, 0, 0); __builtin_amdgcn_s_setprio(0); } while (0)
#define PG8_WAIT_V(n) asm volatile("s_waitcnt vmcnt(" #n ")" ::: "memory")
#define PG8_WAIT_L(n) asm volatile("s_waitcnt lgkmcnt(" #n ")" ::: "memory")
#define PG8_BAR __builtin_amdgcn_s_barrier()
#define PG8_SCHED __builtin_amdgcn_sched_barrier(0)
    Unit cur, nxt; int ui = 0;
    if (!next_unit(g, 0, G, c, cur)) return;
    f32x4 acc[2][2][4][2];
#pragma unroll
    for (int a = 0; a < 2; ++a)
#pragma unroll
        for (int b = 0; b < 2; ++b)
#pragma unroll
            for (int m = 0; m < 4; ++m)
#pragma unroll
                for (int n = 0; n < 2; ++n) acc[a][b][m][n] = (f32x4){0.f, 0.f, 0.f, 0.f};
    bf16x8 At[4][2], B0[2][2], B1[2][2];
    const char* cA = a_ptr(g, cur); const char* cB = b_ptr(g, cur);
    PG8_STAGE(PG8_SB(0, 0), cB, voffB); PG8_STAGE(PG8_SA(0, 0), cA, voffA); PG8_STAGE(PG8_SB(0, 1), cB + hstepB, voffB); PG8_STAGE(PG8_SA(0, 1), cA + hstepA, voffA);
    if (wr == 1) PG8_BAR;
    PG8_WAIT_V(4); PG8_BAR;
    PG8_STAGE(PG8_SB(1, 0), cB + kstep, voffB); PG8_STAGE(PG8_SA(1, 0), cA + kstep, voffA); PG8_STAGE(PG8_SB(1, 1), cB + hstepB + kstep, voffB);
    PG8_WAIT_V(6); PG8_BAR;
    for (;;) {
        const bool has_next = next_unit(g, ui + 1, G, c, nxt);
        const char* nA = has_next ? a_ptr(g, nxt) : cA; const char* nB = has_next ? b_ptr(g, nxt) : cB;
        for (int t = 0; t < nt; t += 2) {
            const bool last = (t == nt - 2);
            const char* a1; const char* a2; const char* b2; const char* a3; const char* b3;
            if constexpr (!MERGE) { a1 = cA + (size_t)(t + 1) * kstep; a2 = last ? nA : cA + (size_t)(t + 2) * kstep; b2 = last ? nB : cB + (size_t)(t + 2) * kstep; }
            else { const int ntk = K / BK; const int sg1 = (t + 1) / ntk, sg2 = (t + 2) / ntk;
                a1 = cA + (sg1 == 0 ? 0 : (sg1 == 1 ? g.a_seg1 : g.a_seg2)) * 2 + (size_t)(t + 1 - sg1 * ntk) * kstep;
                a2 = last ? nA : cA + (sg2 == 0 ? 0 : (sg2 == 1 ? g.a_seg1 : g.a_seg2)) * 2 + (size_t)(t + 2 - sg2 * ntk) * kstep;
                b2 = last ? nB : cB + (size_t)sg2 * g.b_seg_stride * 2 + (size_t)(t + 2 - sg2 * ntk) * kstep;
                if (t > 0 && t % ntk == 0) E.rescale(acc, cur, t / ntk, wr, wc, fr, fq); }
            a3 = a2 + kstep; b3 = b2 + kstep;
            PG8_LDB(B0, 0, 0); PG8_SCHED; PG8_LDA(At, 0, 0); PG8_STAGE(PG8_SA(1, 1), a1 + hstepA, voffA);
            PG8_WAIT_L(8); PG8_BAR; PG8_WAIT_L(0); PG8_MMA(0, 0, At, B0); PG8_BAR; PG8_SCHED;
            PG8_LDB(B1, 0, 1); PG8_STAGE(PG8_SB(0, 0), b2, voffB);
            PG8_BAR; PG8_WAIT_L(0); PG8_MMA(0, 1, At, B1); PG8_BAR;
            PG8_LDA(At, 0, 1); PG8_STAGE(PG8_SA(0, 0), a2, voffA);
            PG8_BAR; PG8_WAIT_L(0); PG8_MMA(1, 0, At, B0); PG8_BAR; PG8_SCHED;
            PG8_STAGE(PG8_SB(0, 1), b2 + hstepB, voffB);
            PG8_WAIT_V(6); PG8_BAR; PG8_MMA(1, 1, At, B1); PG8_BAR;
            PG8_LDB(B0, 1, 0); PG8_SCHED; PG8_LDA(At, 1, 0); PG8_STAGE(PG8_SA(0, 1), a2 + hstepA, voffA);
            PG8_WAIT_L(8); PG8_BAR; PG8_WAIT_L(0); PG8_MMA(0, 0, At, B0); PG8_BAR; PG8_SCHED;
            PG8_LDB(B1, 1, 1); PG8_STAGE(PG8_SB(1, 0), b3, voffB);
            PG8_BAR; PG8_WAIT_L(0); PG8_MMA(0, 1, At, B1); PG8_BAR;
            PG8_LDA(At, 1, 1); PG8_STAGE(PG8_SA(1, 0), a3, voffA);
            PG8_BAR; PG8_WAIT_L(0); PG8_MMA(1, 0, At, B0); PG8_BAR; PG8_SCHED;
            PG8_STAGE(PG8_SB(1, 1), b3 + hstepB, voffB);
            PG8_WAIT_V(6); PG8_BAR; PG8_MMA(1, 1, At, B1); PG8_BAR;
        }
        if constexpr (!Epi::AFTER_DRAIN) E(acc, cur, wr, wc, fr, fq);
        if (!has_next) break;
#pragma unroll
        for (int a = 0; a < 2; ++a)
#pragma unroll
            for (int b = 0; b < 2; ++b)
#pragma unroll
                for (int m = 0; m < 4; ++m)
#pragma unroll
                    for (int n = 0; n < 2; ++n) acc[a][b][m][n] = (f32x4){0.f, 0.f, 0.f, 0.f};
        cur = nxt; cA = nA; cB = nB; ++ui;
    }
    PG8_WAIT_V(0);
    if (wr == 0) PG8_BAR;
    PG8_BAR;
    if constexpr (Epi::AFTER_DRAIN) E.fused(acc, cur, wr, wc, fr, fq);
#undef PG8_SA
#undef PG8_SB
#undef PG8_STAGE
#undef PG8_LDA
#undef PG8_LDB
#undef PG8_MMA
#undef PG8_WAIT_V
#undef PG8_WAIT_L
#undef PG8_BAR
#undef PG8_SCHED
}
}
using pg8::Unit;
typedef f32x4 AccT[2][2][4][2];

struct EpiInProj {
    static constexpr bool PERM = true, MERGE = false, AFTER_DRAIN = false;
    bf16_t* slots; bf16_t* kraw; bf16_t* vraw; const float* b_gate;
    DI void operator()(const AccT& acc, const Unit& u, int wr, int wc, int fr, int fq) const {
        const int pn = u.pn; bf16_t* base; int ld = 1024, ccol, mode = 0; const float* bias = b_gate;
        if (pn < 4) { base = slots + 1 * SLOT_E; ccol = pn * 256; }
        else if (pn < 8) { base = slots + 2 * SLOT_E; ccol = (pn - 4) * 256; mode = 1; }
        else if (pn < 12) { base = slots + 3 * SLOT_E; ccol = (pn - 8) * 256; }
        else if (pn == 12) { base = kraw; ld = 256; ccol = 0; }
        else if (pn == 13) { base = vraw; ld = 256; ccol = 0; }
        else if (pn < 18) { base = slots + 4 * SLOT_E; ccol = (pn - 14) * 256; }
        else { const int sec = (pn - 18) >> 2; base = slots + (size_t)(5 + sec) * SLOT_E; ccol = ((pn - 18) & 3) * 256; mode = 2; bias = b_gate + (pn - 18) * 256; }
        const int row0 = u.pm * 256 + wr * 64 + fr, cl = wc * 32 + 8 * fq;
#pragma unroll
        for (int bj = 0; bj < 2; ++bj) {
            float bv[8];
#pragma unroll
            for (int e = 0; e < 8; ++e) bv[e] = (mode == 2) ? bias[cl + bj * 128 + e] : 0.f;
#pragma unroll
            for (int ai = 0; ai < 2; ++ai)
#pragma unroll
                for (int m = 0; m < 4; ++m) {
                    float v[8];
#pragma unroll
                    for (int e = 0; e < 4; ++e) { v[e] = acc[ai][bj][m][0][e]; v[4 + e] = acc[ai][bj][m][1][e]; }
                    if (mode == 1) {
#pragma unroll
                        for (int e = 0; e < 8; ++e) v[e] = gelu_tanh(v[e]);
                    } else if (mode == 2) {
#pragma unroll
                        for (int e = 0; e < 8; ++e) v[e] = sigmoidf_(v[e] + bv[e]);
                    }
                    *(u32x4*)(base + (size_t)(row0 + ai * 128 + m * 16) * ld + ccol + bj * 128 + cl) = pack8(v);
                }
        }
    }
};
struct EpiScaleBf16 {
    static constexpr bool PERM = true, MERGE = false, AFTER_DRAIN = false;
    bf16_t* O; int ldc; int pn_base; const float* scale;
    DI void operator()(const AccT& acc, const Unit& u, int wr, int wc, int fr, int fq) const {
        const int row0 = u.pm * 256 + wr * 64 + fr, cl = (u.pn + pn_base) * 256 + wc * 32 + 8 * fq;
#pragma unroll
        for (int bj = 0; bj < 2; ++bj) {
            float sv[8];
#pragma unroll
            for (int e = 0; e < 8; ++e) sv[e] = scale ? scale[cl + bj * 128 + e] : 1.0f;
#pragma unroll
            for (int ai = 0; ai < 2; ++ai)
#pragma unroll
                for (int m = 0; m < 4; ++m) {
                    float v[8];
#pragma unroll
                    for (int e = 0; e < 4; ++e) { v[e] = acc[ai][bj][m][0][e] * sv[e]; v[4 + e] = acc[ai][bj][m][1][e] * sv[4 + e]; }
                    *(u32x4*)(O + (size_t)(row0 + ai * 128 + m * 16) * ldc + cl + bj * 128) = pack8(v);
                }
        }
    }
};
struct EpiMerge {
    static constexpr bool PERM = true, MERGE = true, AFTER_DRAIN = false;
    bf16_t* gates; bool dry;
    DI void rescale(AccT& acc, const Unit& u, int sb, int wr, int wc, int fr, int fq) const {
        const int row0 = u.pm * 256 + wr * 64 + fr, cl = u.pn * 256 + wc * 32 + 8 * fq;
        const bf16_t* gp = gates + (size_t)(sb - 1) * SLOT_E + (size_t)row0 * 1024 + cl;
#pragma unroll
        for (int ai = 0; ai < 2; ++ai)
#pragma unroll
            for (int m = 0; m < 4; ++m) {
                asm volatile("" : "+v"(gp));
#pragma unroll
                for (int bj = 0; bj < 2; ++bj) {
                    float a[8], b[8]; unpack8(*(const u32x4*)(gp + bj * 128), a); unpack8(*(const u32x4*)(gp + SLOT_E + bj * 128), b);
#pragma unroll
                    for (int e = 0; e < 4; ++e) { acc[ai][bj][m][0][e] *= a[e] * __builtin_amdgcn_rcpf(b[e]); acc[ai][bj][m][1][e] *= a[4 + e] * __builtin_amdgcn_rcpf(b[4 + e]); }
                }
                gp += (m == 3 ? (128 - 48) : 16) * 1024;
            }
    }
    DI void operator()(const AccT& acc, const Unit& u, int wr, int wc, int fr, int fq) const {
        const int row0 = u.pm * 256 + wr * 64 + fr, cl = u.pn * 256 + wc * 32 + 8 * fq;
        bf16_t* gs = gates + 2 * SLOT_E;
#pragma unroll
        for (int ai = 0; ai < 2; ++ai)
#pragma unroll
            for (int m = 0; m < 4; ++m)
#pragma unroll
                for (int bj = 0; bj < 2; ++bj) {
                    const size_t idx = (size_t)(row0 + ai * 128 + m * 16) * 1024 + cl + bj * 128;
                    float gv[8]; unpack8(*(const u32x4*)(gs + idx), gv);
                    float v[8];
#pragma unroll
                    for (int e = 0; e < 4; ++e) { v[e] = acc[ai][bj][m][0][e] * gv[e]; v[4 + e] = acc[ai][bj][m][1][e] * gv[4 + e]; }
                    if (!dry) *(u32x4*)(gs + idx) = pack8(v);
                }
    }
};
DI float dpp_ror1(float v) { return __builtin_bit_cast(float, __builtin_amdgcn_update_dpp(0, __builtin_bit_cast(int, v), 0x121, 0xf, 0xf, false)); }
DI float dpp_ror15(float v) { return __builtin_bit_cast(float, __builtin_amdgcn_update_dpp(0, __builtin_bit_cast(int, v), 0x12f, 0xf, 0xf, false)); }
struct EpiUpFused {
    static constexpr bool PERM = true, MERGE = false, AFTER_DRAIN = false;
    bf16_t* act; float* zedge; float* zpart; const float* cw; const float* cb;
    DI void operator()(const AccT& acc, const Unit& u, int wr, int wc, int fr, int fq) const {
        const int j = u.pn, cl = wc * 32 + 8 * fq;
#pragma unroll
        for (int n = 0; n < 2; ++n) {
            const int ch0 = 128 * j + cl + 4 * n;
            const f32x4 bg = *(const f32x4*)(cb + ch0), w0g = *(const f32x4*)(cw + ch0), w1g = *(const f32x4*)(cw + 6144 + ch0), w2g = *(const f32x4*)(cw + 2 * 6144 + ch0);
            const f32x4 bv = *(const f32x4*)(cb + 3072 + ch0), w0v = *(const f32x4*)(cw + 3072 + ch0), w1v = *(const f32x4*)(cw + 6144 + 3072 + ch0), w2v = *(const f32x4*)(cw + 2 * 6144 + 3072 + ch0);
#pragma unroll
            for (int ai = 0; ai < 2; ++ai) {
                const int rowblk = u.pm * 256 + ai * 128 + wr * 64;
#pragma unroll
                for (int m = 0; m < 4; ++m) {
                    const f32x4 zg = acc[ai][0][m][n], zv = acc[ai][1][m][n];
                    f32x4 pg, pv, ng, nv;
#pragma unroll
                    for (int e = 0; e < 4; ++e) {
                        const float pgs = dpp_ror1(zg[e]), pvs = dpp_ror1(zv[e]), ngs = dpp_ror15(zg[e]), nvs = dpp_ror15(zv[e]);
                        const float pgw = m > 0 ? dpp_ror1(acc[ai][0][m > 0 ? m - 1 : 0][n][e]) : 0.f, pvw = m > 0 ? dpp_ror1(acc[ai][1][m > 0 ? m - 1 : 0][n][e]) : 0.f;
                        const float ngw = m < 3 ? dpp_ror15(acc[ai][0][m < 3 ? m + 1 : 3][n][e]) : 0.f, nvw = m < 3 ? dpp_ror15(acc[ai][1][m < 3 ? m + 1 : 3][n][e]) : 0.f;
                        pg[e] = fr == 0 ? pgw : pgs; pv[e] = fr == 0 ? pvw : pvs; ng[e] = fr == 15 ? ngw : ngs; nv[e] = fr == 15 ? nvw : nvs; }
                    const f32x4 preg = bg + w0g * pg + w1g * zg + w2g * ng, prev = bv + w0v * pv + w1v * zv + w2v * nv;
                    const bool e0 = (m == 0 && fr == 0), e1 = (m == 3 && fr == 15);
                    if (e0 || e1) { const size_t o = ((size_t)((rowblk >> 6) * 2 + (e1 ? 1 : 0))) * 6144 + j * 256 + cl + 4 * n;
                        *(f32x4*)(zpart + o) = preg; *(f32x4*)(zpart + o + 128) = prev; *(f32x4*)(zedge + o) = zg; *(f32x4*)(zedge + o + 128) = zv; }
                    else { u32x2 ov; ov[0] = pk2(preg[0] * sigmoidf_(preg[0]) * prev[0], preg[1] * sigmoidf_(preg[1]) * prev[1]); ov[1] = pk2(preg[2] * sigmoidf_(preg[2]) * prev[2], preg[3] * sigmoidf_(preg[3]) * prev[3]);
                        *(u32x2*)(act + (size_t)(rowblk + 16 * m + fr) * 3072 + ch0) = ov; }
                }
            }
        }
    }
};
DI void ffn_fixup(int pm, bf16_t* act, const float* zedge, const float* zpart, const float* cw, const float* cb) {
    const int tid = ltid();
    for (int pc = tid; pc < 8 * 768; pc += 512) {
        const int er = pc / 768, ch0 = (pc - er * 768) * 4; const int B = 4 * pm + (er >> 1), edge = er & 1;
        const int zc = (ch0 >> 7) * 256 + (ch0 & 127);
        const size_t o = ((size_t)(B * 2 + edge)) * 6144 + zc;
        f32x4 pg = *(const f32x4*)(zpart + o), pv = *(const f32x4*)(zpart + o + 128);
        const int row = B * 64 + (edge ? 63 : 0); const int s0 = seq_start(row), S = seq_len(row), t = row - s0;
        if (edge == 0 && t > 0) { const size_t q = ((size_t)((B - 1) * 2 + 1)) * 6144 + zc; pg += *(const f32x4*)(cw + ch0) * *(const f32x4*)(zedge + q); pv += *(const f32x4*)(cw + 3072 + ch0) * *(const f32x4*)(zedge + q + 128); }
        if (edge == 1 && t < S - 1) { const size_t q = ((size_t)((B + 1) * 2 + 0)) * 6144 + zc; pg += *(const f32x4*)(cw + 2 * 6144 + ch0) * *(const f32x4*)(zedge + q); pv += *(const f32x4*)(cw + 2 * 6144 + 3072 + ch0) * *(const f32x4*)(zedge + q + 128); }
        u32x2 ov; ov[0] = pk2(pg[0] * sigmoidf_(pg[0]) * pv[0], pg[1] * sigmoidf_(pg[1]) * pv[1]); ov[1] = pk2(pg[2] * sigmoidf_(pg[2]) * pv[2], pg[3] * sigmoidf_(pg[3]) * pv[3]);
        *(u32x2*)(act + (size_t)row * 3072 + ch0) = ov;
    }
    asm volatile("s_waitcnt vmcnt(0)" ::: "memory");
    __syncthreads();
}
struct EpiResid {
    static constexpr bool PERM = false, MERGE = false, AFTER_DRAIN = false;
    float* x; const float* modl; int gate_off; bool dry;
    DI void operator()(const AccT& acc, const Unit& u, int wr, int wc, int fr, int fq) const {
        const int row0 = u.pm * 256 + wr * 64 + fr, col0 = u.pn * 256 + wc * 32 + 4 * fq;
        const float* gp = modl + (size_t)mod_row(u.pm * 256) * 6144 + gate_off;
#pragma unroll
        for (int bj = 0; bj < 2; ++bj)
#pragma unroll
            for (int n = 0; n < 2; ++n) {
                const int col = col0 + bj * 128 + n * 16; const f32x4 gv = *(const f32x4*)(gp + col);
#pragma unroll
                for (int ai = 0; ai < 2; ++ai)
#pragma unroll
                    for (int m = 0; m < 4; ++m) { float* xp = x + (size_t)(row0 + ai * 128 + m * 16) * 1024 + col; f32x4 xv = *(const f32x4*)xp; xv += gv * acc[ai][bj][m][n]; if (!dry) *(f32x4*)xp = xv; }
            }
    }
};


#define XB_TMO      128
#define XB_XCNT(j)  (256  + 64 * (j))
#define XB_XSUB(j)  (1280 + 64 * (j))
#define XB_XGEN(j)  (2304 + 64 * (j))
#define XB_TOP      3328
#define XB_TOPGEN   3392
#define XB_SPIN_CAP (1u << 18)
DI unsigned xb_ld(unsigned* p) { return __hip_atomic_load(p, __ATOMIC_RELAXED, __HIP_MEMORY_SCOPE_AGENT); }
DI unsigned xb_add(unsigned* p, unsigned v) { return __hip_atomic_fetch_add(p, v, __ATOMIC_RELAXED, __HIP_MEMORY_SCOPE_AGENT); }
DI unsigned xb_xcc_id() { return (unsigned)__builtin_amdgcn_s_getreg((3 << 11) | 20) & 0xFu; }
#define XB_SPIN(cond, bar) do { unsigned _sp = 0; while (cond) { __builtin_amdgcn_s_sleep(1); \
    if ((++_sp & 255u) == 0u) { if (xb_ld(&(bar)[XB_TMO])) break; if (_sp > XB_SPIN_CAP) { atomicAdd(&(bar)[XB_TMO], 1u); break; } } } } while (0)
DI void xcd_barrier_complete(unsigned* bar, unsigned x, unsigned& nloc, unsigned& nx) {
    const unsigned G = gridDim.x;
    unsigned sum, cnt, mine, sp = 0u;
    for (;;) {
        sum = 0u; cnt = 0u; mine = 0u;
#pragma unroll
        for (unsigned j = 0; j < 16; ++j) { const unsigned c = xb_ld(&bar[XB_XCNT(j)]); sum += c; cnt += (c > 0u) ? 1u : 0u; mine = (j == x) ? c : mine; }
        if (sum == G) break;
        __builtin_amdgcn_s_sleep(1);
        if ((++sp & 255u) == 0u) { if (xb_ld(&bar[XB_TMO])) break; if (sp > XB_SPIN_CAP) { atomicAdd(&bar[XB_TMO], 1u); break; } }
    }
    nloc = mine > 0u ? mine : 1u; nx = cnt > 0u ? cnt : 1u;
}
DI void gbar_post(const KP p, unsigned char* shm) {
    volatile LAS unsigned* st = (volatile LAS unsigned*)(LAS unsigned char*)(shm + 131072);
    if (threadIdx.x == 0) { st[0] = 0u; st[1] = 0u; (void)xb_add(&((unsigned*)(p.ws() + OFF_BAR))[XB_XCNT(xb_xcc_id())], 1u); }
    __syncthreads();
}
DI void gbar(const KP p, unsigned char* shm) {
    asm volatile("s_waitcnt vmcnt(0)" ::: "memory");
    __syncthreads();
    if (threadIdx.x == 0) {
        unsigned* bar = (unsigned*)(p.ws() + OFF_BAR); const unsigned x = xb_xcc_id();
        volatile LAS unsigned* st = (volatile LAS unsigned*)(LAS unsigned char*)(shm + 131072);
        __builtin_amdgcn_s_waitcnt(0);
        unsigned nloc = st[0], nx = st[1];
        if (nloc == 0u) { xcd_barrier_complete(bar, x, nloc, nx); st[0] = nloc; st[1] = nx; }
        const unsigned old = xb_add(&bar[XB_XSUB(x)], 1u);
        const unsigned gen = old / nloc;
        if (old + 1u == (gen + 1u) * nloc) {
            __builtin_amdgcn_fence(__ATOMIC_RELEASE, "agent");
            asm volatile("s_waitcnt vmcnt(0)" ::: "memory");
            const unsigned og = xb_add(&bar[XB_TOP], 1u);
            const unsigned tg = og / nx;
            if (og + 1u == (tg + 1u) * nx) xb_add(&bar[XB_TOPGEN], 1u);
            else XB_SPIN(xb_ld(&bar[XB_TOPGEN]) == tg, bar);
            __builtin_amdgcn_fence(__ATOMIC_ACQUIRE, "agent");
            xb_add(&bar[XB_XGEN(x)], 1u);
            asm volatile("s_waitcnt vmcnt(0)" ::: "memory");
        } else {
            XB_SPIN(xb_ld(&bar[XB_XGEN(x)]) == gen, bar);
            __builtin_amdgcn_fence(__ATOMIC_ACQUIRE, "agent");
            asm volatile("s_waitcnt vmcnt(0)" ::: "memory");
        }
    }
    __syncthreads();
}

struct EpiResidNorm {
    static constexpr bool PERM = false, MERGE = false, AFTER_DRAIN = true;
    float* x; const float* modl; int gate_off; int mode; const float* gam; const float* modn; int sh_off, sc_off; bf16_t* dst; float* rss; unsigned* cnt; unsigned* bar; float* rsl;
    DI void fused(AccT& acc, const Unit& u, int wr, int wc, int fr, int fq) const {
        const int row0 = u.pm * 256 + wr * 64 + fr, col0 = u.pn * 256 + wc * 32 + 4 * fq;
        const int mrow = mod_row(u.pm * 256);
        const float* gp = modl + (size_t)mrow * 6144 + gate_off + col0;
        { f32x4 gv[2][2];
#pragma unroll
          for (int bj = 0; bj < 2; ++bj)
#pragma unroll
              for (int n = 0; n < 2; ++n) gv[bj][n] = *(const f32x4*)(gp + bj * 128 + n * 16);
          const float* xp = x + (size_t)row0 * 1024 + col0;
#pragma unroll
          for (int ai = 0; ai < 2; ++ai)
#pragma unroll
              for (int m = 0; m < 4; ++m) {
                  asm volatile("" : "+v"(xp));
                  float sq = 0.f;
#pragma unroll
                  for (int bj = 0; bj < 2; ++bj)
#pragma unroll
                      for (int n = 0; n < 2; ++n) { f32x4 xv = *(const f32x4*)(xp + bj * 128 + n * 16); xv += gv[bj][n] * acc[ai][bj][m][n]; acc[ai][bj][m][n] = xv; sq += xv[0] * xv[0] + xv[1] * xv[1] + xv[2] * xv[2] + xv[3] * xv[3]; }
                  sq += __shfl_xor(sq, 16); sq += __shfl_xor(sq, 32);
                  if (fq == 0) __hip_atomic_store(&rss[(size_t)(row0 + ai * 128 + m * 16) * 16 + u.pn * 4 + wc], sq, __ATOMIC_RELAXED, __HIP_MEMORY_SCOPE_AGENT);
                  xp += (m == 3 ? (128 - 48) : 16) * 1024;
              } }
        asm volatile("s_waitcnt vmcnt(0)" ::: "memory");
        __syncthreads();
        if (threadIdx.x == 0) { (void)xb_add(&cnt[u.pm], 1u); XB_SPIN(xb_ld(&cnt[u.pm]) < 4u, bar); }
        __syncthreads();
        float rs[2][4];
        { const int L = fq * 16 + fr; float* rw = rsl + (wr * 4 + wc) * 128;
#pragma unroll
          for (int ai = 0; ai < 2; ++ai) { const float* rp = rss + (size_t)(u.pm * 256 + ai * 128 + wr * 64 + L) * 16;
              float t = 0.f;
#pragma unroll
              for (int q = 0; q < 8; ++q) { const unsigned long long w = __hip_atomic_load((const unsigned long long*)rp + q, __ATOMIC_RELAXED, __HIP_MEMORY_SCOPE_AGENT); t += __uint_as_float((unsigned)w) + __uint_as_float((unsigned)(w >> 32)); }
              rw[ai * 64 + L] = rsqrtf(t * (1.0f / 1024.0f) + 1e-6f); }
#pragma unroll
          for (int ai = 0; ai < 2; ++ai)
#pragma unroll
              for (int m = 0; m < 4; ++m) rs[ai][m] = rw[ai * 64 + 16 * m + fr]; }
        { const float* mn = modn + (size_t)mrow * 6144 + col0;
          f32x4 ms[2][2], sh[2][2];
#pragma unroll
          for (int bj = 0; bj < 2; ++bj)
#pragma unroll
              for (int n = 0; n < 2; ++n) { const int cc = bj * 128 + n * 16; ms[bj][n] = *(const f32x4*)(gam + col0 + cc); sh[bj][n] = (f32x4){0.f, 0.f, 0.f, 0.f};
                  if (mode == 0) { ms[bj][n] = ms[bj][n] * (*(const f32x4*)(mn + sc_off + cc) + 1.0f); sh[bj][n] = *(const f32x4*)(mn + sh_off + cc); } }
          float* xq = x + (size_t)row0 * 1024 + col0; bf16_t* dq = dst + (size_t)row0 * 1024 + col0;
#pragma unroll
          for (int ai = 0; ai < 2; ++ai)
#pragma unroll
              for (int m = 0; m < 4; ++m) {
                  asm volatile("" : "+v"(xq), "+v"(dq));
#pragma unroll
                  for (int bj = 0; bj < 2; ++bj)
#pragma unroll
                      for (int n = 0; n < 2; ++n) { const int cc = bj * 128 + n * 16; const f32x4 y = acc[ai][bj][m][n] * rs[ai][m] * ms[bj][n] + sh[bj][n];
                          if (mode == 0) { *(f32x4*)(xq + cc) = acc[ai][bj][m][n]; u32x2 ob; ob[0] = pk2(y[0], y[1]); ob[1] = pk2(y[2], y[3]); *(u32x2*)(dq + cc) = ob; } else *(f32x4*)(xq + cc) = y; }
                  xq += (m == 3 ? (128 - 48) : 16) * 1024; dq += (m == 3 ? (128 - 48) : 16) * 1024;
              } }
    }
};

DI float wave_sum(float v) {
#pragma unroll
    for (int o = 32; o > 0; o >>= 1) v += __shfl_xor(v, o);
    return v;
}

DI void phase_mod(const KP p, unsigned char* shm) {
    float* sc = (float*)shm; float* red = sc + 9 * 1024;
    const int tid = ltid(); bool inited = false;
    const float* cond = p.in(5); const float* cctx = p.in(6);
    for (int it = lbid(); it < 192; it += lgdim()) {
        if (!inited) { for (int e = tid; e < 9 * 1024; e += 512) { const int r = e >> 10, k = e & 1023; const float v = r == 0 ? cctx[k] : cond[(r - 1) * 1024 + k]; sc[e] = v / (1.0f + expf(-v)); } __syncthreads(); inited = true; }
        const int l = it / 96, j0 = (it % 96) * 64, j = tid & 63, kq = tid >> 6;
        const float* w = p.in(9) + (size_t)l * 1024 * 6144 + j0 + j;
        float a0 = 0, a1 = 0, a2 = 0, a3 = 0, a4 = 0, a5 = 0, a6 = 0, a7 = 0, a8 = 0;
        for (int k = kq * 128; k < kq * 128 + 128; ++k) { const float wv = w[(size_t)k * 6144];
            a0 += sc[k] * wv; a1 += sc[1024 + k] * wv; a2 += sc[2048 + k] * wv; a3 += sc[3072 + k] * wv; a4 += sc[4096 + k] * wv; a5 += sc[5120 + k] * wv; a6 += sc[6144 + k] * wv; a7 += sc[7168 + k] * wv; a8 += sc[8192 + k] * wv; }
        float* rp = red + (kq * 9) * 64 + j;
        rp[0] = a0; rp[64] = a1; rp[128] = a2; rp[192] = a3; rp[256] = a4; rp[320] = a5; rp[384] = a6; rp[448] = a7; rp[512] = a8;
        __syncthreads();
        for (int e = tid; e < 576; e += 512) { const int r = e >> 6, jj = e & 63; float s = p.in(10)[(size_t)l * 6144 + j0 + jj];
            for (int q = 0; q < 8; ++q) s += red[(q * 9 + r) * 64 + jj];
            ((float*)(p.ws() + OFF_MOD))[((size_t)l * 9 + r) * 6144 + j0 + jj] = s; }
        __syncthreads();
    }
    __syncthreads();
}

DI void phase_kbound(const KP p, unsigned char* shm) {
    const int tid = ltid(), lane = tid & 63, wid = tid >> 6; float* red = (float*)shm; float* out = (float*)(p.ws() + OFF_KMAX);
    for (int it = lbid(); it < 64; it += lgdim()) {
        const int l = it >> 5, b = (it >> 2) & 7, hk = it & 3; const int key = tid >> 1, half = tid & 1;
        const float* src = p.in(2) + ((((size_t)b * 2 + l) * 256 + key) * 256) + hk * 64 + half * 32;
        float ss = 0.f;
#pragma unroll
        for (int i = 0; i < 8; ++i) { const f32x4 v = *(const f32x4*)(src + i * 4); ss += v[0] * v[0] + v[1] * v[1] + v[2] * v[2] + v[3] * v[3]; }
        ss += __shfl_xor(ss, 1);
#pragma unroll
        for (int o = 2; o < 64; o <<= 1) ss = fmaxf(ss, __shfl_xor(ss, o));
        if (lane == 0) red[wid] = ss;
        __syncthreads();
        if (tid == 0) { float m = red[0]; for (int w = 1; w < 8; ++w) m = fmaxf(m, red[w]); out[it] = m; }
        __syncthreads();
    }
    if (lbid() == lgdim() - 1 && tid < 2) { float g2 = 0.f; for (int d = 0; d < 64; ++d) { const float g = p.in(21)[tid * 64 + d]; g2 = fmaxf(g2, g * g); } out[64 + tid] = 64.0f * g2; }
}

DI void transpose_tile(const float* src, int N, int k0, int scol0, bf16_t* dst, int ldd, int drow0, float* tile) {
    const int tid = ltid();
#pragma unroll
    for (int i = 0; i < 2; ++i) { const int idx = tid + i * 512, k = idx >> 4, n4 = idx & 15; const f32x4 v = *(const f32x4*)(src + (size_t)(k0 + k) * N + scol0 + n4 * 4);
        float* t = tile + k * 65 + n4 * 4; t[0] = v[0]; t[1] = v[1]; t[2] = v[2]; t[3] = v[3]; }
    __syncthreads();
    { const int n = tid >> 3, kg = tid & 7; float f[8];
#pragma unroll
      for (int j = 0; j < 8; ++j) f[j] = tile[(kg * 8 + j) * 65 + n];
      *(u32x4*)(dst + (size_t)(drow0 + n) * ldd + k0 + kg * 8) = pack8(f); }
    __syncthreads();
}
DI void phase_weights(const KP p, int l, unsigned char* shm, int mask = 31, int Gw = 0, int cw = 0) {
    float* tile = (float*)shm; unsigned char* W = p.ws() + OFF_W;
    const int G = Gw > 0 ? Gw : lgdim(), c = Gw > 0 ? cw : lbid(); int base = 0;
    auto run = [&](const float* src, int K, int N, bf16_t* dst, int ldd, int mode) {
        const int ntn = N / 64, ntk = K / 64, nt = ntn * ntk;
        int first = (c - base) % G; if (first < 0) first += G;
        for (int ti = first; ti < nt; ti += G) { const int kt = ti / ntn, nn = ti - kt * ntn; const int drow0 = nn * 64; int scol0 = drow0;
            if (mode == 1) { const int j = drow0 >> 8, w = drow0 & 255; scol0 = w < 128 ? 128 * j + w : 3072 + 128 * j + (w - 128); }
            transpose_tile(src, N, kt * 64, scol0, dst, ldd, drow0, tile); }
        base += nt;
    };
    if (mask & 1) run(p.in(11) + (size_t)l * 1024 * 7680, 1024, 7680, (bf16_t*)(W + W_IN), 1024, 0);
    if (mask & 2) run(p.in(28) + (size_t)l * 1024 * 6144, 1024, 6144, (bf16_t*)(W + W_UP), 1024, 1);
    if (mask & 4) run(p.in(31) + (size_t)l * 3072 * 1024, 3072, 1024, (bf16_t*)(W + W_DOWN), 3072, 0);
    if (mask & 8) {
    run(p.in(24) + (size_t)l * 1024 * 1024, 1024, 1024, (bf16_t*)(W + W_BR), 1024, 0);
    run(p.in(25) + (size_t)l * 1024 * 1024, 1024, 1024, (bf16_t*)(W + W_BR) + (size_t)1024 * 1024, 1024, 0);
    run(p.in(26) + (size_t)l * 1024 * 1024, 1024, 1024, (bf16_t*)(W + W_BR) + (size_t)2 * 1024 * 1024, 1024, 0);
    run(p.in(27) + (size_t)l * 1024 * 1024, 1024, 1024, (bf16_t*)(W + W_O), 1024, 0); }
    if (mask & 16) {
    for (int g = 0; g < 4; ++g) run(p.in(22) + ((size_t)l * 4 + g) * 256 * 256, 256, 256, (bf16_t*)(W + W_POOL) + (size_t)g * 256 * 256, 256, 0);
    bf16_t* wg = (bf16_t*)(W + W_GATE);
    for (int e = c * 512 + ltid(); e < 16 * 2 * 128 * 64; e += G * 512) {
        const int k = e & 63, col = (e >> 6) & 127, dir = (e >> 13) & 1, n = e >> 14;
        const float* src = (col < 64 ? p.in(15) : p.in(17)) + ((((size_t)l * 2 + dir) * 16 + n) * 64 + k) * 64 + (col & 63);
        wg[e] = (bf16_t)(pk2(*src, 0.f) & 0xffffu);
    } }
}

DI void phase_norm(const KP p, int l, bool from_input, const float* gam, int sh_off, int sc_off, bf16_t* dst, bool final_) {
    const int tid_ = ltid(); const int lane = tid_ & 63, wid = tid_ >> 6;
    const float* modl = (const float*)(p.ws() + OFF_MOD) + (size_t)l * 9 * 6144;
    const int stride = lgdim() * 8;
    f32x4 gv[4];
#pragma unroll
    for (int i = 0; i < 4; ++i) gv[i] = *(const f32x4*)(gam + i * 256 + lane * 4);
    for (int mb = lbid() * 8 + wid; mb < MT; mb += 3 * stride) {
        f32x4 xv[3][4]; float ss[3];
#pragma unroll
        for (int r = 0; r < 3; ++r) { const int m = mb + r * stride; ss[r] = 0.f;
            if (m < MT) { const float* xr = from_input ? (m < MCTX ? p.in(0) + (size_t)m * 1024 : p.in(1) + (size_t)(m - MCTX) * 1024) : p.out() + (size_t)m * 1024;
#pragma unroll
                for (int i = 0; i < 4; ++i) xv[r][i] = *(const f32x4*)(xr + i * 256 + lane * 4); }
            else {
#pragma unroll
                for (int i = 0; i < 4; ++i) xv[r][i] = (f32x4){0.f, 0.f, 0.f, 0.f}; } }
#pragma unroll
        for (int r = 0; r < 3; ++r) {
#pragma unroll
            for (int i = 0; i < 4; ++i) ss[r] += xv[r][i][0] * xv[r][i][0] + xv[r][i][1] * xv[r][i][1] + xv[r][i][2] * xv[r][i][2] + xv[r][i][3] * xv[r][i][3];
            ss[r] = wave_sum(ss[r]); }
#pragma unroll
        for (int r = 0; r < 3; ++r) { const int m = mb + r * stride; if (m >= MT) continue;
            const float rs = rsqrtf(ss[r] * (1.0f / 1024.0f) + 1e-6f);
            const float* mr = modl + (size_t)mod_row(m) * 6144;
#pragma unroll
            for (int i = 0; i < 4; ++i) { const int cc = i * 256 + lane * 4;
                if (final_) { f32x4 y = xv[r][i] * rs * gv[i]; *(f32x4*)(p.out() + (size_t)m * 1024 + cc) = y; }
                else { const f32x4 scv = *(const f32x4*)(mr + sc_off + cc), shv = *(const f32x4*)(mr + sh_off + cc);
                    f32x4 y = xv[r][i] * rs * gv[i] * (scv + 1.0f) + shv; u32x2 o; o[0] = pk2(y[0], y[1]); o[1] = pk2(y[2], y[3]);
                    *(u32x2*)(dst + (size_t)m * 1024 + cc) = o;
                    if (from_input) *(f32x4*)(p.out() + (size_t)m * 1024 + cc) = xv[r][i]; }
            }
        }
    }
}

DI void phase_e1_elem(const KP p, int l, unsigned char* shm, int parts = 15) {
    float* tab = (float*)shm;
    const int tid = ltid();
    for (int e = tid; e < 1024; e += 512) { const int pos = e >> 4, j = e & 15; const float inv = exp2f(-(float)j * (13.287712379549449f / 16.0f)); const float ang = (float)pos * inv; tab[2 * e] = __cosf(ang); tab[2 * e + 1] = __sinf(ang); }
    __syncthreads();
    bf16_t* slots = (bf16_t*)(p.ws() + OFF_SLOTS);
    bf16_t* qb = slots + 3 * SLOT_E; bf16_t* kraw = (bf16_t*)(p.ws() + OFF_KRAW); bf16_t* vraw = (bf16_t*)(p.ws() + OFF_VRAW);
    const size_t gtid = (size_t)lbid() * 512 + tid, gsz = (size_t)lgdim() * 512;
    if (parts & 1) {
        auto qk_ptr = [&](size_t e) -> bf16_t* { const int i = (int)(e & 7); const int hh = 16 + (int)((e >> 3) & 3); const int m = (int)(e >> 5);
            return kraw + (size_t)m * 256 + (hh - 16) * 64 + i * 8; };
        auto qk_proc = [&](size_t e, u32x4 rawv, bf16_t* ptr) {
            const int i = (int)(e & 7); const int hh = 16 + (int)((e >> 3) & 3); const int m = (int)(e >> 5); const bool isq = false;
            float x[8]; unpack8(rawv, x);
            float ss = 0.f;
#pragma unroll
            for (int j = 0; j < 8; ++j) ss += x[j] * x[j];
            ss += __shfl_xor(ss, 1); ss += __shfl_xor(ss, 2); ss += __shfl_xor(ss, 4);
            const float rs = rsqrtf(ss * (1.0f / 64.0f) + 1e-6f);
            const float* g = (isq ? p.in(20) : p.in(21)) + l * 64 + i * 8; const f32x4 g0 = *(const f32x4*)g, g1 = *(const f32x4*)(g + 4);
#pragma unroll
            for (int j = 0; j < 4; ++j) { x[j] = x[j] * rs * g0[j]; x[4 + j] = x[4 + j] * rs * g1[j]; }
            const bool lat = m >= MCTX;
            float part[8];
#pragma unroll
            for (int j = 0; j < 8; ++j) part[j] = __shfl_xor(x[j], 2);
            if (lat) { const int t = (m - MCTX) & 1023; const int pos = (i < 4) ? (t >> 6) : (t & 63);
#pragma unroll
                for (int j = 0; j < 8; ++j) { const int jj = (i & 1) * 8 + j; const float cs = tab[2 * (pos * 16 + jj)], sn = tab[2 * (pos * 16 + jj) + 1];
                    x[j] = (i & 2) ? (part[j] * sn + x[j] * cs) : (x[j] * cs - part[j] * sn); }
            } else if (!isq) { float* o = p.out() + OUT_CK + ((((size_t)(m >> 8) * 2 + l) * 256 + (m & 255)) * 256) + (hh - 16) * 64 + i * 8;
                *(f32x4*)o = (f32x4){x[0], x[1], x[2], x[3]}; *(f32x4*)(o + 4) = (f32x4){x[4], x[5], x[6], x[7]}; }
            *(u32x4*)ptr = pack8(x); };
        const size_t N = (size_t)MT * 4 * 8;
        for (size_t e = gtid; e < N; e += 2 * gsz) { const size_t e1 = e + gsz; const bool has1 = e1 < N;
            bf16_t* p0 = qk_ptr(e); bf16_t* p1 = qk_ptr(has1 ? e1 : e);
            const u32x4 r0 = *(const u32x4*)p0, r1 = *(const u32x4*)p1;
            qk_proc(e, r0, p0); if (has1) qk_proc(e1, r1, p1); }
    }
    bf16_t* vT = (bf16_t*)(p.ws() + OFF_VT);
    if (parts & 2)
    for (size_t e = gtid; e < (size_t)MT * 32; e += gsz) {
        int seq, t, grp;
        if (e < (size_t)MCTX * 32) { t = (int)(e & 255); grp = (int)((e >> 8) & 31); seq = (int)(e >> 13); }
        else { const size_t e2 = e - (size_t)MCTX * 32; t = (int)(e2 & 1023); grp = (int)((e2 >> 10) & 31); seq = 16 + (int)(e2 >> 15); }
        const int hk = grp >> 3, dg = grp & 7; const int m = seq < 16 ? seq * 256 + t : MCTX + (seq - 16) * 1024 + t;
        const u32x4 raw = *(const u32x4*)(vraw + (size_t)m * 256 + hk * 64 + dg * 8);
        bf16_t* dstp; int Sk;
        if (seq < 16) { Sk = 256; dstp = vT + ((size_t)(seq * 4 + hk) * 64 + dg * 8) * 256 + t; }
        else { Sk = 1280; dstp = vT + VT_LAT_E + ((size_t)((seq - 16) * 4 + hk) * 64 + dg * 8) * 1280 + 256 + t; }
#pragma unroll
        for (int j = 0; j < 8; ++j) dstp[(size_t)j * Sk] = (bf16_t)((j & 1) ? (raw[j >> 1] >> 16) : (raw[j >> 1] & 0xffffu));
        if (seq < 16) { float f[8]; unpack8(raw, f); float* o = p.out() + OUT_CV + ((((size_t)seq * 2 + l) * 256 + t) * 256) + hk * 64 + dg * 8;
            *(f32x4*)o = (f32x4){f[0], f[1], f[2], f[3]}; *(f32x4*)(o + 4) = (f32x4){f[4], f[5], f[6], f[7]}; }
    }
    bf16_t* ck = (bf16_t*)(p.ws() + OFF_CK);
    if (parts & 4)
    for (size_t e = gtid; e < (size_t)8 * 256 * 32; e += gsz) {
        const int c8 = (int)(e & 31), t = (int)((e >> 5) & 255), b = (int)(e >> 13);
        const float* src = p.in(2) + ((((size_t)b * 2 + l) * 256 + t) * 256) + c8 * 8;
        float f[8]; const f32x4 a = *(const f32x4*)src, bb = *(const f32x4*)(src + 4); f[0] = a[0]; f[1] = a[1]; f[2] = a[2]; f[3] = a[3]; f[4] = bb[0]; f[5] = bb[1]; f[6] = bb[2]; f[7] = bb[3];
        *(u32x4*)(ck + ((size_t)b * 256 + t) * 256 + c8 * 8) = pack8(f);
    }
    if (parts & 4)
    for (size_t e = gtid; e < (size_t)8 * 32 * 256; e += gsz) {
        const int t = (int)(e & 255), grp = (int)((e >> 8) & 31), b = (int)(e >> 13); const int hk = grp >> 3, dg = grp & 7;
        const float* src = p.in(3) + ((((size_t)b * 2 + l) * 256 + t) * 256) + hk * 64 + dg * 8;
        bf16_t* dstp = vT + VT_LAT_E + ((size_t)(b * 4 + hk) * 64 + dg * 8) * 1280 + t;
#pragma unroll
        for (int j = 0; j < 8; ++j) dstp[(size_t)j * 1280] = (bf16_t)(pk2(src[j], 0.f) & 0xffffu);
    }
    const bf16_t* up = slots + 4 * SLOT_E; bf16_t* dd = slots;
    if (parts & 8) {
#define POOL_GROUP(GI, WW) \
        for (size_t e = gtid; e < (size_t)MT * 32; e += gsz) { \
            const int c8 = (GI) * 32 + (int)(e & 31), m = (int)(e >> 5); const int s0 = seq_start(m), S = seq_len(m), t = m - s0; \
            u32x4 rv[WW]; \
            _Pragma("unroll") for (int k = 0; k < (WW); ++k) { int tt = t - (WW) / 2 + k; tt = tt < 0 ? 0 : (tt >= S ? S - 1 : tt); rv[k] = *(const u32x4*)(up + (size_t)(s0 + tt) * 1024 + c8 * 8); } \
            float sum[8] = {0, 0, 0, 0, 0, 0, 0, 0}, self[8]; int cnt = 0; \
            _Pragma("unroll") for (int k = 0; k < (WW); ++k) { const int tt = t - (WW) / 2 + k; const bool ok = tt >= 0 && tt < S; cnt += ok ? 1 : 0; float f[8]; unpack8(rv[k], f); \
                _Pragma("unroll") for (int j = 0; j < 8; ++j) sum[j] += ok ? f[j] : 0.f; } \
            unpack8(rv[(WW) / 2], self); \
            const float inv = 1.0f / (float)cnt; \
            _Pragma("unroll") for (int j = 0; j < 8; ++j) sum[j] = sum[j] * inv - self[j]; \
            *(u32x4*)(dd + (size_t)m * 1024 + c8 * 8) = pack8(sum); }
        POOL_GROUP(0, 2) POOL_GROUP(1, 4) POOL_GROUP(2, 8) POOL_GROUP(3, 16)
#undef POOL_GROUP
    }
}

DI void phase_e2(const KP p, int l, const bf16_t* z, int ntl, int j0, bf16_t* act) {
    const float* cw = p.in(29) + (size_t)l * 3 * 6144; const float* cb = p.in(30) + (size_t)l * 6144;
    const int ldz = ntl * 256;
    const int gtid = lbid() * 512 + ltid(), gsz = lgdim() * 512;
    const int per_m = ntl * 16, rpt = gsz / per_m;
    const int r = gtid % per_m, mrow0 = gtid / per_m; const int jl = r >> 4, cg8 = r & 15;
    if (mrow0 >= rpt) return;
    f32x4 wv[2][4][2];
#pragma unroll
    for (int h = 0; h < 2; ++h) { const int wcol = h * 3072 + (j0 + jl) * 128 + cg8 * 8;
#pragma unroll
        for (int q = 0; q < 2; ++q) { wv[h][0][q] = *(const f32x4*)(cb + wcol + q * 4); wv[h][1][q] = *(const f32x4*)(cw + wcol + q * 4); wv[h][2][q] = *(const f32x4*)(cw + 6144 + wcol + q * 4); wv[h][3][q] = *(const f32x4*)(cw + 2 * 6144 + wcol + q * 4); } }
    const u32x4 zero = (u32x4){0, 0, 0, 0};
    for (int mb = mrow0; mb < MT; mb += 2 * rpt) {
        u32x4 zr[2][2][3];
#pragma unroll
        for (int u = 0; u < 2; ++u) { const int m = mb + u * rpt; const bool ok = m < MT; const int mm = ok ? m : mb;
            const int s0 = seq_start(mm), S = seq_len(mm), t = mm - s0; const bool hp = t > 0, hn = t < S - 1;
#pragma unroll
            for (int h = 0; h < 2; ++h) { const bf16_t* zp = z + (size_t)mm * ldz + jl * 256 + h * 128 + cg8 * 8;
                zr[u][h][0] = hp ? *(const u32x4*)(zp - ldz) : zero; zr[u][h][1] = *(const u32x4*)zp; zr[u][h][2] = hn ? *(const u32x4*)(zp + ldz) : zero; } }
#pragma unroll
        for (int u = 0; u < 2; ++u) { const int m = mb + u * rpt; if (m >= MT) continue;
            float res[2][8];
#pragma unroll
            for (int h = 0; h < 2; ++h) { float z0[8], z1[8], z2[8]; unpack8(zr[u][h][0], z0); unpack8(zr[u][h][1], z1); unpack8(zr[u][h][2], z2);
#pragma unroll
                for (int j = 0; j < 8; ++j) res[h][j] = wv[h][0][j >> 2][j & 3] + wv[h][1][j >> 2][j & 3] * z0[j] + wv[h][2][j >> 2][j & 3] * z1[j] + wv[h][3][j >> 2][j & 3] * z2[j]; }
            float o[8];
#pragma unroll
            for (int j = 0; j < 8; ++j) o[j] = res[0][j] * sigmoidf_(res[0][j]) * res[1][j];
            *(u32x4*)(act + (size_t)m * 3072 + (j0 + jl) * 128 + cg8 * 8) = pack8(o); }
    }
}

DI int crow(int reg, int h) { return (reg & 3) + 8 * (reg >> 2) + 4 * h; }
DI float fsig(float x) { return __builtin_amdgcn_rcpf(1.0f + __builtin_amdgcn_exp2f(-1.4426950408889634f * x)); }
constexpr int L2_XW = 0, L2_SEG = 8 * 16 * 68 * 4, L2_CST = L2_SEG + 8192, L2_CW = L2_CST + 512, L2_WG = L2_CW + 1280, L2_RAW = L2_WG + 128 * 144, L2_END = L2_RAW + 8 * 19 * 64 * 2;
static_assert(L2_END <= 131072, "lds");
template <int DIR>
DI void lru_sweep(const KP p, int l, int seq, int n, unsigned char* shm, bool wet) {
    const int tid = ltid(), lane = tid & 63, wid = tid >> 6, l16 = lane & 15, kg = lane >> 4;
    const int S = seq < 16 ? 256 : 1024, m0 = seq < 16 ? seq * 256 : MCTX + (seq - 16) * 1024, nst = S >> 7;
    bf16_t* slots = (bf16_t*)(p.ws() + OFF_SLOTS);
    const bf16_t* xr = slots + 1 * SLOT_E + n * 64; const bf16_t* yv = slots + 2 * SLOT_E + n * 64; bf16_t* yo = slots + 4 * SLOT_E + n * 64;
    float* xw = (float*)(shm + L2_XW) + wid * 16 * 68; float* segs = (float*)(shm + L2_SEG); float* cst = (float*)(shm + L2_CST);
    bf16_t* wgl = (bf16_t*)(shm + L2_WG);
    { const bf16_t* wg = (const bf16_t*)(p.ws() + OFF_W + W_GATE) + ((size_t)n * 2 + DIR) * 128 * 64;
#pragma unroll
      for (int i = 0; i < 2; ++i) { const int pc = tid + i * 512, col = pc >> 3, part = pc & 7; *(u32x4*)(wgl + col * 72 + part * 8) = *(const u32x4*)(wg + col * 64 + part * 8); } }
    float br[4], bi[4], ls8[4];
#pragma unroll
    for (int cq = 0; cq < 4; ++cq) { const size_t o = ((size_t)l * 2 + DIR) * 1024 + n * 64 + cq * 16 + l16; br[cq] = p.in(16)[o]; bi[cq] = p.in(18)[o];
        ls8[cq] = -8.0f * 1.4426950408889634f * log1pf(expf(-p.in(19)[o])); }
    const float w0 = p.in(13)[((size_t)l * 4 + 0) * 1024 + n * 64 + lane], w1 = p.in(13)[((size_t)l * 4 + 1) * 1024 + n * 64 + lane], w2 = p.in(13)[((size_t)l * 4 + 2) * 1024 + n * 64 + lane],
                w3 = p.in(13)[((size_t)l * 4 + 3) * 1024 + n * 64 + lane], wb = p.in(14)[(size_t)l * 1024 + n * 64 + lane];
    if (tid < 64) cst[tid] = seq < 16 ? 0.f : p.in(4)[(((size_t)(seq - 16) * 2 + l) * 2 + DIR) * 1024 + n * 64 + tid];
    __syncthreads();
    bf16_t* rawt = (bf16_t*)(shm + L2_RAW) + wid * 19 * 64;
    u32x4 rr[3];
    auto load_raw = [&](int base) {
#pragma unroll
        for (int i = 0; i < 3; ++i) { const int pc = lane + i * 64, r = pc >> 3, part = pc & 7; const int tt = base + wid * 16 - 1 + r; rr[i] = (u32x4){0, 0, 0, 0};
            if (pc < 152 && tt >= 0 && tt < S) rr[i] = *(const u32x4*)(xr + (size_t)(m0 + tt) * 1024 + part * 8); } };
    load_raw(DIR == 0 ? 0 : (nst - 1) * 128);
#pragma unroll 1
    for (int s = 0; s < nst; ++s) {
        const int base = (DIR == 0 ? s : nst - 1 - s) * 128; const int par = s & 1;
        u32x4 yv4[2], tv4[2];
#pragma unroll
        for (int i = 0; i < 2; ++i) { const int pc = lane + i * 64; const size_t o = (size_t)(m0 + base + wid * 16 + (pc >> 3)) * 1024 + (pc & 7) * 8;
            yv4[i] = *(const u32x4*)(yv + o); tv4[i] = DIR == 1 ? *(const u32x4*)(yo + o) : (u32x4){0, 0, 0, 0}; }
#pragma unroll
        for (int i = 0; i < 3; ++i) { const int pc = lane + i * 64; if (pc < 152) *(u32x4*)(rawt + pc * 8) = rr[i]; }
        { float xf[19];
#pragma unroll
          for (int r = 0; r < 19; ++r) xf[r] = bflo((unsigned)rawt[r * 64 + lane]);
#pragma unroll
          for (int tk = 0; tk < 16; ++tk) xw[tk * 68 + lane] = wb + w0 * xf[tk] + w1 * xf[tk + 1] + w2 * xf[tk + 2] + w3 * xf[tk + 3]; }
        if (s + 1 < nst) load_raw((DIR == 0 ? s + 1 : nst - 2 - s) * 128);
        bf16x8 Af[2];
#pragma unroll
        for (int ks = 0; ks < 2; ++ks) { const f32x4 a0 = *(const f32x4*)(xw + l16 * 68 + ks * 32 + kg * 8), a1 = *(const f32x4*)(xw + l16 * 68 + ks * 32 + kg * 8 + 4);
            u32x4 pk; pk[0] = pk2(a0[0], a0[1]); pk[1] = pk2(a0[2], a0[3]); pk[2] = pk2(a1[0], a1[1]); pk[3] = pk2(a1[2], a1[3]); Af[ks] = __builtin_bit_cast(bf16x8, pk); }
        float hh[4][4], pp[4][4], Pl[4], Hl[4];
#pragma unroll
        for (int cq = 0; cq < 4; ++cq) { f32x4 ar = (f32x4){0.f, 0.f, 0.f, 0.f}, ai = (f32x4){0.f, 0.f, 0.f, 0.f};
#pragma unroll
            for (int ks = 0; ks < 2; ++ks) { const bf16x8 Br = *(const bf16x8*)(wgl + (cq * 16 + l16) * 72 + ks * 32 + kg * 8), Bi = *(const bf16x8*)(wgl + ((4 + cq) * 16 + l16) * 72 + ks * 32 + kg * 8);
                ar = __builtin_amdgcn_mfma_f32_16x16x32_bf16(Af[ks], Br, ar, 0, 0, 0); ai = __builtin_amdgcn_mfma_f32_16x16x32_bf16(Af[ks], Bi, ai, 0, 0, 0); }
            float H = 0.f, P = 1.f;
#pragma unroll
            for (int jj = 0; jj < 4; ++jj) { const int i = DIR == 0 ? jj : 3 - jj;
                const float r = fsig(ar[i] + br[cq]), ig = fsig(ai[i] + bi[cq]), x = xw[(kg * 4 + i) * 68 + cq * 16 + l16];
                const float a = __builtin_amdgcn_exp2f(r * ls8[cq]); const float u = __builtin_amdgcn_sqrtf(fmaf(-a, a, 1.0f)) * ig * x; H = fmaf(a, H, u); P *= a; hh[cq][i] = H; pp[cq][i] = P; }
            Pl[cq] = P; Hl[cq] = H; }
        float Pe[4], He[4];
#pragma unroll
        for (int cq = 0; cq < 4; ++cq) {
#pragma unroll
            for (int d = 1; d <= 2; d <<= 1) { const int src = (DIR == 0 ? lane - 16 * d : lane + 16 * d) & 63; const bool ok = DIR == 0 ? kg >= d : kg <= 3 - d;
                const float Pp = __shfl(Pl[cq], src), Hp = __shfl(Hl[cq], src);
                if (ok) { Hl[cq] = fmaf(Pl[cq], Hp, Hl[cq]); Pl[cq] *= Pp; } }
            const int src = (DIR == 0 ? lane - 16 : lane + 16) & 63; const bool ok = DIR == 0 ? kg >= 1 : kg <= 2;
            const float Pp = __shfl(Pl[cq], src), Hp = __shfl(Hl[cq], src); Pe[cq] = ok ? Pp : 1.0f; He[cq] = ok ? Hp : 0.0f; }
        if (kg == (DIR == 0 ? 3 : 0)) {
#pragma unroll
            for (int cq = 0; cq < 4; ++cq) { float* sp = segs + ((par * 8 + wid) * 64 + cq * 16 + l16) * 2; sp[0] = Pl[cq]; sp[1] = Hl[cq]; } }
        __syncthreads();
        float cwl = cst[par * 64 + lane];
        { float sP[8], sH[8];
#pragma unroll
          for (int w2 = 0; w2 < 8; ++w2) { const f32x2_t v = *(const f32x2_t*)(segs + ((par * 8 + w2) * 64 + lane) * 2); sP[w2] = v[0]; sH[w2] = v[1]; }
#pragma unroll
          for (int jj = 0; jj < 8; ++jj) { const int w2 = DIR == 0 ? jj : 7 - jj; const bool before = DIR == 0 ? w2 < wid : w2 > wid; if (before) cwl = fmaf(sP[w2], cwl, sH[w2]); } }
#pragma unroll
        for (int cq = 0; cq < 4; ++cq) { const int c = cq * 16 + l16; const float cwv = __shfl(cwl, c);
            const float cl = fmaf(Pe[cq], cwv, He[cq]);
#pragma unroll
            for (int i = 0; i < 4; ++i) hh[cq][i] = fmaf(pp[cq][i], cl, hh[cq][i]);
            if (wid == (DIR == 0 ? 7 : 0) && kg == (DIR == 0 ? 3 : 0)) cst[(par ^ 1) * 64 + c] = hh[cq][DIR == 0 ? 3 : 0];
#pragma unroll
            for (int i = 0; i < 4; ++i) xw[(kg * 4 + i) * 68 + c] = hh[cq][i];
        }
#pragma unroll
        for (int i = 0; i < 2; ++i) { const int pc = lane + i * 64, tk = pc >> 3, part = pc & 7; const f32x4 h0 = *(const f32x4*)(xw + tk * 68 + part * 8), h1 = *(const f32x4*)(xw + tk * 68 + part * 8 + 4);
            float y[8], t[8], o[8]; unpack8(yv4[i], y); unpack8(tv4[i], t);
#pragma unroll
            for (int e = 0; e < 4; ++e) { o[e] = fmaf(h0[e], y[e], t[e]); o[4 + e] = fmaf(h1[e], y[4 + e], t[4 + e]); }
            if (wet) *(u32x4*)(yo + (size_t)(m0 + base + wid * 16 + tk) * 1024 + part * 8) = pack8(o); }
    }
    __syncthreads();
    if (wet && seq < 16 && tid < 64) p.out()[OUT_ST + (((size_t)seq * 2 + l) * 2 + DIR) * 1024 + n * 64 + tid] = cst[(nst & 1) * 64 + tid];
    __syncthreads();
}
DI void lru_item(const KP p, int l, int seq, int n, unsigned char* shm, bool wet = true) {
    __syncthreads();
    lru_sweep<0>(p, l, seq, n, shm, wet);
    lru_sweep<1>(p, l, seq, n, shm, wet);
}

DI void attn_item(const KP p, int l, int seq, int hk, int qb, unsigned char* shm, bool wet = true) {
    const int tid = ltid(), lane = tid & 63, wid = tid >> 6, h = lane >> 5, l32 = lane & 31;
    const bool lat = seq >= 16; const int m0 = lat ? MCTX + (seq - 16) * 1024 : seq * 256; const int Sk = lat ? 1280 : 256, nt = Sk >> 6;
    bf16_t* slots = (bf16_t*)(p.ws() + OFF_SLOTS); bf16_t* qbuf = slots + 3 * SLOT_E;
    const bf16_t* kraw = (const bf16_t*)(p.ws() + OFF_KRAW); const bf16_t* ck = (const bf16_t*)(p.ws() + OFF_CK);
    const bf16_t* vT = (const bf16_t*)(p.ws() + OFF_VT) + (lat ? VT_LAT_E + (size_t)((seq - 16) * 4 + hk) * 64 * 1280 : (size_t)(seq * 4 + hk) * 64 * 256);
    bf16_t* Kt = (bf16_t*)shm; bf16_t* Vt = (bf16_t*)(shm + 4 * 9216);
    const int head = hk * 4 + (wid >> 1); const int mq = m0 + qb * 64 + (wid & 1) * 32 + l32;
    bf16x8 Qf[4];
    { float qv[4][8]; float ss = 0.f;
#pragma unroll
      for (int ks = 0; ks < 4; ++ks) { unpack8(*(const u32x4*)(qbuf + (size_t)mq * 1024 + head * 64 + ks * 16 + h * 8), qv[ks]);
#pragma unroll
          for (int j = 0; j < 8; ++j) ss += qv[ks][j] * qv[ks][j]; }
      ss += __shfl_xor(ss, 32);
      const float rs = rsqrtf(ss * (1.0f / 64.0f) + 1e-6f);
      const float* gq = p.in(20) + l * 64 + h * 8;
#pragma unroll
      for (int ks = 0; ks < 4; ++ks) { const f32x4 g0 = *(const f32x4*)(gq + ks * 16), g1 = *(const f32x4*)(gq + ks * 16 + 4);
#pragma unroll
          for (int j = 0; j < 4; ++j) { qv[ks][j] *= rs * g0[j]; qv[ks][4 + j] *= rs * g1[j]; } }
      if (lat) { const int t = mq - m0;
#pragma unroll
          for (int j = 0; j < 8; ++j) { const float inv = exp2f(-(float)(h * 8 + j) * (13.287712379549449f / 16.0f));
              const float ar = (float)(t >> 6) * inv, ac = (float)(t & 63) * inv; const float cr = __cosf(ar), sr = __sinf(ar), cc = __cosf(ac), sc = __sinf(ac);
              const float a1 = qv[0][j], a2 = qv[1][j], b1 = qv[2][j], b2 = qv[3][j];
              qv[0][j] = a1 * cr - a2 * sr; qv[1][j] = a1 * sr + a2 * cr; qv[2][j] = b1 * cc - b2 * sc; qv[3][j] = b1 * sc + b2 * cc; } }
#pragma unroll
      for (int ks = 0; ks < 4; ++ks) Qf[ks] = __builtin_bit_cast(bf16x8, pack8(qv[ks])); }
    float offs;
    { float qq = 0.f;
#pragma unroll
      for (int ks = 0; ks < 4; ++ks)
#pragma unroll
          for (int j = 0; j < 8; ++j) { const float v = __uint_as_float(((unsigned)(unsigned short)Qf[ks][j]) << 16); qq += v * v; }
      qq += __shfl_xor(qq, 32);
      const float* kb = (const float*)(p.ws() + OFF_KMAX); float kmx = kb[64 + l]; if (lat) kmx = fmaxf(kmx, kb[(l * 8 + (seq - 16)) * 4 + hk]);
      offs = 1.01f * 0.125f * 1.4426950408889634f * sqrtf(qq * kmx); }
    const int lr = tid >> 3, lp = tid & 7;
    auto kaddr = [&](int kt) -> const bf16_t* { if (lat) { return kt < 4 ? ck + ((size_t)(seq - 16) * 256 + kt * 64 + lr) * 256 + hk * 64 + lp * 8 : kraw + (size_t)(m0 + (kt - 4) * 64 + lr) * 256 + hk * 64 + lp * 8; }
                                                  return kraw + (size_t)(m0 + kt * 64 + lr) * 256 + hk * 64 + lp * 8; };
    u32x4 kA = *(const u32x4*)kaddr(0), vA = *(const u32x4*)(vT + (size_t)lr * Sk + lp * 8);
    u32x4 kB = *(const u32x4*)kaddr(1), vB = *(const u32x4*)(vT + (size_t)lr * Sk + 64 + lp * 8);
    f32x16 O0, O1;
#pragma unroll
    for (int r = 0; r < 16; ++r) { O0[r] = 0.f; O1[r] = 0.f; }
    float lrun = 0.f; const float cs = 0.125f * 1.4426950408889634f;
    auto compute = [&](const bf16_t* Kb, const bf16_t* Vb) {
        f32x16 st0, st1;
#pragma unroll
        for (int r = 0; r < 16; ++r) { st0[r] = 0.f; st1[r] = 0.f; }
        bf16x8 ka[4][2];
#pragma unroll
        for (int ks = 0; ks < 4; ++ks) { ka[ks][0] = *(const bf16x8*)(Kb + (l32) * 72 + ks * 16 + h * 8); ka[ks][1] = *(const bf16x8*)(Kb + (32 + l32) * 72 + ks * 16 + h * 8); }
        __builtin_amdgcn_s_setprio(1);
#pragma unroll
        for (int ks = 0; ks < 4; ++ks) { st0 = __builtin_amdgcn_mfma_f32_32x32x16_bf16(ka[ks][0], Qf[ks], st0, 0, 0, 0); st1 = __builtin_amdgcn_mfma_f32_32x32x16_bf16(ka[ks][1], Qf[ks], st1, 0, 0, 0); }
        __builtin_amdgcn_s_setprio(0);
        float psum = 0.f;
#pragma unroll
        for (int r = 0; r < 16; ++r) { const float p0 = __builtin_amdgcn_exp2f(fmaf(st0[r], cs, -offs)), p1 = __builtin_amdgcn_exp2f(fmaf(st1[r], cs, -offs)); st0[r] = p0; st1[r] = p1; psum += p0 + p1; }
        lrun += psum;
#pragma unroll
        for (int kb = 0; kb < 2; ++kb)
#pragma unroll
            for (int s = 0; s < 2; ++s) {
                u32x4 pb;
                if (kb == 0) { pb[0] = pk2(st0[8 * s + 0], st0[8 * s + 1]); pb[1] = pk2(st0[8 * s + 2], st0[8 * s + 3]); pb[2] = pk2(st0[8 * s + 4], st0[8 * s + 5]); pb[3] = pk2(st0[8 * s + 6], st0[8 * s + 7]); }
                else { pb[0] = pk2(st1[8 * s + 0], st1[8 * s + 1]); pb[1] = pk2(st1[8 * s + 2], st1[8 * s + 3]); pb[2] = pk2(st1[8 * s + 4], st1[8 * s + 5]); pb[3] = pk2(st1[8 * s + 6], st1[8 * s + 7]); }
                const bf16x8 Pb = __builtin_bit_cast(bf16x8, pb);
                { const bf16_t* vp = Vb + (l32) * 68 + kb * 32 + 16 * s + 4 * h; const u32x2 v0 = *(const u32x2*)vp, v1 = *(const u32x2*)(vp + 8); u32x4 va; va[0] = v0[0]; va[1] = v0[1]; va[2] = v1[0]; va[3] = v1[1];
                  O0 = __builtin_amdgcn_mfma_f32_32x32x16_bf16(__builtin_bit_cast(bf16x8, va), Pb, O0, 0, 0, 0); }
                { const bf16_t* vp = Vb + (32 + l32) * 68 + kb * 32 + 16 * s + 4 * h; const u32x2 v0 = *(const u32x2*)vp, v1 = *(const u32x2*)(vp + 8); u32x4 va; va[0] = v0[0]; va[1] = v0[1]; va[2] = v1[0]; va[3] = v1[1];
                  O1 = __builtin_amdgcn_mfma_f32_32x32x16_bf16(__builtin_bit_cast(bf16x8, va), Pb, O1, 0, 0, 0); }
            }
    };
#pragma unroll 1
    for (int it = 0; it < (nt >> 1); ++it) {
        const int sb = (it & 1) * 2; bf16_t* K0 = Kt + sb * 4608; bf16_t* K1 = K0 + 4608; bf16_t* V0 = Vt + sb * 4352; bf16_t* V1 = V0 + 4352;
        *(u32x4*)(K0 + lr * 72 + lp * 8) = kA; *(u32x4*)(K1 + lr * 72 + lp * 8) = kB;
        { u32x2 w0, w1; w0[0] = vA[0]; w0[1] = vA[1]; w1[0] = vA[2]; w1[1] = vA[3]; *(u32x2*)(V0 + lr * 68 + lp * 8) = w0; *(u32x2*)(V0 + lr * 68 + lp * 8 + 4) = w1; }
        { u32x2 w0, w1; w0[0] = vB[0]; w0[1] = vB[1]; w1[0] = vB[2]; w1[1] = vB[3]; *(u32x2*)(V1 + lr * 68 + lp * 8) = w0; *(u32x2*)(V1 + lr * 68 + lp * 8 + 4) = w1; }
        __syncthreads();
        const int kt = it * 2;
        if (kt + 2 < nt) { kA = *(const u32x4*)kaddr(kt + 2); vA = *(const u32x4*)(vT + (size_t)lr * Sk + (kt + 2) * 64 + lp * 8);
                           kB = *(const u32x4*)kaddr(kt + 3); vB = *(const u32x4*)(vT + (size_t)lr * Sk + (kt + 3) * 64 + lp * 8); }
        compute(K0, V0);
        compute(K1, V1);
    }
    const float ltot = lrun + __shfl_xor(lrun, 32); const float inv = 1.0f / ltot;
    if (wet)
#pragma unroll
    for (int rg = 0; rg < 4; ++rg) { const int d = 8 * rg + 4 * h; u32x2 o;
        o[0] = pk2(O0[4 * rg] * inv, O0[4 * rg + 1] * inv); o[1] = pk2(O0[4 * rg + 2] * inv, O0[4 * rg + 3] * inv); *(u32x2*)(qbuf + (size_t)mq * 1024 + head * 64 + d) = o;
        o[0] = pk2(O1[4 * rg] * inv, O1[4 * rg + 1] * inv); o[1] = pk2(O1[4 * rg + 2] * inv, O1[4 * rg + 3] * inv); *(u32x2*)(qbuf + (size_t)mq * 1024 + head * 64 + 32 + d) = o; }
    __syncthreads();
}

__global__ void __launch_bounds__(512) mega(Params p_unused) {
    KP p = fresh_kp();
    extern __shared__ __attribute__((aligned(16))) unsigned char shm[];
    cg::grid_group grid = cg::this_grid();
    LAS unsigned char* lds = (LAS unsigned char*)shm;
    bf16_t* slots = (bf16_t*)(p.ws() + OFF_SLOTS); unsigned char* W = p.ws() + OFF_W;
    const int G = lgdim(), c = lbid();
    if (lbid() < 0) grid.sync();
    gbar_post(p, shm);
    phase_mod(p, shm);
    phase_kbound(p, shm);
    phase_weights(p, 0, shm, 1);
#if EXP == 5
    phase_mod(p, shm); phase_weights(p, 0, shm);
#endif
    gbar(p, shm); p = fresh_kp();
#pragma unroll 1
    for (int l = 0; l < 2; ++l) {
        const float* modl = (const float*)(p.ws() + OFF_MOD) + (size_t)l * 9 * 6144;
        if (l == 0) { phase_norm(p, 0, true, p.in(7), 0, 1024, slots, false);
#if EXP == 1
        for (int r = 0; r < 12; ++r) gbar(p, shm);
#endif
        gbar(p, shm); p = fresh_kp(); }
        { pg8::Gemm g{slots, (const bf16_t*)(W + W_IN), 1024, 1024, 1024, 48, 30, 1, 0, 0, 0, 0, 0};
          EpiInProj E{slots, (bf16_t*)(p.ws() + OFF_KRAW), (bf16_t*)(p.ws() + OFF_VRAW), p.in(12) + (size_t)l * 3072};
          pg8::gemm_phase(lds, g, E);
          if (l == 0 && G == 256 && c >= 160) { __syncthreads(); phase_weights(p, 0, shm, 8 | 16, 96, c - 160); }
          else if (l == 0 && G != 256) { __syncthreads(); phase_weights(p, 0, shm, 8 | 16); }
#if EXP == 4
          __syncthreads(); pg8::gemm_phase(lds, g, E);
#endif
        }
        gbar(p, shm); p = fresh_kp();
        phase_e1_elem(p, l, shm);
#if EXP == 8
        __syncthreads(); phase_e1_elem(p, l, shm, 14);
#endif
        gbar(p, shm); p = fresh_kp();
        { pg8::Gemm g{slots, (const bf16_t*)(W + W_POOL), 1024, 256, 256, 48, 4, 1, 0, 256, 0, 0, 0};
          EpiScaleBf16 E{slots, 1024, 0, p.in(23) + (size_t)l * 1024};
          if (G != 256) pg8::gemm_phase(lds, g, E); else if (c >= 128) pg8::gemm_phase(lds, g, E, 128, c - 128); }
        __syncthreads();
#if EXP == 3
        { const bool dry = lbid() < 0;
          if (c < 128) lru_item(p, l, 16 + (c >> 4), c & 15, shm, dry); else { for (int k = 0; k < 2; ++k) { const int it = (c - 128) * 2 + k; lru_item(p, l, it >> 4, it & 15, shm, dry); } } }
#endif
        if (G == 256) { if (c < 128) lru_item(p, l, 16 + (c >> 4), c & 15, shm); else { for (int k = 0; k < 2; ++k) { const int it = (c - 128) * 2 + k; lru_item(p, l, it >> 4, it & 15, shm); } } }
        else for (int it = c; it < 384; it += G) { if (it < 128) lru_item(p, l, 16 + (it >> 4), it & 15, shm); else lru_item(p, l, (it - 128) >> 4, (it - 128) & 15, shm); }
#if EXP == 2
        { const bool dry = lbid() < 0;
            for (int it = c; it < 512; it += 256) attn_item(p, l, 16 + (it >> 6), (it >> 4) & 3, it & 15, shm, dry);
            if (c >= 128) for (int k = 0; k < 2; ++k) { const int j = (c - 128) * 2 + k; attn_item(p, l, j >> 4, (j >> 2) & 3, j & 3, shm, dry); } }
#endif
        if (G == 256) {
            for (int it = c; it < 512; it += 256) attn_item(p, l, 16 + (it >> 6), (it >> 4) & 3, it & 15, shm);
            if (c >= 128) for (int k = 0; k < 2; ++k) { const int j = (c - 128) * 2 + k; attn_item(p, l, j >> 4, (j >> 2) & 3, j & 3, shm); }
        } else
        for (int it = c; it < 768; it += G) { if (it < 512) attn_item(p, l, 16 + (it >> 6), (it >> 4) & 3, it & 15, shm); else { const int j = it - 512; attn_item(p, l, j >> 4, (j >> 2) & 3, j & 3, shm); } }
        gbar(p, shm); p = fresh_kp();
        { pg8::Gemm g{slots + 4 * SLOT_E, (const bf16_t*)(W + W_BR), 1024, 1024, 1024, 48, 4, 1, 0, 0, -(long)SLOT_E, -4 * (long)SLOT_E, (long)1024 * 1024};
          EpiMerge E{slots + 5 * SLOT_E, false};
#if EXP == 9
          { EpiMerge E2{slots + 5 * SLOT_E, lbid() >= 0}; pg8::gemm_phase(lds, g, E2); __syncthreads(); }
#endif
          pg8::gemm_phase(lds, g, E);
          if (G == 256 && c >= 192) phase_weights(p, l, shm, l == 0 ? (2 | 4) : 4, 64, c - 192);
          else if (G != 256) { __syncthreads(); phase_weights(p, l, shm, l == 0 ? (2 | 4) : 4); } }
        gbar(p, shm); p = fresh_kp();
        { pg8::Gemm g{slots + 7 * SLOT_E, (const bf16_t*)(W + W_O), 1024, 1024, 1024, 48, 4, 1, 0, 0, 0, 0, 0};
          EpiResidNorm E{p.out(), modl, 2048, 0, p.in(8) + l * 1024, modl, 3072, 4096, slots, (float*)(p.ws() + OFF_RSS), (unsigned*)(p.ws() + OFF_CNT) + (l * 2 + 0) * 48, (unsigned*)(p.ws() + OFF_BAR), (float*)(shm + 131072 + 16)};
          pg8::gemm_phase(lds, g, E); }
        gbar(p, shm); p = fresh_kp();
        { pg8::Gemm g{slots, (const bf16_t*)(W + W_UP), 1024, 1024, 1024, 48, 24, 1, 0, 0, 0, 0, 0};
          float* zedge = (float*)(slots + 1 * SLOT_E); float* zpart = zedge + (size_t)192 * 2 * 6144;
          EpiUpFused E{slots + 5 * SLOT_E, zedge, zpart, p.in(29) + (size_t)l * 3 * 6144, p.in(30) + (size_t)l * 6144};
          pg8::gemm_phase(lds, g, E);
          if (l == 0 && G == 256 && c >= 128) { __syncthreads(); phase_weights(p, 1, shm, 1 | 8 | 16, 128, c - 128); }
          else if (l == 0 && G != 256) { __syncthreads(); phase_weights(p, 1, shm, 1 | 8 | 16); } }
        gbar(p, shm); p = fresh_kp();
        { pg8::Gemm g{slots + 5 * SLOT_E, (const bf16_t*)(W + W_DOWN), 3072, 3072, 3072, 48, 4, 1, 0, 0, 0, 0, 0};
          { Unit u0; if (pg8::next_unit(g, 0, G, c, u0)) { const float* zedge = (const float*)(slots + 1 * SLOT_E);
              ffn_fixup(u0.pm, slots + 5 * SLOT_E, zedge, zedge + (size_t)192 * 2 * 6144, p.in(29) + (size_t)l * 3 * 6144, p.in(30) + (size_t)l * 6144); } }
          const float* modn = (const float*)(p.ws() + OFF_MOD) + (size_t)9 * 6144;
          EpiResidNorm E{p.out(), modl, 5120, l == 0 ? 0 : 1, l == 0 ? p.in(7) + 1024 : p.in(32), modn, 0, 1024, slots, (float*)(p.ws() + OFF_RSS), (unsigned*)(p.ws() + OFF_CNT) + (l * 2 + 1) * 48, (unsigned*)(p.ws() + OFF_BAR), (float*)(shm + 131072 + 16)};
          pg8::gemm_phase(lds, g, E);
          if (l == 0 && G == 256 && c >= 192) phase_weights(p, 1, shm, 2, 64, c - 192);
          else if (l == 0 && G != 256) { __syncthreads(); phase_weights(p, 1, shm, 2); } }
        gbar(p, shm); p = fresh_kp();
    }
}

extern "C" void kernel_launch(void* const* d_in, const int* in_sizes, int n_in, void* d_out, int out_size, void* d_ws, size_t ws_size, hipStream_t stream) {
    static int grid_blocks = 0;
    if (!grid_blocks) {
        int dev = 0, cus = 0, per_cu = 0;
        (void)hipGetDevice(&dev);
        (void)hipDeviceGetAttribute(&cus, hipDeviceAttributeMultiprocessorCount, dev);
        if (hipFuncSetAttribute((const void*)mega, hipFuncAttributeMaxDynamicSharedMemorySize, LDS_BYTES) != hipSuccess) { fprintf(stderr, "setattr failed\n"); return; }
        if (hipOccupancyMaxActiveBlocksPerMultiprocessor(&per_cu, (const void*)mega, 512, LDS_BYTES) != hipSuccess || per_cu < 1) { fprintf(stderr, "occupancy query failed\n"); return; }
        grid_blocks = cus;
    }
    if (ws_size < WS_NEED || n_in < 33) { fprintf(stderr, "workspace too small: %zu < %zu\n", ws_size, (size_t)WS_NEED); return; }
    Params p{};
    for (int i = 0; i < 33; ++i) p.in[i] = (const float*)d_in[i];
    p.out = (float*)d_out; p.ws = (unsigned char*)d_ws;
    (void)hipMemsetAsync((unsigned char*)d_ws + OFF_BAR, 0, (size_t)XCD_BAR_WORDS * 4 + 256 * 4 + 256 * 4, stream);
    void* args[] = {&p};
    hipError_t e = hipLaunchCooperativeKernel((void*)mega, dim3(grid_blocks), dim3(512), args, LDS_BYTES, stream);
    if (e != hipSuccess) fprintf(stderr, "cooperative launch failed: %s (grid %d)\n", hipGetErrorString(e), grid_blocks);
}
```

```cpp
#include <hip/hip_runtime.h>
#include <hip/hip_cooperative_groups.h>
#include <cstdio>
namespace cg = cooperative_groups;

#define LAS __attribute__((address_space(3)))
#define DI __device__ __forceinline__
typedef unsigned short bf16_t;
typedef short bf16x8 __attribute__((ext_vector_type(8)));
typedef float f32x4 __attribute__((ext_vector_type(4)));
typedef float f32x16 __attribute__((ext_vector_type(16)));
typedef unsigned u32x4 __attribute__((ext_vector_type(4)));
typedef unsigned u32x2 __attribute__((ext_vector_type(2)));
typedef float f32x2_t __attribute__((ext_vector_type(2)));
typedef __bf16 bfx2 __attribute__((ext_vector_type(2)));

constexpr int MT = 12288, MCTX = 4096, DM = 1024;
constexpr size_t SLOT_E = (size_t)MT * 1024;
constexpr size_t SLOT_B = SLOT_E * 2;
constexpr size_t OFF_SLOTS = 0;
constexpr size_t OFF_KRAW = 8 * SLOT_B;
constexpr size_t OFF_VRAW = OFF_KRAW + (size_t)MT * 256 * 2;
constexpr size_t OFF_CK = OFF_VRAW + (size_t)MT * 256 * 2;
constexpr size_t OFF_VT = OFF_CK + (size_t)8 * 256 * 256 * 2;
constexpr size_t VT_LAT_E = (size_t)16 * 4 * 64 * 256;
constexpr size_t OFF_W = OFF_VT + ((size_t)16 * 4 * 64 * 256 + (size_t)8 * 4 * 64 * 1280) * 2;
constexpr size_t W_IN = 0, W_BR = W_IN + (size_t)7680 * 1024 * 2, W_O = W_BR + (size_t)3 * 1024 * 1024 * 2, W_UP = W_O + (size_t)1024 * 1024 * 2,
                 W_DOWN = W_UP + (size_t)6144 * 1024 * 2, W_POOL = W_DOWN + (size_t)1024 * 3072 * 2, W_GATE = W_POOL + (size_t)1024 * 256 * 2, W_END = W_GATE + (size_t)16 * 2 * 128 * 64 * 2;
constexpr size_t OFF_MOD = OFF_W + W_END;
constexpr size_t OFF_BAR = OFF_MOD + (size_t)2 * 9 * 6144 * 4;
constexpr int XCD_BAR_WORDS = 3456;
constexpr size_t OFF_KMAX = OFF_BAR + (size_t)XCD_BAR_WORDS * 4;
constexpr size_t OFF_CNT = OFF_KMAX + 256 * 4;
constexpr size_t OFF_RSS = OFF_CNT + 256 * 4;
constexpr size_t WS_NEED = OFF_RSS + (size_t)MT * 16 * 4;
#ifndef EXP
#define EXP 0
#endif
constexpr int LDS_BYTES = 131072 + 16 + 4096;
constexpr size_t OUT_CK = (size_t)MT * 1024, OUT_CV = OUT_CK + (size_t)16 * 2 * 256 * 256, OUT_ST = OUT_CV + (size_t)16 * 2 * 256 * 256;

struct Params { const float* in[33]; float* out; unsigned char* ws; };
typedef const __attribute__((address_space(4))) unsigned char* kptr_t;
struct KP { kptr_t k;
    DI const float* in(int i) const { return *(const float* const __attribute__((address_space(4)))*)(k + 8 * i); }
    DI float* out() const { return *(float* const __attribute__((address_space(4)))*)(k + 8 * 33); }
    DI unsigned char* ws() const { return *(unsigned char* const __attribute__((address_space(4)))*)(k + 8 * 34); } };
DI KP fresh_kp() { kptr_t k = (kptr_t)__builtin_amdgcn_kernarg_segment_ptr(); asm volatile("" : "+s"(k)); KP p; p.k = k; return p; }
DI int ltid() { int t = threadIdx.x; asm volatile("" : "+v"(t)); return t; }
DI int lbid() { int t = blockIdx.x; asm volatile("" : "+s"(t)); return t; }
DI int lgdim() { int t = gridDim.x; asm volatile("" : "+s"(t)); return t; }

DI unsigned pk2(float a, float b) { bfx2 v; v[0] = (__bf16)a; v[1] = (__bf16)b; return __builtin_bit_cast(unsigned, v); }
DI float bflo(unsigned u) { return __uint_as_float(u << 16); }
DI float bfhi(unsigned u) { return __uint_as_float(u & 0xffff0000u); }
DI void unpack8(u32x4 v, float* f) { f[0] = bflo(v[0]); f[1] = bfhi(v[0]); f[2] = bflo(v[1]); f[3] = bfhi(v[1]); f[4] = bflo(v[2]); f[5] = bfhi(v[2]); f[6] = bflo(v[3]); f[7] = bfhi(v[3]); }
DI u32x4 pack8(const float* f) { u32x4 r; r[0] = pk2(f[0], f[1]); r[1] = pk2(f[2], f[3]); r[2] = pk2(f[4], f[5]); r[3] = pk2(f[6], f[7]); return r; }
DI float sigmoidf_(float x) { return __builtin_amdgcn_rcpf(1.0f + __builtin_amdgcn_exp2f(-1.4426950408889634f * x)); }
DI float gelu_tanh(float x) { const float z = 0.7978845608028654f * (x + 0.044715f * x * x * x); return x * sigmoidf_(2.0f * z); }
DI int seq_start(int m) { return m < MCTX ? (m & ~255) : (MCTX + ((m - MCTX) & ~1023)); }
DI int seq_len(int m) { return m < MCTX ? 256 : 1024; }
DI int mod_row(int m) { return m < MCTX ? 0 : 1 + ((m - MCTX) >> 10); }

namespace pg8 {
constexpr int BM = 256, BK = 64, HALF = 128, HTB = HALF * BK * 2, STAGE_BYTES = 8 * HTB, NXCD = 8, WGM = 8;
DI int lds_byte(int r, int c) { const int st = (r >> 4) * 2 + (c >> 5), rr = r & 15, cc = c & 31, ob = rr * 64 + cc * 2; return st * 1024 + (ob ^ (((ob >> 9) & 1) << 5)); }
DI void stage_rc(int b, int& R, int& C) { const int st = b / 1024, sb = b % 1024, swz = sb ^ (((sb >> 9) & 1) << 5); R = (st >> 1) * 16 + swz / 64; C = (st & 1) * 32 + (swz % 64) / 2; }
DI int perm32(int rho) { const int n = rho >> 4, i = rho & 15; return 8 * (i >> 2) + 4 * n + (i & 3); }
struct Unit { int pm, pn, seg, row0, half; };
struct Gemm { const bf16_t* A; const bf16_t* Bt; int lda, ldb, K; int nM, nN, nSeg, pn0; long a_pn_stride, a_seg1, a_seg2, b_seg_stride; int tail_half; };
DI bool next_unit(const Gemm& g, int i, int G, int c, Unit& u) {
    const int nwg = g.nM * g.nN; const int it = i / g.nSeg; u.seg = i - it * g.nSeg;
    long L = (long)it * G + c; int hsel = 0; u.half = 0;
    if (g.tail_half) { const int fr_ = nwg / G;
        if (it > fr_) return false;
        if (it == fr_) { L = (long)fr_ * G + (c >> 1); hsel = c & 1; u.half = 1; } }
    if (L >= nwg) return false;
    int wgid = (int)L; { const int q = nwg / NXCD, r = nwg % NXCD, xcd = wgid % NXCD, off = wgid / NXCD; wgid = (xcd < r ? xcd * (q + 1) : r * (q + 1) + (xcd - r) * q) + off; }
    const int nig = WGM * g.nN, gid = wgid / nig, fm = gid * WGM, gsz = (g.nM - fm) < WGM ? (g.nM - fm) : WGM;
    u.pm = fm + ((wgid % nig) % gsz); u.pn = (wgid % nig) / gsz; u.row0 = u.pm * 256 + hsel * 128; return true;
}
DI const char* a_ptr(const Gemm& g, const Unit& u) { return (const char*)(g.A + (size_t)u.row0 * g.lda + (size_t)u.pn * g.a_pn_stride + (u.seg == 0 ? 0 : (u.seg == 1 ? g.a_seg1 : g.a_seg2))); }
DI const char* b_ptr(const Gemm& g, const Unit& u) { return (const char*)(g.Bt + (size_t)(g.pn0 + u.pn) * 256 * g.ldb + (size_t)u.seg * g.b_seg_stride); }

template <class Epi>
DI void gemm_phase(LAS unsigned char* lds, const Gemm g, const Epi& E, int Gv = 0, int cv = 0) {
    const int tid = ltid(), wid = __builtin_amdgcn_readfirstlane(tid >> 6), lane = tid & 63, wr = wid >> 2, wc = wid & 3, fr = lane & 15, fq = lane >> 4;
    constexpr bool MERGE = Epi::MERGE;
    const int K = g.K, nt = MERGE ? 3 * (K / BK) : K / BK; const int G = Gv > 0 ? Gv : lgdim(), c = Gv > 0 ? cv : lbid();
    unsigned voffA[2], voffB[2];
#pragma unroll
    for (int i = 0; i < 2; ++i) { int R, C; stage_rc(tid * 16 + i * 8192, R, C); const int Rb = Epi::PERM ? ((R & ~31) + perm32(R & 31)) : R;
        voffA[i] = (unsigned)(R * g.lda + C) * 2u; voffB[i] = (unsigned)(Rb * g.ldb + C) * 2u; }
    const size_t kstep = (size_t)(BK * 2);
    const size_t hstepA = (size_t)HALF * g.lda * 2, hstepB = (size_t)HALF * g.ldb * 2;
    const unsigned ldsw = (unsigned)wid * 1024u;
    const int aoff = lds_byte(wr * 64 + fr, fq * 8), boff = lds_byte(wc * 32 + fr, fq * 8);
#define PG8_SA(b, h) (((b) * 2 + (h)) * HTB)
#define PG8_SB(b, h) ((4 + (b) * 2 + (h)) * HTB)
#define PG8_STAGE(bufoff, gbase, voff) do { _Pragma("unroll") for (int _i = 0; _i < 2; ++_i) \
        __builtin_amdgcn_global_load_lds((const unsigned*)((const char*)(gbase) + (voff)[_i]), (LAS unsigned*)(lds + (bufoff) + ldsw + _i * 8192), 16, 0, 0); } while (0)
#define PG8_LDA(dst, b, h) do { _Pragma("unroll") for (int m = 0; m < 4; ++m) _Pragma("unroll") for (int k = 0; k < 2; ++k) dst[m][k] = *(const LAS bf16x8*)(lds + PG8_SA(b, h) + aoff + m * 2048 + k * 1024); } while (0)
#define PG8_LDB(dst, b, h) do { _Pragma("unroll") for (int n = 0; n < 2; ++n) _Pragma("unroll") for (int k = 0; k < 2; ++k) dst[n][k] = *(const LAS bf16x8*)(lds + PG8_SB(b, h) + boff + n * 2048 + k * 1024); } while (0)
#define PG8_MMA(ai, bj, At, Bt) do { __builtin_amdgcn_s_setprio(1); _Pragma("unroll") for (int m = 0; m < 4; ++m) _Pragma("unroll") for (int n = 0; n < 2; ++n) _Pragma("unroll") for (int k = 0; k < 2; ++k) \
        acc[ai][bj][m][n] = __builtin_amdgcn_mfma_f32_16x16x32_bf16(Bt[n][k], At[m][k], acc[ai][bj][m][n], 0, 0, 0); __builtin_amdgcn_s_setprio(0); } while (0)
#define PG8_WAIT_V(n) asm volatile("s_waitcnt vmcnt(" #n ")" ::: "memory")
#define PG8_WAIT_L(n) asm volatile("s_waitcnt lgkmcnt(" #n ")" ::: "memory")
#define PG8_BAR __builtin_amdgcn_s_barrier()
#define PG8_SCHED __builtin_amdgcn_sched_barrier(0)
    Unit cur, nxt; int ui = 0;
    if (!next_unit(g, 0, G, c, cur)) return;
    f32x4 acc[2][2][4][2];
#pragma unroll
    for (int a = 0; a < 2; ++a)
#pragma unroll
        for (int b = 0; b < 2; ++b)
#pragma unroll
            for (int m = 0; m < 4; ++m)
#pragma unroll
                for (int n = 0; n < 2; ++n) acc[a][b][m][n] = (f32x4){0.f, 0.f, 0.f, 0.f};
    bf16x8 At[4][2], B0[2][2], B1[2][2];
    const char* cA = a_ptr(g, cur); const char* cB = b_ptr(g, cur);
    PG8_STAGE(PG8_SB(0, 0), cB, voffB); PG8_STAGE(PG8_SA(0, 0), cA, voffA); PG8_STAGE(PG8_SB(0, 1), cB + hstepB, voffB); PG8_STAGE(PG8_SA(0, 1), cA + hstepA, voffA);
    if (wr == 1) PG8_BAR;
    PG8_WAIT_V(4); PG8_BAR;
    PG8_STAGE(PG8_SB(1, 0), cB + kstep, voffB); PG8_STAGE(PG8_SA(1, 0), cA + kstep, voffA); PG8_STAGE(PG8_SB(1, 1), cB + hstepB + kstep, voffB);
    PG8_WAIT_V(6); PG8_BAR;
    for (;;) {
        const bool has_next = next_unit(g, ui + 1, G, c, nxt);
        const char* nA = has_next ? a_ptr(g, nxt) : cA; const char* nB = has_next ? b_ptr(g, nxt) : cB;
        for (int t = 0; t < nt; t += 2) {
            const bool last = (t == nt - 2);
            const char* a1; const char* a2; const char* b2; const char* a3; const char* b3;
            if constexpr (!MERGE) { a1 = cA + (size_t)(t + 1) * kstep; a2 = last ? nA : cA + (size_t)(t + 2) * kstep; b2 = last ? nB : cB + (size_t)(t + 2) * kstep; }
            else { const int ntk = K / BK; const int sg1 = (t + 1) / ntk, sg2 = (t + 2) / ntk;
                a1 = cA + (sg1 == 0 ? 0 : (sg1 == 1 ? g.a_seg1 : g.a_seg2)) * 2 + (size_t)(t + 1 - sg1 * ntk) * kstep;
                a2 = last ? nA : cA + (sg2 == 0 ? 0 : (sg2 == 1 ? g.a_seg1 : g.a_seg2)) * 2 + (size_t)(t + 2 - sg2 * ntk) * kstep;
                b2 = last ? nB : cB + (size_t)sg2 * g.b_seg_stride * 2 + (size_t)(t + 2 - sg2 * ntk) * kstep;
                if (t > 0 && t % ntk == 0) E.rescale(acc, cur, t / ntk, wr, wc, fr, fq); }
            a3 = a2 + kstep; b3 = b2 + kstep;
            PG8_LDB(B0, 0, 0); PG8_SCHED; PG8_LDA(At, 0, 0); PG8_STAGE(PG8_SA(1, 1), a1 + hstepA, voffA);
            PG8_WAIT_L(8); PG8_BAR; PG8_WAIT_L(0); PG8_MMA(0, 0, At, B0); PG8_BAR; PG8_SCHED;
            PG8_LDB(B1, 0, 1); PG8_STAGE(PG8_SB(0, 0), b2, voffB);
            PG8_BAR; PG8_WAIT_L(0); PG8_MMA(0, 1, At, B1); PG8_BAR;
            PG8_LDA(At, 0, 1); PG8_STAGE(PG8_SA(0, 0), a2, voffA);
            PG8_BAR; PG8_WAIT_L(0); if (!cur.half) { PG8_MMA(1, 0, At, B0); } PG8_BAR; PG8_SCHED;
            PG8_STAGE(PG8_SB(0, 1), b2 + hstepB, voffB);
            PG8_WAIT_V(6); PG8_BAR; if (!cur.half) { PG8_MMA(1, 1, At, B1); } PG8_BAR;
            PG8_LDB(B0, 1, 0); PG8_SCHED; PG8_LDA(At, 1, 0); PG8_STAGE(PG8_SA(0, 1), a2 + hstepA, voffA);
            PG8_WAIT_L(8); PG8_BAR; PG8_WAIT_L(0); PG8_MMA(0, 0, At, B0); PG8_BAR; PG8_SCHED;
            PG8_LDB(B1, 1, 1); PG8_STAGE(PG8_SB(1, 0), b3, voffB);
            PG8_BAR; PG8_WAIT_L(0); PG8_MMA(0, 1, At, B1); PG8_BAR;
            PG8_LDA(At, 1, 1); PG8_STAGE(PG8_SA(1, 0), a3, voffA);
            PG8_BAR; PG8_WAIT_L(0); if (!cur.half) { PG8_MMA(1, 0, At, B0); } PG8_BAR; PG8_SCHED;
            PG8_STAGE(PG8_SB(1, 1), b3 + hstepB, voffB);
            PG8_WAIT_V(6); PG8_BAR; if (!cur.half) { PG8_MMA(1, 1, At, B1); } PG8_BAR;
        }
        if constexpr (!Epi::AFTER_DRAIN) E(acc, cur, wr, wc, fr, fq);
        if (!has_next) break;
#pragma unroll
        for (int a = 0; a < 2; ++a)
#pragma unroll
            for (int b = 0; b < 2; ++b)
#pragma unroll
                for (int m = 0; m < 4; ++m)
#pragma unroll
                    for (int n = 0; n < 2; ++n) acc[a][b][m][n] = (f32x4){0.f, 0.f, 0.f, 0.f};
        cur = nxt; cA = nA; cB = nB; ++ui;
    }
    PG8_WAIT_V(0);
    if (wr == 0) PG8_BAR;
    PG8_BAR;
    if constexpr (Epi::AFTER_DRAIN) E.fused(acc, cur, wr, wc, fr, fq);
#undef PG8_SA
#undef PG8_SB
#undef PG8_STAGE
#undef PG8_LDA
#undef PG8_LDB
#undef PG8_MMA
#undef PG8_WAIT_V
#undef PG8_WAIT_L
#undef PG8_BAR
#undef PG8_SCHED
}
}
using pg8::Unit;
typedef f32x4 AccT[2][2][4][2];

struct EpiInProj {
    static constexpr bool PERM = true, MERGE = false, AFTER_DRAIN = false;
    bf16_t* slots; bf16_t* kraw; bf16_t* vraw; const float* b_gate;
    DI void operator()(const AccT& acc, const Unit& u, int wr, int wc, int fr, int fq) const {
        const int pn = u.pn; bf16_t* base; int ld = 1024, ccol, mode = 0; const float* bias = b_gate;
        if (pn < 4) { base = slots + 1 * SLOT_E; ccol = pn * 256; }
        else if (pn < 8) { base = slots + 2 * SLOT_E; ccol = (pn - 4) * 256; mode = 1; }
        else if (pn < 12) { base = slots + 3 * SLOT_E; ccol = (pn - 8) * 256; }
        else if (pn == 12) { base = kraw; ld = 256; ccol = 0; }
        else if (pn == 13) { base = vraw; ld = 256; ccol = 0; }
        else if (pn < 18) { base = slots + 4 * SLOT_E; ccol = (pn - 14) * 256; }
        else { const int sec = (pn - 18) >> 2; base = slots + (size_t)(5 + sec) * SLOT_E; ccol = ((pn - 18) & 3) * 256; mode = 2; bias = b_gate + (pn - 18) * 256; }
        const int row0 = u.pm * 256 + wr * 64 + fr, cl = wc * 32 + 8 * fq;
#pragma unroll
        for (int bj = 0; bj < 2; ++bj) {
            float bv[8];
#pragma unroll
            for (int e = 0; e < 8; ++e) bv[e] = (mode == 2) ? bias[cl + bj * 128 + e] : 0.f;
#pragma unroll
            for (int ai = 0; ai < 2; ++ai)
#pragma unroll
                for (int m = 0; m < 4; ++m) {
                    float v[8];
#pragma unroll
                    for (int e = 0; e < 4; ++e) { v[e] = acc[ai][bj][m][0][e]; v[4 + e] = acc[ai][bj][m][1][e]; }
                    if (mode == 1) {
#pragma unroll
                        for (int e = 0; e < 8; ++e) v[e] = gelu_tanh(v[e]);
                    } else if (mode == 2) {
#pragma unroll
                        for (int e = 0; e < 8; ++e) v[e] = sigmoidf_(v[e] + bv[e]);
                    }
                    *(u32x4*)(base + (size_t)(row0 + ai * 128 + m * 16) * ld + ccol + bj * 128 + cl) = pack8(v);
                }
        }
    }
};
struct EpiScaleBf16 {
    static constexpr bool PERM = true, MERGE = false, AFTER_DRAIN = false;
    bf16_t* O; int ldc; int pn_base; const float* scale;
    DI void operator()(const AccT& acc, const Unit& u, int wr, int wc, int fr, int fq) const {
        const int row0 = u.pm * 256 + wr * 64 + fr, cl = (u.pn + pn_base) * 256 + wc * 32 + 8 * fq;
#pragma unroll
        for (int bj = 0; bj < 2; ++bj) {
            float sv[8];
#pragma unroll
            for (int e = 0; e < 8; ++e) sv[e] = scale ? scale[cl + bj * 128 + e] : 1.0f;
#pragma unroll
            for (int ai = 0; ai < 2; ++ai)
#pragma unroll
                for (int m = 0; m < 4; ++m) {
                    float v[8];
#pragma unroll
                    for (int e = 0; e < 4; ++e) { v[e] = acc[ai][bj][m][0][e] * sv[e]; v[4 + e] = acc[ai][bj][m][1][e] * sv[4 + e]; }
                    *(u32x4*)(O + (size_t)(row0 + ai * 128 + m * 16) * ldc + cl + bj * 128) = pack8(v);
                }
        }
    }
};
struct EpiMerge {
    static constexpr bool PERM = true, MERGE = true, AFTER_DRAIN = false;
    bf16_t* gates; bool dry;
    DI void rescale(AccT& acc, const Unit& u, int sb, int wr, int wc, int fr, int fq) const {
        const int row0 = u.pm * 256 + wr * 64 + fr, cl = u.pn * 256 + wc * 32 + 8 * fq;
        const bf16_t* gp = gates + (size_t)(sb - 1) * SLOT_E + (size_t)row0 * 1024 + cl;
#pragma unroll
        for (int ai = 0; ai < 2; ++ai)
#pragma unroll
            for (int m = 0; m < 4; ++m) {
                asm volatile("" : "+v"(gp));
#pragma unroll
                for (int bj = 0; bj < 2; ++bj) {
                    float a[8], b[8]; unpack8(*(const u32x4*)(gp + bj * 128), a); unpack8(*(const u32x4*)(gp + SLOT_E + bj * 128), b);
#pragma unroll
                    for (int e = 0; e < 4; ++e) { acc[ai][bj][m][0][e] *= a[e] * __builtin_amdgcn_rcpf(b[e]); acc[ai][bj][m][1][e] *= a[4 + e] * __builtin_amdgcn_rcpf(b[4 + e]); }
                }
                gp += (m == 3 ? (128 - 48) : 16) * 1024;
            }
    }
    DI void operator()(const AccT& acc, const Unit& u, int wr, int wc, int fr, int fq) const {
        const int row0 = u.pm * 256 + wr * 64 + fr, cl = u.pn * 256 + wc * 32 + 8 * fq;
        bf16_t* gs = gates + 2 * SLOT_E;
#pragma unroll
        for (int ai = 0; ai < 2; ++ai)
#pragma unroll
            for (int m = 0; m < 4; ++m)
#pragma unroll
                for (int bj = 0; bj < 2; ++bj) {
                    const size_t idx = (size_t)(row0 + ai * 128 + m * 16) * 1024 + cl + bj * 128;
                    float gv[8]; unpack8(*(const u32x4*)(gs + idx), gv);
                    float v[8];
#pragma unroll
                    for (int e = 0; e < 4; ++e) { v[e] = acc[ai][bj][m][0][e] * gv[e]; v[4 + e] = acc[ai][bj][m][1][e] * gv[4 + e]; }
                    if (!dry) *(u32x4*)(gs + idx) = pack8(v);
                }
    }
};
DI float dpp_ror1(float v) { return __builtin_bit_cast(float, __builtin_amdgcn_update_dpp(0, __builtin_bit_cast(int, v), 0x121, 0xf, 0xf, false)); }
DI float dpp_ror15(float v) { return __builtin_bit_cast(float, __builtin_amdgcn_update_dpp(0, __builtin_bit_cast(int, v), 0x12f, 0xf, 0xf, false)); }
struct EpiUpFused {
    static constexpr bool PERM = true, MERGE = false, AFTER_DRAIN = false;
    bf16_t* act; float* zedge; float* zpart; const float* cw; const float* cb;
    DI void operator()(const AccT& acc, const Unit& u, int wr, int wc, int fr, int fq) const {
        const int j = u.pn, cl = wc * 32 + 8 * fq;
#pragma unroll
        for (int n = 0; n < 2; ++n) {
            const int ch0 = 128 * j + cl + 4 * n;
            const f32x4 bg = *(const f32x4*)(cb + ch0), w0g = *(const f32x4*)(cw + ch0), w1g = *(const f32x4*)(cw + 6144 + ch0), w2g = *(const f32x4*)(cw + 2 * 6144 + ch0);
            const f32x4 bv = *(const f32x4*)(cb + 3072 + ch0), w0v = *(const f32x4*)(cw + 3072 + ch0), w1v = *(const f32x4*)(cw + 6144 + 3072 + ch0), w2v = *(const f32x4*)(cw + 2 * 6144 + 3072 + ch0);
#pragma unroll
            for (int ai = 0; ai < 2; ++ai) {
                if (u.half && ai == 1) continue;
                const int rowblk = u.row0 + ai * 128 + wr * 64;
#pragma unroll
                for (int m = 0; m < 4; ++m) {
                    const f32x4 zg = acc[ai][0][m][n], zv = acc[ai][1][m][n];
                    f32x4 pg, pv, ng, nv;
#pragma unroll
                    for (int e = 0; e < 4; ++e) {
                        const float pgs = dpp_ror1(zg[e]), pvs = dpp_ror1(zv[e]), ngs = dpp_ror15(zg[e]), nvs = dpp_ror15(zv[e]);
                        const float pgw = m > 0 ? dpp_ror1(acc[ai][0][m > 0 ? m - 1 : 0][n][e]) : 0.f, pvw = m > 0 ? dpp_ror1(acc[ai][1][m > 0 ? m - 1 : 0][n][e]) : 0.f;
                        const float ngw = m < 3 ? dpp_ror15(acc[ai][0][m < 3 ? m + 1 : 3][n][e]) : 0.f, nvw = m < 3 ? dpp_ror15(acc[ai][1][m < 3 ? m + 1 : 3][n][e]) : 0.f;
                        pg[e] = fr == 0 ? pgw : pgs; pv[e] = fr == 0 ? pvw : pvs; ng[e] = fr == 15 ? ngw : ngs; nv[e] = fr == 15 ? nvw : nvs; }
                    const f32x4 preg = bg + w0g * pg + w1g * zg + w2g * ng, prev = bv + w0v * pv + w1v * zv + w2v * nv;
                    const bool e0 = (m == 0 && fr == 0), e1 = (m == 3 && fr == 15);
                    if (e0 || e1) { const size_t o = ((size_t)((rowblk >> 6) * 2 + (e1 ? 1 : 0))) * 6144 + j * 256 + cl + 4 * n;
                        *(f32x4*)(zpart + o) = preg; *(f32x4*)(zpart + o + 128) = prev; *(f32x4*)(zedge + o) = zg; *(f32x4*)(zedge + o + 128) = zv; }
                    else { u32x2 ov; ov[0] = pk2(preg[0] * sigmoidf_(preg[0]) * prev[0], preg[1] * sigmoidf_(preg[1]) * prev[1]); ov[1] = pk2(preg[2] * sigmoidf_(preg[2]) * prev[2], preg[3] * sigmoidf_(preg[3]) * prev[3]);
                        *(u32x2*)(act + (size_t)(rowblk + 16 * m + fr) * 3072 + ch0) = ov; }
                }
            }
        }
    }
};
DI void ffn_fixup(int pm, bf16_t* act, const float* zedge, const float* zpart, const float* cw, const float* cb) {
    const int tid = ltid();
    for (int pc = tid; pc < 8 * 768; pc += 512) {
        const int er = pc / 768, ch0 = (pc - er * 768) * 4; const int B = 4 * pm + (er >> 1), edge = er & 1;
        const int zc = (ch0 >> 7) * 256 + (ch0 & 127);
        const size_t o = ((size_t)(B * 2 + edge)) * 6144 + zc;
        f32x4 pg = *(const f32x4*)(zpart + o), pv = *(const f32x4*)(zpart + o + 128);
        const int row = B * 64 + (edge ? 63 : 0); const int s0 = seq_start(row), S = seq_len(row), t = row - s0;
        if (edge == 0 && t > 0) { const size_t q = ((size_t)((B - 1) * 2 + 1)) * 6144 + zc; pg += *(const f32x4*)(cw + ch0) * *(const f32x4*)(zedge + q); pv += *(const f32x4*)(cw + 3072 + ch0) * *(const f32x4*)(zedge + q + 128); }
        if (edge == 1 && t < S - 1) { const size_t q = ((size_t)((B + 1) * 2 + 0)) * 6144 + zc; pg += *(const f32x4*)(cw + 2 * 6144 + ch0) * *(const f32x4*)(zedge + q); pv += *(const f32x4*)(cw + 2 * 6144 + 3072 + ch0) * *(const f32x4*)(zedge + q + 128); }
        u32x2 ov; ov[0] = pk2(pg[0] * sigmoidf_(pg[0]) * pv[0], pg[1] * sigmoidf_(pg[1]) * pv[1]); ov[1] = pk2(pg[2] * sigmoidf_(pg[2]) * pv[2], pg[3] * sigmoidf_(pg[3]) * pv[3]);
        *(u32x2*)(act + (size_t)row * 3072 + ch0) = ov;
    }
    asm volatile("s_waitcnt vmcnt(0)" ::: "memory");
    __syncthreads();
}
struct EpiResid {
    static constexpr bool PERM = false, MERGE = false, AFTER_DRAIN = false;
    float* x; const float* modl; int gate_off; bool dry;
    DI void operator()(const AccT& acc, const Unit& u, int wr, int wc, int fr, int fq) const {
        const int row0 = u.pm * 256 + wr * 64 + fr, col0 = u.pn * 256 + wc * 32 + 4 * fq;
        const float* gp = modl + (size_t)mod_row(u.pm * 256) * 6144 + gate_off;
#pragma unroll
        for (int bj = 0; bj < 2; ++bj)
#pragma unroll
            for (int n = 0; n < 2; ++n) {
                const int col = col0 + bj * 128 + n * 16; const f32x4 gv = *(const f32x4*)(gp + col);
#pragma unroll
                for (int ai = 0; ai < 2; ++ai)
#pragma unroll
                    for (int m = 0; m < 4; ++m) { float* xp = x + (size_t)(row0 + ai * 128 + m * 16) * 1024 + col; f32x4 xv = *(const f32x4*)xp; xv += gv * acc[ai][bj][m][n]; if (!dry) *(f32x4*)xp = xv; }
            }
    }
};


#define XB_TMO      128
#define XB_XCNT(j)  (256  + 64 * (j))
#define XB_XSUB(j)  (1280 + 64 * (j))
#define XB_XGEN(j)  (2304 + 64 * (j))
#define XB_TOP      3328
#define XB_TOPGEN   3392
#define XB_SPIN_CAP (1u << 18)
DI unsigned xb_ld(unsigned* p) { return __hip_atomic_load(p, __ATOMIC_RELAXED, __HIP_MEMORY_SCOPE_AGENT); }
DI unsigned xb_add(unsigned* p, unsigned v) { return __hip_atomic_fetch_add(p, v, __ATOMIC_RELAXED, __HIP_MEMORY_SCOPE_AGENT); }
DI unsigned xb_xcc_id() { return (unsigned)__builtin_amdgcn_s_getreg((3 << 11) | 20) & 0xFu; }
#define XB_SPIN(cond, bar) do { unsigned _sp = 0; while (cond) { __builtin_amdgcn_s_sleep(1); \
    if ((++_sp & 255u) == 0u) { if (xb_ld(&(bar)[XB_TMO])) break; if (_sp > XB_SPIN_CAP) { atomicAdd(&(bar)[XB_TMO], 1u); break; } } } } while (0)
DI void xcd_barrier_complete(unsigned* bar, unsigned x, unsigned& nloc, unsigned& nx) {
    const unsigned G = gridDim.x;
    unsigned sum, cnt, mine, sp = 0u;
    for (;;) {
        sum = 0u; cnt = 0u; mine = 0u;
#pragma unroll
        for (unsigned j = 0; j < 16; ++j) { const unsigned c = xb_ld(&bar[XB_XCNT(j)]); sum += c; cnt += (c > 0u) ? 1u : 0u; mine = (j == x) ? c : mine; }
        if (sum == G) break;
        __builtin_amdgcn_s_sleep(1);
        if ((++sp & 255u) == 0u) { if (xb_ld(&bar[XB_TMO])) break; if (sp > XB_SPIN_CAP) { atomicAdd(&bar[XB_TMO], 1u); break; } }
    }
    nloc = mine > 0u ? mine : 1u; nx = cnt > 0u ? cnt : 1u;
}
DI void gbar_post(const KP p, unsigned char* shm) {
    volatile LAS unsigned* st = (volatile LAS unsigned*)(LAS unsigned char*)(shm + 131072);
    if (threadIdx.x == 0) { st[0] = 0u; st[1] = 0u; (void)xb_add(&((unsigned*)(p.ws() + OFF_BAR))[XB_XCNT(xb_xcc_id())], 1u); }
    __syncthreads();
}
DI void gbar(const KP p, unsigned char* shm) {
    asm volatile("s_waitcnt vmcnt(0)" ::: "memory");
    __syncthreads();
    if (threadIdx.x == 0) {
        unsigned* bar = (unsigned*)(p.ws() + OFF_BAR); const unsigned x = xb_xcc_id();
        volatile LAS unsigned* st = (volatile LAS unsigned*)(LAS unsigned char*)(shm + 131072);
        __builtin_amdgcn_s_waitcnt(0);
        unsigned nloc = st[0], nx = st[1];
        if (nloc == 0u) { xcd_barrier_complete(bar, x, nloc, nx); st[0] = nloc; st[1] = nx; }
        const unsigned old = xb_add(&bar[XB_XSUB(x)], 1u);
        const unsigned gen = old / nloc;
        if (old + 1u == (gen + 1u) * nloc) {
            __builtin_amdgcn_fence(__ATOMIC_RELEASE, "agent");
            asm volatile("s_waitcnt vmcnt(0)" ::: "memory");
            const unsigned og = xb_add(&bar[XB_TOP], 1u);
            const unsigned tg = og / nx;
            if (og + 1u == (tg + 1u) * nx) xb_add(&bar[XB_TOPGEN], 1u);
            else XB_SPIN(xb_ld(&bar[XB_TOPGEN]) == tg, bar);
            __builtin_amdgcn_fence(__ATOMIC_ACQUIRE, "agent");
            xb_add(&bar[XB_XGEN(x)], 1u);
            asm volatile("s_waitcnt vmcnt(0)" ::: "memory");
        } else {
            XB_SPIN(xb_ld(&bar[XB_XGEN(x)]) == gen, bar);
            __builtin_amdgcn_fence(__ATOMIC_ACQUIRE, "agent");
            asm volatile("s_waitcnt vmcnt(0)" ::: "memory");
        }
    }
    __syncthreads();
}

struct EpiResidNorm {
    static constexpr bool PERM = false, MERGE = false, AFTER_DRAIN = true;
    float* x; const float* modl; int gate_off; int mode; const float* gam; const float* modn; int sh_off, sc_off; bf16_t* dst; float* rss; unsigned* cnt; unsigned* bar; float* rsl;
    DI void fused(AccT& acc, const Unit& u, int wr, int wc, int fr, int fq) const {
        const int row0 = u.pm * 256 + wr * 64 + fr, col0 = u.pn * 256 + wc * 32 + 4 * fq;
        const int mrow = mod_row(u.pm * 256);
        const float* gp = modl + (size_t)mrow * 6144 + gate_off + col0;
        { f32x4 gv[2][2];
#pragma unroll
          for (int bj = 0; bj < 2; ++bj)
#pragma unroll
              for (int n = 0; n < 2; ++n) gv[bj][n] = *(const f32x4*)(gp + bj * 128 + n * 16);
          const float* xp = x + (size_t)row0 * 1024 + col0;
#pragma unroll
          for (int ai = 0; ai < 2; ++ai)
#pragma unroll
              for (int m = 0; m < 4; ++m) {
                  asm volatile("" : "+v"(xp));
                  float sq = 0.f;
#pragma unroll
                  for (int bj = 0; bj < 2; ++bj)
#pragma unroll
                      for (int n = 0; n < 2; ++n) { f32x4 xv = *(const f32x4*)(xp + bj * 128 + n * 16); xv += gv[bj][n] * acc[ai][bj][m][n]; acc[ai][bj][m][n] = xv; sq += xv[0] * xv[0] + xv[1] * xv[1] + xv[2] * xv[2] + xv[3] * xv[3]; }
                  sq += __shfl_xor(sq, 16); sq += __shfl_xor(sq, 32);
                  if (fq == 0) __hip_atomic_store(&rss[(size_t)(row0 + ai * 128 + m * 16) * 16 + u.pn * 4 + wc], sq, __ATOMIC_RELAXED, __HIP_MEMORY_SCOPE_AGENT);
                  xp += (m == 3 ? (128 - 48) : 16) * 1024;
              } }
        asm volatile("s_waitcnt vmcnt(0)" ::: "memory");
        __syncthreads();
        if (threadIdx.x == 0) { (void)xb_add(&cnt[u.pm], 1u); XB_SPIN(xb_ld(&cnt[u.pm]) < 4u, bar); }
        __syncthreads();
        float rs[2][4];
        { const int L = fq * 16 + fr; float* rw = rsl + (wr * 4 + wc) * 128;
#pragma unroll
          for (int ai = 0; ai < 2; ++ai) { const float* rp = rss + (size_t)(u.pm * 256 + ai * 128 + wr * 64 + L) * 16;
              float t = 0.f;
#pragma unroll
              for (int q = 0; q < 8; ++q) { const unsigned long long w = __hip_atomic_load((const unsigned long long*)rp + q, __ATOMIC_RELAXED, __HIP_MEMORY_SCOPE_AGENT); t += __uint_as_float((unsigned)w) + __uint_as_float((unsigned)(w >> 32)); }
              rw[ai * 64 + L] = rsqrtf(t * (1.0f / 1024.0f) + 1e-6f); }
#pragma unroll
          for (int ai = 0; ai < 2; ++ai)
#pragma unroll
              for (int m = 0; m < 4; ++m) rs[ai][m] = rw[ai * 64 + 16 * m + fr]; }
        { const float* mn = modn + (size_t)mrow * 6144 + col0;
          f32x4 ms[2][2], sh[2][2];
#pragma unroll
          for (int bj = 0; bj < 2; ++bj)
#pragma unroll
              for (int n = 0; n < 2; ++n) { const int cc = bj * 128 + n * 16; ms[bj][n] = *(const f32x4*)(gam + col0 + cc); sh[bj][n] = (f32x4){0.f, 0.f, 0.f, 0.f};
                  if (mode == 0) { ms[bj][n] = ms[bj][n] * (*(const f32x4*)(mn + sc_off + cc) + 1.0f); sh[bj][n] = *(const f32x4*)(mn + sh_off + cc); } }
          float* xq = x + (size_t)row0 * 1024 + col0; bf16_t* dq = dst + (size_t)row0 * 1024 + col0;
#pragma unroll
          for (int ai = 0; ai < 2; ++ai)
#pragma unroll
              for (int m = 0; m < 4; ++m) {
                  asm volatile("" : "+v"(xq), "+v"(dq));
#pragma unroll
                  for (int bj = 0; bj < 2; ++bj)
#pragma unroll
                      for (int n = 0; n < 2; ++n) { const int cc = bj * 128 + n * 16; const f32x4 y = acc[ai][bj][m][n] * rs[ai][m] * ms[bj][n] + sh[bj][n];
                          if (mode == 0) { *(f32x4*)(xq + cc) = acc[ai][bj][m][n]; u32x2 ob; ob[0] = pk2(y[0], y[1]); ob[1] = pk2(y[2], y[3]); *(u32x2*)(dq + cc) = ob; } else *(f32x4*)(xq + cc) = y; }
                  xq += (m == 3 ? (128 - 48) : 16) * 1024; dq += (m == 3 ? (128 - 48) : 16) * 1024;
              } }
    }
};

DI float wave_sum(float v) {
#pragma unroll
    for (int o = 32; o > 0; o >>= 1) v += __shfl_xor(v, o);
    return v;
}

DI void phase_mod(const KP p, unsigned char* shm) {
    float* sc = (float*)shm; float* red = sc + 9 * 1024;
    const int tid = ltid(); bool inited = false;
    const float* cond = p.in(5); const float* cctx = p.in(6);
    for (int it = lbid(); it < 192; it += lgdim()) {
        if (!inited) { for (int e = tid; e < 9 * 1024; e += 512) { const int r = e >> 10, k = e & 1023; const float v = r == 0 ? cctx[k] : cond[(r - 1) * 1024 + k]; sc[e] = v / (1.0f + expf(-v)); } __syncthreads(); inited = true; }
        const int l = it / 96, j0 = (it % 96) * 64, j = tid & 63, kq = tid >> 6;
        const float* w = p.in(9) + (size_t)l * 1024 * 6144 + j0 + j;
        float a0 = 0, a1 = 0, a2 = 0, a3 = 0, a4 = 0, a5 = 0, a6 = 0, a7 = 0, a8 = 0;
        for (int k = kq * 128; k < kq * 128 + 128; ++k) { const float wv = w[(size_t)k * 6144];
            a0 += sc[k] * wv; a1 += sc[1024 + k] * wv; a2 += sc[2048 + k] * wv; a3 += sc[3072 + k] * wv; a4 += sc[4096 + k] * wv; a5 += sc[5120 + k] * wv; a6 += sc[6144 + k] * wv; a7 += sc[7168 + k] * wv; a8 += sc[8192 + k] * wv; }
        float* rp = red + (kq * 9) * 64 + j;
        rp[0] = a0; rp[64] = a1; rp[128] = a2; rp[192] = a3; rp[256] = a4; rp[320] = a5; rp[384] = a6; rp[448] = a7; rp[512] = a8;
        __syncthreads();
        for (int e = tid; e < 576; e += 512) { const int r = e >> 6, jj = e & 63; float s = p.in(10)[(size_t)l * 6144 + j0 + jj];
            for (int q = 0; q < 8; ++q) s += red[(q * 9 + r) * 64 + jj];
            ((float*)(p.ws() + OFF_MOD))[((size_t)l * 9 + r) * 6144 + j0 + jj] = s; }
        __syncthreads();
    }
    __syncthreads();
}

DI void phase_kbound(const KP p, unsigned char* shm) {
    const int tid = ltid(), lane = tid & 63, wid = tid >> 6; float* red = (float*)shm; float* out = (float*)(p.ws() + OFF_KMAX);
    for (int it = lbid(); it < 64; it += lgdim()) {
        const int l = it >> 5, b = (it >> 2) & 7, hk = it & 3; const int key = tid >> 1, half = tid & 1;
        const float* src = p.in(2) + ((((size_t)b * 2 + l) * 256 + key) * 256) + hk * 64 + half * 32;
        float ss = 0.f;
#pragma unroll
        for (int i = 0; i < 8; ++i) { const f32x4 v = *(const f32x4*)(src + i * 4); ss += v[0] * v[0] + v[1] * v[1] + v[2] * v[2] + v[3] * v[3]; }
        ss += __shfl_xor(ss, 1);
#pragma unroll
        for (int o = 2; o < 64; o <<= 1) ss = fmaxf(ss, __shfl_xor(ss, o));
        if (lane == 0) red[wid] = ss;
        __syncthreads();
        if (tid == 0) { float m = red[0]; for (int w = 1; w < 8; ++w) m = fmaxf(m, red[w]); out[it] = m; }
        __syncthreads();
    }
    if (lbid() == lgdim() - 1 && tid < 2) { float g2 = 0.f; for (int d = 0; d < 64; ++d) { const float g = p.in(21)[tid * 64 + d]; g2 = fmaxf(g2, g * g); } out[64 + tid] = 64.0f * g2; }
}

DI void transpose_tile(const float* src, int N, int k0, int scol0, bf16_t* dst, int ldd, int drow0, float* tile) {
    const int tid = ltid();
#pragma unroll
    for (int i = 0; i < 2; ++i) { const int idx = tid + i * 512, k = idx >> 4, n4 = idx & 15; const f32x4 v = *(const f32x4*)(src + (size_t)(k0 + k) * N + scol0 + n4 * 4);
        float* t = tile + k * 65 + n4 * 4; t[0] = v[0]; t[1] = v[1]; t[2] = v[2]; t[3] = v[3]; }
    __syncthreads();
    { const int n = tid >> 3, kg = tid & 7; float f[8];
#pragma unroll
      for (int j = 0; j < 8; ++j) f[j] = tile[(kg * 8 + j) * 65 + n];
      *(u32x4*)(dst + (size_t)(drow0 + n) * ldd + k0 + kg * 8) = pack8(f); }
    __syncthreads();
}
DI void phase_weights(const KP p, int l, unsigned char* shm, int mask = 31, int Gw = 0, int cw = 0) {
    float* tile = (float*)shm; unsigned char* W = p.ws() + OFF_W;
    const int G = Gw > 0 ? Gw : lgdim(), c = Gw > 0 ? cw : lbid(); int base = 0;
    auto run = [&](const float* src, int K, int N, bf16_t* dst, int ldd, int mode) {
        const int ntn = N / 64, ntk = K / 64, nt = ntn * ntk;
        int first = (c - base) % G; if (first < 0) first += G;
        for (int ti = first; ti < nt; ti += G) { const int kt = ti / ntn, nn = ti - kt * ntn; const int drow0 = nn * 64; int scol0 = drow0;
            if (mode == 1) { const int j = drow0 >> 8, w = drow0 & 255; scol0 = w < 128 ? 128 * j + w : 3072 + 128 * j + (w - 128); }
            transpose_tile(src, N, kt * 64, scol0, dst, ldd, drow0, tile); }
        base += nt;
    };
    if (mask & 1) run(p.in(11) + (size_t)l * 1024 * 7680, 1024, 7680, (bf16_t*)(W + W_IN), 1024, 0);
    if (mask & 2) run(p.in(28) + (size_t)l * 1024 * 6144, 1024, 6144, (bf16_t*)(W + W_UP), 1024, 1);
    if (mask & 4) run(p.in(31) + (size_t)l * 3072 * 1024, 3072, 1024, (bf16_t*)(W + W_DOWN), 3072, 0);
    if (mask & 8) {
    run(p.in(24) + (size_t)l * 1024 * 1024, 1024, 1024, (bf16_t*)(W + W_BR), 1024, 0);
    run(p.in(25) + (size_t)l * 1024 * 1024, 1024, 1024, (bf16_t*)(W + W_BR) + (size_t)1024 * 1024, 1024, 0);
    run(p.in(26) + (size_t)l * 1024 * 1024, 1024, 1024, (bf16_t*)(W + W_BR) + (size_t)2 * 1024 * 1024, 1024, 0);
    run(p.in(27) + (size_t)l * 1024 * 1024, 1024, 1024, (bf16_t*)(W + W_O), 1024, 0); }
    if (mask & 16) {
    for (int g = 0; g < 4; ++g) run(p.in(22) + ((size_t)l * 4 + g) * 256 * 256, 256, 256, (bf16_t*)(W + W_POOL) + (size_t)g * 256 * 256, 256, 0);
    bf16_t* wg = (bf16_t*)(W + W_GATE);
    for (int e = c * 512 + ltid(); e < 16 * 2 * 128 * 64; e += G * 512) {
        const int k = e & 63, col = (e >> 6) & 127, dir = (e >> 13) & 1, n = e >> 14;
        const float* src = (col < 64 ? p.in(15) : p.in(17)) + ((((size_t)l * 2 + dir) * 16 + n) * 64 + k) * 64 + (col & 63);
        wg[e] = (bf16_t)(pk2(*src, 0.f) & 0xffffu);
    } }
}

DI void phase_norm(const KP p, int l, bool from_input, const float* gam, int sh_off, int sc_off, bf16_t* dst, bool final_) {
    const int tid_ = ltid(); const int lane = tid_ & 63, wid = tid_ >> 6;
    const float* modl = (const float*)(p.ws() + OFF_MOD) + (size_t)l * 9 * 6144;
    const int stride = lgdim() * 8;
    f32x4 gv[4];
#pragma unroll
    for (int i = 0; i < 4; ++i) gv[i] = *(const f32x4*)(gam + i * 256 + lane * 4);
    for (int mb = lbid() * 8 + wid; mb < MT; mb += 3 * stride) {
        f32x4 xv[3][4]; float ss[3];
#pragma unroll
        for (int r = 0; r < 3; ++r) { const int m = mb + r * stride; ss[r] = 0.f;
            if (m < MT) { const float* xr = from_input ? (m < MCTX ? p.in(0) + (size_t)m * 1024 : p.in(1) + (size_t)(m - MCTX) * 1024) : p.out() + (size_t)m * 1024;
#pragma unroll
                for (int i = 0; i < 4; ++i) xv[r][i] = *(const f32x4*)(xr + i * 256 + lane * 4); }
            else {
#pragma unroll
                for (int i = 0; i < 4; ++i) xv[r][i] = (f32x4){0.f, 0.f, 0.f, 0.f}; } }
#pragma unroll
        for (int r = 0; r < 3; ++r) {
#pragma unroll
            for (int i = 0; i < 4; ++i) ss[r] += xv[r][i][0] * xv[r][i][0] + xv[r][i][1] * xv[r][i][1] + xv[r][i][2] * xv[r][i][2] + xv[r][i][3] * xv[r][i][3];
            ss[r] = wave_sum(ss[r]); }
#pragma unroll
        for (int r = 0; r < 3; ++r) { const int m = mb + r * stride; if (m >= MT) continue;
            const float rs = rsqrtf(ss[r] * (1.0f / 1024.0f) + 1e-6f);
            const float* mr = modl + (size_t)mod_row(m) * 6144;
#pragma unroll
            for (int i = 0; i < 4; ++i) { const int cc = i * 256 + lane * 4;
                if (final_) { f32x4 y = xv[r][i] * rs * gv[i]; *(f32x4*)(p.out() + (size_t)m * 1024 + cc) = y; }
                else { const f32x4 scv = *(const f32x4*)(mr + sc_off + cc), shv = *(const f32x4*)(mr + sh_off + cc);
                    f32x4 y = xv[r][i] * rs * gv[i] * (scv + 1.0f) + shv; u32x2 o; o[0] = pk2(y[0], y[1]); o[1] = pk2(y[2], y[3]);
                    *(u32x2*)(dst + (size_t)m * 1024 + cc) = o;
                    if (from_input) *(f32x4*)(p.out() + (size_t)m * 1024 + cc) = xv[r][i]; }
            }
        }
    }
}

DI void phase_e1_elem(const KP p, int l, unsigned char* shm, int parts = 15) {
    float* tab = (float*)shm;
    const int tid = ltid();
    for (int e = tid; e < 1024; e += 512) { const int pos = e >> 4, j = e & 15; const float inv = exp2f(-(float)j * (13.287712379549449f / 16.0f)); const float ang = (float)pos * inv; tab[2 * e] = __cosf(ang); tab[2 * e + 1] = __sinf(ang); }
    __syncthreads();
    bf16_t* slots = (bf16_t*)(p.ws() + OFF_SLOTS);
    bf16_t* qb = slots + 3 * SLOT_E; bf16_t* kraw = (bf16_t*)(p.ws() + OFF_KRAW); bf16_t* vraw = (bf16_t*)(p.ws() + OFF_VRAW);
    const size_t gtid = (size_t)lbid() * 512 + tid, gsz = (size_t)lgdim() * 512;
    if (parts & 1) {
        auto qk_ptr = [&](size_t e) -> bf16_t* { const int i = (int)(e & 7); const int hh = 16 + (int)((e >> 3) & 3); const int m = (int)(e >> 5);
            return kraw + (size_t)m * 256 + (hh - 16) * 64 + i * 8; };
        auto qk_proc = [&](size_t e, u32x4 rawv, bf16_t* ptr) {
            const int i = (int)(e & 7); const int hh = 16 + (int)((e >> 3) & 3); const int m = (int)(e >> 5); const bool isq = false;
            float x[8]; unpack8(rawv, x);
            float ss = 0.f;
#pragma unroll
            for (int j = 0; j < 8; ++j) ss += x[j] * x[j];
            ss += __shfl_xor(ss, 1); ss += __shfl_xor(ss, 2); ss += __shfl_xor(ss, 4);
            const float rs = rsqrtf(ss * (1.0f / 64.0f) + 1e-6f);
            const float* g = (isq ? p.in(20) : p.in(21)) + l * 64 + i * 8; const f32x4 g0 = *(const f32x4*)g, g1 = *(const f32x4*)(g + 4);
#pragma unroll
            for (int j = 0; j < 4; ++j) { x[j] = x[j] * rs * g0[j]; x[4 + j] = x[4 + j] * rs * g1[j]; }
            const bool lat = m >= MCTX;
            float part[8];
#pragma unroll
            for (int j = 0; j < 8; ++j) part[j] = __shfl_xor(x[j], 2);
            if (lat) { const int t = (m - MCTX) & 1023; const int pos = (i < 4) ? (t >> 6) : (t & 63);
#pragma unroll
                for (int j = 0; j < 8; ++j) { const int jj = (i & 1) * 8 + j; const float cs = tab[2 * (pos * 16 + jj)], sn = tab[2 * (pos * 16 + jj) + 1];
                    x[j] = (i & 2) ? (part[j] * sn + x[j] * cs) : (x[j] * cs - part[j] * sn); }
            } else if (!isq) { float* o = p.out() + OUT_CK + ((((size_t)(m >> 8) * 2 + l) * 256 + (m & 255)) * 256) + (hh - 16) * 64 + i * 8;
                *(f32x4*)o = (f32x4){x[0], x[1], x[2], x[3]}; *(f32x4*)(o + 4) = (f32x4){x[4], x[5], x[6], x[7]}; }
            *(u32x4*)ptr = pack8(x); };
        const size_t N = (size_t)MT * 4 * 8;
        for (size_t e = gtid; e < N; e += 2 * gsz) { const size_t e1 = e + gsz; const bool has1 = e1 < N;
            bf16_t* p0 = qk_ptr(e); bf16_t* p1 = qk_ptr(has1 ? e1 : e);
            const u32x4 r0 = *(const u32x4*)p0, r1 = *(const u32x4*)p1;
            qk_proc(e, r0, p0); if (has1) qk_proc(e1, r1, p1); }
    }
    bf16_t* vT = (bf16_t*)(p.ws() + OFF_VT);
    if (parts & 2)
    for (size_t e = gtid; e < (size_t)MT * 32; e += gsz) {
        int seq, t, grp;
        if (e < (size_t)MCTX * 32) { t = (int)(e & 255); grp = (int)((e >> 8) & 31); seq = (int)(e >> 13); }
        else { const size_t e2 = e - (size_t)MCTX * 32; t = (int)(e2 & 1023); grp = (int)((e2 >> 10) & 31); seq = 16 + (int)(e2 >> 15); }
        const int hk = grp >> 3, dg = grp & 7; const int m = seq < 16 ? seq * 256 + t : MCTX + (seq - 16) * 1024 + t;
        const u32x4 raw = *(const u32x4*)(vraw + (size_t)m * 256 + hk * 64 + dg * 8);
        bf16_t* dstp; int Sk;
        if (seq < 16) { Sk = 256; dstp = vT + ((size_t)(seq * 4 + hk) * 64 + dg * 8) * 256 + t; }
        else { Sk = 1280; dstp = vT + VT_LAT_E + ((size_t)((seq - 16) * 4 + hk) * 64 + dg * 8) * 1280 + 256 + t; }
#pragma unroll
        for (int j = 0; j < 8; ++j) dstp[(size_t)j * Sk] = (bf16_t)((j & 1) ? (raw[j >> 1] >> 16) : (raw[j >> 1] & 0xffffu));
        if (seq < 16) { float f[8]; unpack8(raw, f); float* o = p.out() + OUT_CV + ((((size_t)seq * 2 + l) * 256 + t) * 256) + hk * 64 + dg * 8;
            *(f32x4*)o = (f32x4){f[0], f[1], f[2], f[3]}; *(f32x4*)(o + 4) = (f32x4){f[4], f[5], f[6], f[7]}; }
    }
    bf16_t* ck = (bf16_t*)(p.ws() + OFF_CK);
    if (parts & 4)
    for (size_t e = gtid; e < (size_t)8 * 256 * 32; e += gsz) {
        const int c8 = (int)(e & 31), t = (int)((e >> 5) & 255), b = (int)(e >> 13);
        const float* src = p.in(2) + ((((size_t)b * 2 + l) * 256 + t) * 256) + c8 * 8;
        float f[8]; const f32x4 a = *(const f32x4*)src, bb = *(const f32x4*)(src + 4); f[0] = a[0]; f[1] = a[1]; f[2] = a[2]; f[3] = a[3]; f[4] = bb[0]; f[5] = bb[1]; f[6] = bb[2]; f[7] = bb[3];
        *(u32x4*)(ck + ((size_t)b * 256 + t) * 256 + c8 * 8) = pack8(f);
    }
    if (parts & 4)
    for (size_t e = gtid; e < (size_t)8 * 32 * 256; e += gsz) {
        const int t = (int)(e & 255), grp = (int)((e >> 8) & 31), b = (int)(e >> 13); const int hk = grp >> 3, dg = grp & 7;
        const float* src = p.in(3) + ((((size_t)b * 2 + l) * 256 + t) * 256) + hk * 64 + dg * 8;
        bf16_t* dstp = vT + VT_LAT_E + ((size_t)(b * 4 + hk) * 64 + dg * 8) * 1280 + t;
#pragma unroll
        for (int j = 0; j < 8; ++j) dstp[(size_t)j * 1280] = (bf16_t)(pk2(src[j], 0.f) & 0xffffu);
    }
    const bf16_t* up = slots + 4 * SLOT_E; bf16_t* dd = slots;
    if (parts & 8) {
#define POOL_GROUP(GI, WW) \
        for (size_t e = gtid; e < (size_t)MT * 32; e += gsz) { \
            const int c8 = (GI) * 32 + (int)(e & 31), m = (int)(e >> 5); const int s0 = seq_start(m), S = seq_len(m), t = m - s0; \
            u32x4 rv[WW]; \
            _Pragma("unroll") for (int k = 0; k < (WW); ++k) { int tt = t - (WW) / 2 + k; tt = tt < 0 ? 0 : (tt >= S ? S - 1 : tt); rv[k] = *(const u32x4*)(up + (size_t)(s0 + tt) * 1024 + c8 * 8); } \
            float sum[8] = {0, 0, 0, 0, 0, 0, 0, 0}, self[8]; int cnt = 0; \
            _Pragma("unroll") for (int k = 0; k < (WW); ++k) { const int tt = t - (WW) / 2 + k; const bool ok = tt >= 0 && tt < S; cnt += ok ? 1 : 0; float f[8]; unpack8(rv[k], f); \
                _Pragma("unroll") for (int j = 0; j < 8; ++j) sum[j] += ok ? f[j] : 0.f; } \
            unpack8(rv[(WW) / 2], self); \
            const float inv = 1.0f / (float)cnt; \
            _Pragma("unroll") for (int j = 0; j < 8; ++j) sum[j] = sum[j] * inv - self[j]; \
            *(u32x4*)(dd + (size_t)m * 1024 + c8 * 8) = pack8(sum); }
        POOL_GROUP(0, 2) POOL_GROUP(1, 4) POOL_GROUP(2, 8) POOL_GROUP(3, 16)
#undef POOL_GROUP
    }
}

DI void phase_e2(const KP p, int l, const bf16_t* z, int ntl, int j0, bf16_t* act) {
    const float* cw = p.in(29) + (size_t)l * 3 * 6144; const float* cb = p.in(30) + (size_t)l * 6144;
    const int ldz = ntl * 256;
    const int gtid = lbid() * 512 + ltid(), gsz = lgdim() * 512;
    const int per_m = ntl * 16, rpt = gsz / per_m;
    const int r = gtid % per_m, mrow0 = gtid / per_m; const int jl = r >> 4, cg8 = r & 15;
    if (mrow0 >= rpt) return;
    f32x4 wv[2][4][2];
#pragma unroll
    for (int h = 0; h < 2; ++h) { const int wcol = h * 3072 + (j0 + jl) * 128 + cg8 * 8;
#pragma unroll
        for (int q = 0; q < 2; ++q) { wv[h][0][q] = *(const f32x4*)(cb + wcol + q * 4); wv[h][1][q] = *(const f32x4*)(cw + wcol + q * 4); wv[h][2][q] = *(const f32x4*)(cw + 6144 + wcol + q * 4); wv[h][3][q] = *(const f32x4*)(cw + 2 * 6144 + wcol + q * 4); } }
    const u32x4 zero = (u32x4){0, 0, 0, 0};
    for (int mb = mrow0; mb < MT; mb += 2 * rpt) {
        u32x4 zr[2][2][3];
#pragma unroll
        for (int u = 0; u < 2; ++u) { const int m = mb + u * rpt; const bool ok = m < MT; const int mm = ok ? m : mb;
            const int s0 = seq_start(mm), S = seq_len(mm), t = mm - s0; const bool hp = t > 0, hn = t < S - 1;
#pragma unroll
            for (int h = 0; h < 2; ++h) { const bf16_t* zp = z + (size_t)mm * ldz + jl * 256 + h * 128 + cg8 * 8;
                zr[u][h][0] = hp ? *(const u32x4*)(zp - ldz) : zero; zr[u][h][1] = *(const u32x4*)zp; zr[u][h][2] = hn ? *(const u32x4*)(zp + ldz) : zero; } }
#pragma unroll
        for (int u = 0; u < 2; ++u) { const int m = mb + u * rpt; if (m >= MT) continue;
            float res[2][8];
#pragma unroll
            for (int h = 0; h < 2; ++h) { float z0[8], z1[8], z2[8]; unpack8(zr[u][h][0], z0); unpack8(zr[u][h][1], z1); unpack8(zr[u][h][2], z2);
#pragma unroll
                for (int j = 0; j < 8; ++j) res[h][j] = wv[h][0][j >> 2][j & 3] + wv[h][1][j >> 2][j & 3] * z0[j] + wv[h][2][j >> 2][j & 3] * z1[j] + wv[h][3][j >> 2][j & 3] * z2[j]; }
            float o[8];
#pragma unroll
            for (int j = 0; j < 8; ++j) o[j] = res[0][j] * sigmoidf_(res[0][j]) * res[1][j];
            *(u32x4*)(act + (size_t)m * 3072 + (j0 + jl) * 128 + cg8 * 8) = pack8(o); }
    }
}

DI int crow(int reg, int h) { return (reg & 3) + 8 * (reg >> 2) + 4 * h; }
DI float fsig(float x) { return __builtin_amdgcn_rcpf(1.0f + __builtin_amdgcn_exp2f(-1.4426950408889634f * x)); }
constexpr int L2_XW = 0, L2_SEG = 8 * 16 * 68 * 4, L2_CST = L2_SEG + 8192, L2_CW = L2_CST + 512, L2_WG = L2_CW + 1280, L2_RAW = L2_WG + 128 * 144, L2_END = L2_RAW + 8 * 19 * 64 * 2;
static_assert(L2_END <= 131072, "lds");
template <int DIR>
DI void lru_sweep(const KP p, int l, int seq, int n, unsigned char* shm, bool wet) {
    const int tid = ltid(), lane = tid & 63, wid = tid >> 6, l16 = lane & 15, kg = lane >> 4;
    const int S = seq < 16 ? 256 : 1024, m0 = seq < 16 ? seq * 256 : MCTX + (seq - 16) * 1024, nst = S >> 7;
    bf16_t* slots = (bf16_t*)(p.ws() + OFF_SLOTS);
    const bf16_t* xr = slots + 1 * SLOT_E + n * 64; const bf16_t* yv = slots + 2 * SLOT_E + n * 64; bf16_t* yo = slots + 4 * SLOT_E + n * 64;
    float* xw = (float*)(shm + L2_XW) + wid * 16 * 68; float* segs = (float*)(shm + L2_SEG); float* cst = (float*)(shm + L2_CST);
    bf16_t* wgl = (bf16_t*)(shm + L2_WG);
    { const bf16_t* wg = (const bf16_t*)(p.ws() + OFF_W + W_GATE) + ((size_t)n * 2 + DIR) * 128 * 64;
#pragma unroll
      for (int i = 0; i < 2; ++i) { const int pc = tid + i * 512, col = pc >> 3, part = pc & 7; *(u32x4*)(wgl + col * 72 + part * 8) = *(const u32x4*)(wg + col * 64 + part * 8); } }
    float br[4], bi[4], ls8[4];
#pragma unroll
    for (int cq = 0; cq < 4; ++cq) { const size_t o = ((size_t)l * 2 + DIR) * 1024 + n * 64 + cq * 16 + l16; br[cq] = p.in(16)[o]; bi[cq] = p.in(18)[o];
        ls8[cq] = -8.0f * 1.4426950408889634f * log1pf(expf(-p.in(19)[o])); }
    const float w0 = p.in(13)[((size_t)l * 4 + 0) * 1024 + n * 64 + lane], w1 = p.in(13)[((size_t)l * 4 + 1) * 1024 + n * 64 + lane], w2 = p.in(13)[((size_t)l * 4 + 2) * 1024 + n * 64 + lane],
                w3 = p.in(13)[((size_t)l * 4 + 3) * 1024 + n * 64 + lane], wb = p.in(14)[(size_t)l * 1024 + n * 64 + lane];
    if (tid < 64) cst[tid] = seq < 16 ? 0.f : p.in(4)[(((size_t)(seq - 16) * 2 + l) * 2 + DIR) * 1024 + n * 64 + tid];
    __syncthreads();
    bf16_t* rawt = (bf16_t*)(shm + L2_RAW) + wid * 19 * 64;
    u32x4 rr[3];
    auto load_raw = [&](int base) {
#pragma unroll
        for (int i = 0; i < 3; ++i) { const int pc = lane + i * 64, r = pc >> 3, part = pc & 7; const int tt = base + wid * 16 - 1 + r; rr[i] = (u32x4){0, 0, 0, 0};
            if (pc < 152 && tt >= 0 && tt < S) rr[i] = *(const u32x4*)(xr + (size_t)(m0 + tt) * 1024 + part * 8); } };
    load_raw(DIR == 0 ? 0 : (nst - 1) * 128);
#pragma unroll 1
    for (int s = 0; s < nst; ++s) {
        const int base = (DIR == 0 ? s : nst - 1 - s) * 128; const int par = s & 1;
        u32x4 yv4[2], tv4[2];
#pragma unroll
        for (int i = 0; i < 2; ++i) { const int pc = lane + i * 64; const size_t o = (size_t)(m0 + base + wid * 16 + (pc >> 3)) * 1024 + (pc & 7) * 8;
            yv4[i] = *(const u32x4*)(yv + o); tv4[i] = DIR == 1 ? *(const u32x4*)(yo + o) : (u32x4){0, 0, 0, 0}; }
#pragma unroll
        for (int i = 0; i < 3; ++i) { const int pc = lane + i * 64; if (pc < 152) *(u32x4*)(rawt + pc * 8) = rr[i]; }
        { float xf[19];
#pragma unroll
          for (int r = 0; r < 19; ++r) xf[r] = bflo((unsigned)rawt[r * 64 + lane]);
#pragma unroll
          for (int tk = 0; tk < 16; ++tk) xw[tk * 68 + lane] = wb + w0 * xf[tk] + w1 * xf[tk + 1] + w2 * xf[tk + 2] + w3 * xf[tk + 3]; }
        if (s + 1 < nst) load_raw((DIR == 0 ? s + 1 : nst - 2 - s) * 128);
        bf16x8 Af[2];
#pragma unroll
        for (int ks = 0; ks < 2; ++ks) { const f32x4 a0 = *(const f32x4*)(xw + l16 * 68 + ks * 32 + kg * 8), a1 = *(const f32x4*)(xw + l16 * 68 + ks * 32 + kg * 8 + 4);
            u32x4 pk; pk[0] = pk2(a0[0], a0[1]); pk[1] = pk2(a0[2], a0[3]); pk[2] = pk2(a1[0], a1[1]); pk[3] = pk2(a1[2], a1[3]); Af[ks] = __builtin_bit_cast(bf16x8, pk); }
        float hh[4][4], pp[4][4], Pl[4], Hl[4];
#pragma unroll
        for (int cq = 0; cq < 4; ++cq) { f32x4 ar = (f32x4){0.f, 0.f, 0.f, 0.f}, ai = (f32x4){0.f, 0.f, 0.f, 0.f};
#pragma unroll
            for (int ks = 0; ks < 2; ++ks) { const bf16x8 Br = *(const bf16x8*)(wgl + (cq * 16 + l16) * 72 + ks * 32 + kg * 8), Bi = *(const bf16x8*)(wgl + ((4 + cq) * 16 + l16) * 72 + ks * 32 + kg * 8);
                ar = __builtin_amdgcn_mfma_f32_16x16x32_bf16(Af[ks], Br, ar, 0, 0, 0); ai = __builtin_amdgcn_mfma_f32_16x16x32_bf16(Af[ks], Bi, ai, 0, 0, 0); }
            float H = 0.f, P = 1.f;
#pragma unroll
            for (int jj = 0; jj < 4; ++jj) { const int i = DIR == 0 ? jj : 3 - jj;
                const float r = fsig(ar[i] + br[cq]), ig = fsig(ai[i] + bi[cq]), x = xw[(kg * 4 + i) * 68 + cq * 16 + l16];
                const float a = __builtin_amdgcn_exp2f(r * ls8[cq]); const float u = __builtin_amdgcn_sqrtf(fmaf(-a, a, 1.0f)) * ig * x; H = fmaf(a, H, u); P *= a; hh[cq][i] = H; pp[cq][i] = P; }
            Pl[cq] = P; Hl[cq] = H; }
        float Pe[4], He[4];
#pragma unroll
        for (int cq = 0; cq < 4; ++cq) {
#pragma unroll
            for (int d = 1; d <= 2; d <<= 1) { const int src = (DIR == 0 ? lane - 16 * d : lane + 16 * d) & 63; const bool ok = DIR == 0 ? kg >= d : kg <= 3 - d;
                const float Pp = __shfl(Pl[cq], src), Hp = __shfl(Hl[cq], src);
                if (ok) { Hl[cq] = fmaf(Pl[cq], Hp, Hl[cq]); Pl[cq] *= Pp; } }
            const int src = (DIR == 0 ? lane - 16 : lane + 16) & 63; const bool ok = DIR == 0 ? kg >= 1 : kg <= 2;
            const float Pp = __shfl(Pl[cq], src), Hp = __shfl(Hl[cq], src); Pe[cq] = ok ? Pp : 1.0f; He[cq] = ok ? Hp : 0.0f; }
        if (kg == (DIR == 0 ? 3 : 0)) {
#pragma unroll
            for (int cq = 0; cq < 4; ++cq) { float* sp = segs + ((par * 8 + wid) * 64 + cq * 16 + l16) * 2; sp[0] = Pl[cq]; sp[1] = Hl[cq]; } }
        __syncthreads();
        float cwl = cst[par * 64 + lane];
        { float sP[8], sH[8];
#pragma unroll
          for (int w2 = 0; w2 < 8; ++w2) { const f32x2_t v = *(const f32x2_t*)(segs + ((par * 8 + w2) * 64 + lane) * 2); sP[w2] = v[0]; sH[w2] = v[1]; }
#pragma unroll
          for (int jj = 0; jj < 8; ++jj) { const int w2 = DIR == 0 ? jj : 7 - jj; const bool before = DIR == 0 ? w2 < wid : w2 > wid; if (before) cwl = fmaf(sP[w2], cwl, sH[w2]); } }
#pragma unroll
        for (int cq = 0; cq < 4; ++cq) { const int c = cq * 16 + l16; const float cwv = __shfl(cwl, c);
            const float cl = fmaf(Pe[cq], cwv, He[cq]);
#pragma unroll
            for (int i = 0; i < 4; ++i) hh[cq][i] = fmaf(pp[cq][i], cl, hh[cq][i]);
            if (wid == (DIR == 0 ? 7 : 0) && kg == (DIR == 0 ? 3 : 0)) cst[(par ^ 1) * 64 + c] = hh[cq][DIR == 0 ? 3 : 0];
#pragma unroll
            for (int i = 0; i < 4; ++i) xw[(kg * 4 + i) * 68 + c] = hh[cq][i];
        }
#pragma unroll
        for (int i = 0; i < 2; ++i) { const int pc = lane + i * 64, tk = pc >> 3, part = pc & 7; const f32x4 h0 = *(const f32x4*)(xw + tk * 68 + part * 8), h1 = *(const f32x4*)(xw + tk * 68 + part * 8 + 4);
            float y[8], t[8], o[8]; unpack8(yv4[i], y); unpack8(tv4[i], t);
#pragma unroll
            for (int e = 0; e < 4; ++e) { o[e] = fmaf(h0[e], y[e], t[e]); o[4 + e] = fmaf(h1[e], y[4 + e], t[4 + e]); }
            if (wet) *(u32x4*)(yo + (size_t)(m0 + base + wid * 16 + tk) * 1024 + part * 8) = pack8(o); }
    }
    __syncthreads();
    if (wet && seq < 16 && tid < 64) p.out()[OUT_ST + (((size_t)seq * 2 + l) * 2 + DIR) * 1024 + n * 64 + tid] = cst[(nst & 1) * 64 + tid];
    __syncthreads();
}
DI void lru_item(const KP p, int l, int seq, int n, unsigned char* shm, bool wet = true) {
    __syncthreads();
    lru_sweep<0>(p, l, seq, n, shm, wet);
    lru_sweep<1>(p, l, seq, n, shm, wet);
}

DI void attn_item(const KP p, int l, int seq, int hk, int qb, unsigned char* shm, bool wet = true) {
    const int tid = ltid(), lane = tid & 63, wid = tid >> 6, h = lane >> 5, l32 = lane & 31;
    const bool lat = seq >= 16; const int m0 = lat ? MCTX + (seq - 16) * 1024 : seq * 256; const int Sk = lat ? 1280 : 256, nt = Sk >> 6;
    bf16_t* slots = (bf16_t*)(p.ws() + OFF_SLOTS); bf16_t* qbuf = slots + 3 * SLOT_E;
    const bf16_t* kraw = (const bf16_t*)(p.ws() + OFF_KRAW); const bf16_t* ck = (const bf16_t*)(p.ws() + OFF_CK);
    const bf16_t* vT = (const bf16_t*)(p.ws() + OFF_VT) + (lat ? VT_LAT_E + (size_t)((seq - 16) * 4 + hk) * 64 * 1280 : (size_t)(seq * 4 + hk) * 64 * 256);
    bf16_t* Kt = (bf16_t*)shm; bf16_t* Vt = (bf16_t*)(shm + 4 * 9216);
    const int head = hk * 4 + (wid >> 1); const int mq = m0 + qb * 64 + (wid & 1) * 32 + l32;
    bf16x8 Qf[4];
    { float qv[4][8]; float ss = 0.f;
#pragma unroll
      for (int ks = 0; ks < 4; ++ks) { unpack8(*(const u32x4*)(qbuf + (size_t)mq * 1024 + head * 64 + ks * 16 + h * 8), qv[ks]);
#pragma unroll
          for (int j = 0; j < 8; ++j) ss += qv[ks][j] * qv[ks][j]; }
      ss += __shfl_xor(ss, 32);
      const float rs = rsqrtf(ss * (1.0f / 64.0f) + 1e-6f);
      const float* gq = p.in(20) + l * 64 + h * 8;
#pragma unroll
      for (int ks = 0; ks < 4; ++ks) { const f32x4 g0 = *(const f32x4*)(gq + ks * 16), g1 = *(const f32x4*)(gq + ks * 16 + 4);
#pragma unroll
          for (int j = 0; j < 4; ++j) { qv[ks][j] *= rs * g0[j]; qv[ks][4 + j] *= rs * g1[j]; } }
      if (lat) { const int t = mq - m0;
#pragma unroll
          for (int j = 0; j < 8; ++j) { const float inv = exp2f(-(float)(h * 8 + j) * (13.287712379549449f / 16.0f));
              const float ar = (float)(t >> 6) * inv, ac = (float)(t & 63) * inv; const float cr = __cosf(ar), sr = __sinf(ar), cc = __cosf(ac), sc = __sinf(ac);
              const float a1 = qv[0][j], a2 = qv[1][j], b1 = qv[2][j], b2 = qv[3][j];
              qv[0][j] = a1 * cr - a2 * sr; qv[1][j] = a1 * sr + a2 * cr; qv[2][j] = b1 * cc - b2 * sc; qv[3][j] = b1 * sc + b2 * cc; } }
#pragma unroll
      for (int ks = 0; ks < 4; ++ks) Qf[ks] = __builtin_bit_cast(bf16x8, pack8(qv[ks])); }
    float offs;
    { float qq = 0.f;
#pragma unroll
      for (int ks = 0; ks < 4; ++ks)
#pragma unroll
          for (int j = 0; j < 8; ++j) { const float v = __uint_as_float(((unsigned)(unsigned short)Qf[ks][j]) << 16); qq += v * v; }
      qq += __shfl_xor(qq, 32);
      const float* kb = (const float*)(p.ws() + OFF_KMAX); float kmx = kb[64 + l]; if (lat) kmx = fmaxf(kmx, kb[(l * 8 + (seq - 16)) * 4 + hk]);
      offs = 1.01f * 0.125f * 1.4426950408889634f * sqrtf(qq * kmx); }
    const int lr = tid >> 3, lp = tid & 7;
    auto kaddr = [&](int kt) -> const bf16_t* { if (lat) { return kt < 4 ? ck + ((size_t)(seq - 16) * 256 + kt * 64 + lr) * 256 + hk * 64 + lp * 8 : kraw + (size_t)(m0 + (kt - 4) * 64 + lr) * 256 + hk * 64 + lp * 8; }
                                                  return kraw + (size_t)(m0 + kt * 64 + lr) * 256 + hk * 64 + lp * 8; };
    u32x4 kA = *(const u32x4*)kaddr(0), vA = *(const u32x4*)(vT + (size_t)lr * Sk + lp * 8);
    u32x4 kB = *(const u32x4*)kaddr(1), vB = *(const u32x4*)(vT + (size_t)lr * Sk + 64 + lp * 8);
    f32x16 O0, O1;
#pragma unroll
    for (int r = 0; r < 16; ++r) { O0[r] = 0.f; O1[r] = 0.f; }
    float lrun = 0.f; const float cs = 0.125f * 1.4426950408889634f;
    auto compute = [&](const bf16_t* Kb, const bf16_t* Vb) {
        f32x16 st0, st1;
#pragma unroll
        for (int r = 0; r < 16; ++r) { st0[r] = 0.f; st1[r] = 0.f; }
        bf16x8 ka[4][2];
#pragma unroll
        for (int ks = 0; ks < 4; ++ks) { ka[ks][0] = *(const bf16x8*)(Kb + (l32) * 72 + ks * 16 + h * 8); ka[ks][1] = *(const bf16x8*)(Kb + (32 + l32) * 72 + ks * 16 + h * 8); }
        __builtin_amdgcn_s_setprio(1);
#pragma unroll
        for (int ks = 0; ks < 4; ++ks) { st0 = __builtin_amdgcn_mfma_f32_32x32x16_bf16(ka[ks][0], Qf[ks], st0, 0, 0, 0); st1 = __builtin_amdgcn_mfma_f32_32x32x16_bf16(ka[ks][1], Qf[ks], st1, 0, 0, 0); }
        __builtin_amdgcn_s_setprio(0);
        float psum = 0.f;
#pragma unroll
        for (int r = 0; r < 16; ++r) { const float p0 = __builtin_amdgcn_exp2f(fmaf(st0[r], cs, -offs)), p1 = __builtin_amdgcn_exp2f(fmaf(st1[r], cs, -offs)); st0[r] = p0; st1[r] = p1; psum += p0 + p1; }
        lrun += psum;
#pragma unroll
        for (int kb = 0; kb < 2; ++kb)
#pragma unroll
            for (int s = 0; s < 2; ++s) {
                u32x4 pb;
                if (kb == 0) { pb[0] = pk2(st0[8 * s + 0], st0[8 * s + 1]); pb[1] = pk2(st0[8 * s + 2], st0[8 * s + 3]); pb[2] = pk2(st0[8 * s + 4], st0[8 * s + 5]); pb[3] = pk2(st0[8 * s + 6], st0[8 * s + 7]); }
                else { pb[0] = pk2(st1[8 * s + 0], st1[8 * s + 1]); pb[1] = pk2(st1[8 * s + 2], st1[8 * s + 3]); pb[2] = pk2(st1[8 * s + 4], st1[8 * s + 5]); pb[3] = pk2(st1[8 * s + 6], st1[8 * s + 7]); }
                const bf16x8 Pb = __builtin_bit_cast(bf16x8, pb);
                { const bf16_t* vp = Vb + (l32) * 68 + kb * 32 + 16 * s + 4 * h; const u32x2 v0 = *(const u32x2*)vp, v1 = *(const u32x2*)(vp + 8); u32x4 va; va[0] = v0[0]; va[1] = v0[1]; va[2] = v1[0]; va[3] = v1[1];
                  O0 = __builtin_amdgcn_mfma_f32_32x32x16_bf16(__builtin_bit_cast(bf16x8, va), Pb, O0, 0, 0, 0); }
                { const bf16_t* vp = Vb + (32 + l32) * 68 + kb * 32 + 16 * s + 4 * h; const u32x2 v0 = *(const u32x2*)vp, v1 = *(const u32x2*)(vp + 8); u32x4 va; va[0] = v0[0]; va[1] = v0[1]; va[2] = v1[0]; va[3] = v1[1];
                  O1 = __builtin_amdgcn_mfma_f32_32x32x16_bf16(__builtin_bit_cast(bf16x8, va), Pb, O1, 0, 0, 0); }
            }
    };
#pragma unroll 1
    for (int it = 0; it < (nt >> 1); ++it) {
        const int sb = (it & 1) * 2; bf16_t* K0 = Kt + sb * 4608; bf16_t* K1 = K0 + 4608; bf16_t* V0 = Vt + sb * 4352; bf16_t* V1 = V0 + 4352;
        *(u32x4*)(K0 + lr * 72 + lp * 8) = kA; *(u32x4*)(K1 + lr * 72 + lp * 8) = kB;
        { u32x2 w0, w1; w0[0] = vA[0]; w0[1] = vA[1]; w1[0] = vA[2]; w1[1] = vA[3]; *(u32x2*)(V0 + lr * 68 + lp * 8) = w0; *(u32x2*)(V0 + lr * 68 + lp * 8 + 4) = w1; }
        { u32x2 w0, w1; w0[0] = vB[0]; w0[1] = vB[1]; w1[0] = vB[2]; w1[1] = vB[3]; *(u32x2*)(V1 + lr * 68 + lp * 8) = w0; *(u32x2*)(V1 + lr * 68 + lp * 8 + 4) = w1; }
        __syncthreads();
        const int kt = it * 2;
        if (kt + 2 < nt) { kA = *(const u32x4*)kaddr(kt + 2); vA = *(const u32x4*)(vT + (size_t)lr * Sk + (kt + 2) * 64 + lp * 8);
                           kB = *(const u32x4*)kaddr(kt + 3); vB = *(const u32x4*)(vT + (size_t)lr * Sk + (kt + 3) * 64 + lp * 8); }
        compute(K0, V0);
        compute(K1, V1);
    }
    const float ltot = lrun + __shfl_xor(lrun, 32); const float inv = 1.0f / ltot;
    if (wet)
#pragma unroll
    for (int rg = 0; rg < 4; ++rg) { const int d = 8 * rg + 4 * h; u32x2 o;
        o[0] = pk2(O0[4 * rg] * inv, O0[4 * rg + 1] * inv); o[1] = pk2(O0[4 * rg + 2] * inv, O0[4 * rg + 3] * inv); *(u32x2*)(qbuf + (size_t)mq * 1024 + head * 64 + d) = o;
        o[0] = pk2(O1[4 * rg] * inv, O1[4 * rg + 1] * inv); o[1] = pk2(O1[4 * rg + 2] * inv, O1[4 * rg + 3] * inv); *(u32x2*)(qbuf + (size_t)mq * 1024 + head * 64 + 32 + d) = o; }
    __syncthreads();
}

__global__ void __launch_bounds__(512) mega(Params p_unused) {
    KP p = fresh_kp();
    extern __shared__ __attribute__((aligned(16))) unsigned char shm[];
    cg::grid_group grid = cg::this_grid();
    LAS unsigned char* lds = (LAS unsigned char*)shm;
    bf16_t* slots = (bf16_t*)(p.ws() + OFF_SLOTS); unsigned char* W = p.ws() + OFF_W;
    const int G = lgdim(), c = lbid();
    if (lbid() < 0) grid.sync();
    gbar_post(p, shm);
    phase_mod(p, shm);
    phase_kbound(p, shm);
    phase_weights(p, 0, shm, 1);
#if EXP == 5
    phase_mod(p, shm); phase_weights(p, 0, shm);
#endif
    gbar(p, shm); p = fresh_kp();
#pragma unroll 1
    for (int l = 0; l < 2; ++l) {
        const float* modl = (const float*)(p.ws() + OFF_MOD) + (size_t)l * 9 * 6144;
        if (l == 0) { phase_norm(p, 0, true, p.in(7), 0, 1024, slots, false);
#if EXP == 1
        for (int r = 0; r < 12; ++r) gbar(p, shm);
#endif
        gbar(p, shm); p = fresh_kp(); }
        { pg8::Gemm g{slots, (const bf16_t*)(W + W_IN), 1024, 1024, 1024, 48, 30, 1, 0, 0, 0, 0, 0};
          EpiInProj E{slots, (bf16_t*)(p.ws() + OFF_KRAW), (bf16_t*)(p.ws() + OFF_VRAW), p.in(12) + (size_t)l * 3072};
          pg8::gemm_phase(lds, g, E);
          if (l == 0 && G == 256 && c >= 160) { __syncthreads(); phase_weights(p, 0, shm, 8 | 16, 96, c - 160); }
          else if (l == 0 && G != 256) { __syncthreads(); phase_weights(p, 0, shm, 8 | 16); }
#if EXP == 4
          __syncthreads(); pg8::gemm_phase(lds, g, E);
#endif
        }
        gbar(p, shm); p = fresh_kp();
        phase_e1_elem(p, l, shm);
#if EXP == 8
        __syncthreads(); phase_e1_elem(p, l, shm, 14);
#endif
        gbar(p, shm); p = fresh_kp();
        { pg8::Gemm g{slots, (const bf16_t*)(W + W_POOL), 1024, 256, 256, 48, 4, 1, 0, 256, 0, 0, 0};
          EpiScaleBf16 E{slots, 1024, 0, p.in(23) + (size_t)l * 1024};
          if (G != 256) pg8::gemm_phase(lds, g, E); else if (c >= 128) pg8::gemm_phase(lds, g, E, 128, c - 128); }
        __syncthreads();
#if EXP == 3
        { const bool dry = lbid() < 0;
          if (c < 128) lru_item(p, l, 16 + (c >> 4), c & 15, shm, dry); else { for (int k = 0; k < 2; ++k) { const int it = (c - 128) * 2 + k; lru_item(p, l, it >> 4, it & 15, shm, dry); } } }
#endif
        if (G == 256) { if (c < 128) lru_item(p, l, 16 + (c >> 4), c & 15, shm); else { for (int k = 0; k < 2; ++k) { const int it = (c - 128) * 2 + k; lru_item(p, l, it >> 4, it & 15, shm); } } }
        else for (int it = c; it < 384; it += G) { if (it < 128) lru_item(p, l, 16 + (it >> 4), it & 15, shm); else lru_item(p, l, (it - 128) >> 4, (it - 128) & 15, shm); }
#if EXP == 2
        { const bool dry = lbid() < 0;
            for (int it = c; it < 512; it += 256) attn_item(p, l, 16 + (it >> 6), (it >> 4) & 3, it & 15, shm, dry);
            if (c >= 128) for (int k = 0; k < 2; ++k) { const int j = (c - 128) * 2 + k; attn_item(p, l, j >> 4, (j >> 2) & 3, j & 3, shm, dry); } }
#endif
        if (G == 256) {
            for (int it = c; it < 512; it += 256) attn_item(p, l, 16 + (it >> 6), (it >> 4) & 3, it & 15, shm);
            if (c >= 128) for (int k = 0; k < 2; ++k) { const int j = (c - 128) * 2 + k; attn_item(p, l, j >> 4, (j >> 2) & 3, j & 3, shm); }
        } else
        for (int it = c; it < 768; it += G) { if (it < 512) attn_item(p, l, 16 + (it >> 6), (it >> 4) & 3, it & 15, shm); else { const int j = it - 512; attn_item(p, l, j >> 4, (j >> 2) & 3, j & 3, shm); } }
        gbar(p, shm); p = fresh_kp();
        { pg8::Gemm g{slots + 4 * SLOT_E, (const bf16_t*)(W + W_BR), 1024, 1024, 1024, 48, 4, 1, 0, 0, -(long)SLOT_E, -4 * (long)SLOT_E, (long)1024 * 1024};
          EpiMerge E{slots + 5 * SLOT_E, false};
#if EXP == 9
          { EpiMerge E2{slots + 5 * SLOT_E, lbid() >= 0}; pg8::gemm_phase(lds, g, E2); __syncthreads(); }
#endif
          pg8::gemm_phase(lds, g, E);
          if (G == 256 && c >= 192) phase_weights(p, l, shm, 2 | 4, 64, c - 192);
          else if (G != 256) { __syncthreads(); phase_weights(p, l, shm, l == 0 ? (2 | 4) : 4); } }
        gbar(p, shm); p = fresh_kp();
        { pg8::Gemm g{slots + 7 * SLOT_E, (const bf16_t*)(W + W_O), 1024, 1024, 1024, 48, 4, 1, 0, 0, 0, 0, 0};
          EpiResidNorm E{p.out(), modl, 2048, 0, p.in(8) + l * 1024, modl, 3072, 4096, slots, (float*)(p.ws() + OFF_RSS), (unsigned*)(p.ws() + OFF_CNT) + (l * 2 + 0) * 48, (unsigned*)(p.ws() + OFF_BAR), (float*)(shm + 131072 + 16)};
          pg8::gemm_phase(lds, g, E); }
        gbar(p, shm); p = fresh_kp();
        { pg8::Gemm g{slots, (const bf16_t*)(W + W_UP), 1024, 1024, 1024, 48, 24, 1, 0, 0, 0, 0, 0, G == 256 ? 1 : 0};
          float* zedge = (float*)(slots + 1 * SLOT_E); float* zpart = zedge + (size_t)192 * 2 * 6144;
          EpiUpFused E{slots + 5 * SLOT_E, zedge, zpart, p.in(29) + (size_t)l * 3 * 6144, p.in(30) + (size_t)l * 6144};
          pg8::gemm_phase(lds, g, E);
          if (l == 0 && G != 256) { __syncthreads(); phase_weights(p, 1, shm, 1 | 8 | 16); } }
        gbar(p, shm); p = fresh_kp();
        { pg8::Gemm g{slots + 5 * SLOT_E, (const bf16_t*)(W + W_DOWN), 3072, 3072, 3072, 48, 4, 1, 0, 0, 0, 0, 0};
          { Unit u0; if (pg8::next_unit(g, 0, G, c, u0)) { const float* zedge = (const float*)(slots + 1 * SLOT_E);
              ffn_fixup(u0.pm, slots + 5 * SLOT_E, zedge, zedge + (size_t)192 * 2 * 6144, p.in(29) + (size_t)l * 3 * 6144, p.in(30) + (size_t)l * 6144); } }
          const float* modn = (const float*)(p.ws() + OFF_MOD) + (size_t)9 * 6144;
          EpiResidNorm E{p.out(), modl, 5120, l == 0 ? 0 : 1, l == 0 ? p.in(7) + 1024 : p.in(32), modn, 0, 1024, slots, (float*)(p.ws() + OFF_RSS), (unsigned*)(p.ws() + OFF_CNT) + (l * 2 + 1) * 48, (unsigned*)(p.ws() + OFF_BAR), (float*)(shm + 131072 + 16)};
          pg8::gemm_phase(lds, g, E);
          if (l == 0 && G == 256 && c >= 192) phase_weights(p, 1, shm, 1 | 8 | 16, 64, c - 192);
          else if (l == 0 && G != 256) { __syncthreads(); phase_weights(p, 1, shm, 2); } }
        gbar(p, shm); p = fresh_kp();
    }
}

extern "C" void kernel_launch(void* const* d_in, const int* in_sizes, int n_in, void* d_out, int out_size, void* d_ws, size_t ws_size, hipStream_t stream) {
    static int grid_blocks = 0;
    if (!grid_blocks) {
        int dev = 0, cus = 0, per_cu = 0;
        (void)hipGetDevice(&dev);
        (void)hipDeviceGetAttribute(&cus, hipDeviceAttributeMultiprocessorCount, dev);
        if (hipFuncSetAttribute((const void*)mega, hipFuncAttributeMaxDynamicSharedMemorySize, LDS_BYTES) != hipSuccess) { fprintf(stderr, "setattr failed\n"); return; }
        if (hipOccupancyMaxActiveBlocksPerMultiprocessor(&per_cu, (const void*)mega, 512, LDS_BYTES) != hipSuccess || per_cu < 1) { fprintf(stderr, "occupancy query failed\n"); return; }
        grid_blocks = cus;
    }
    if (ws_size < WS_NEED || n_in < 33) { fprintf(stderr, "workspace too small: %zu < %zu\n", ws_size, (size_t)WS_NEED); return; }
    Params p{};
    for (int i = 0; i < 33; ++i) p.in[i] = (const float*)d_in[i];
    p.out = (float*)d_out; p.ws = (unsigned char*)d_ws;
    (void)hipMemsetAsync((unsigned char*)d_ws + OFF_BAR, 0, (size_t)XCD_BAR_WORDS * 4 + 256 * 4 + 256 * 4, stream);
    void* args[] = {&p};
    hipError_t e = hipLaunchCooperativeKernel((void*)mega, dim3(grid_blocks), dim3(512), args, LDS_BYTES, stream);
    if (e != hipSuccess) fprintf(stderr, "cooperative launch failed: %s (grid %d)\n", hipGetErrorString(e), grid_blocks);
}
```
